# Optimizing an MI355X kernel written in HIP

```python
import math
import jax, jax.numpy as jnp
from jax import lax
import numpy as np


D_MODEL = 1024
BATCH = 8
SEQ = 2048
DEPTH = 1

D_MIX = D_MODEL
DIFF_WIDTH = D_MIX // 2
HGRN_WIDTH = D_MIX - DIFF_WIDTH
N_DIFF_HEADS = 4
DIFF_V_DIM = DIFF_WIDTH // N_DIFF_HEADS
DIFF_HEAD_DIM = DIFF_V_DIM // 2
N_HGRN_HEADS = 4
HGRN_EXPAND = 128
HGRN_V_DIM = HGRN_WIDTH // N_HGRN_HEADS
Q_BLOCK = 128
HGRN_CHUNK = 64
ROPE_THETA = 10000.0
N_GROUPS = 4
EXPERTS_PER_GROUP = 8
TOP_K = 2
D_EXPERT = D_MODEL // 2
RMS_EPS = 1e-6
SUBLN_EPS = 1e-5
MAX_POS_OFFSET = 512

PROJ_SIZES = (
    2 * N_DIFF_HEADS * DIFF_HEAD_DIM,
    2 * N_DIFF_HEADS * DIFF_HEAD_DIM,
    N_DIFF_HEADS * DIFF_V_DIM,
    N_HGRN_HEADS * HGRN_EXPAND,
    N_HGRN_HEADS * HGRN_EXPAND,
    N_HGRN_HEADS * HGRN_V_DIM,
    N_HGRN_HEADS * HGRN_V_DIM,
)
D_IN_PROJ = sum(PROJ_SIZES)

kernel_name = "hymba_diffattn_hgrn2_hiermoe_adaln"


def rms_norm(x, w, eps):
    xf = x.astype(jnp.float32)
    y = xf * lax.rsqrt(jnp.mean(xf * xf, axis=-1, keepdims=True) + eps)
    return (y * w.astype(jnp.float32)).astype(x.dtype)


def apply_rope(x, positions):
    d = x.shape[-1]
    half = d // 2
    inv_freq = ROPE_THETA ** (-jnp.arange(half, dtype=jnp.float32) / half)
    ang = positions.astype(jnp.float32)[..., None] * inv_freq
    cos = jnp.cos(ang)[:, :, None, :]
    sin = jnp.sin(ang)[:, :, None, :]
    xf = x.astype(jnp.float32)
    x1, x2 = xf[..., :half], xf[..., half:]
    out = jnp.concatenate([x1 * cos - x2 * sin, x2 * cos + x1 * sin], axis=-1)
    return out.astype(x.dtype)


def diff_attention(q, k, v, positions, lq1, lk1, lq2, lk2, subln_w, lambda_init):
    B, S = q.shape[0], q.shape[1]
    H, d = N_DIFF_HEADS, DIFF_HEAD_DIM
    q = apply_rope(q, positions)
    k = apply_rope(k, positions)
    lam = (jnp.exp(jnp.sum(lq1.astype(jnp.float32) * lk1.astype(jnp.float32)))
           - jnp.exp(jnp.sum(lq2.astype(jnp.float32) * lk2.astype(jnp.float32)))
           + lambda_init)
    qh = q.transpose(0, 2, 1, 3) * (d ** -0.5)
    kh = k.transpose(0, 2, 1, 3)
    vh = v.transpose(0, 2, 1, 3)
    nb = S // Q_BLOCK
    q_blocks = qh.reshape(B, 2 * H, nb, Q_BLOCK, d).transpose(2, 0, 1, 3, 4)
    key_idx = jnp.arange(S)

    def one_block(args):
        qb, bi = args
        s = jnp.einsum('bhqd,bhkd->bhqk', qb, kh).astype(jnp.float32)
        q_idx = bi * Q_BLOCK + jnp.arange(Q_BLOCK)
        mask = key_idx[None, :] <= q_idx[:, None]
        s = jnp.where(mask, s, -jnp.inf)
        p = jax.nn.softmax(s, axis=-1).reshape(B, H, 2, Q_BLOCK, S)
        a = p[:, :, 0] - lam * p[:, :, 1]
        return jnp.einsum('bhqk,bhkv->bhqv', a.astype(vh.dtype), vh)

    o = lax.map(one_block, (q_blocks, jnp.arange(nb)))
    o = o.transpose(1, 0, 3, 2, 4).reshape(B, S, H, 2 * d)
    o = rms_norm(o, subln_w, SUBLN_EPS) * (1.0 - lambda_init)
    return o.reshape(B, S, H * 2 * d)


def chunk_gla(q, k, v, logf):
    B, S, H, K = q.shape
    V = v.shape[-1]
    C = HGRN_CHUNK
    nc = S // C

    def to_chunks(t):
        return t.reshape(B, nc, C, H, t.shape[-1]).transpose(1, 0, 3, 2, 4)

    tri = jnp.tril(jnp.ones((C, C), dtype=bool))

    def step(state, inp):
        qb, kb, vb, gb = inp
        b = jnp.cumsum(gb, axis=2)
        diff = b[:, :, :, None, :] - b[:, :, None, :, :]
        dec = jnp.exp(jnp.where(tri[:, :, None], diff, -jnp.inf))
        attn = jnp.einsum('bhtsk,bhsk->bhts', qb[:, :, :, None, :] * dec, kb)
        o_intra = jnp.einsum('bhts,bhsv->bhtv', attn, vb)
        o_inter = jnp.einsum('bhtk,bhkv->bhtv', qb * jnp.exp(b), state)
        b_last = b[:, :, -1:, :]
        k_dec = kb * jnp.exp(b_last - b)
        new_state = (jnp.exp(b_last[:, :, 0, :])[..., None] * state
                     + jnp.einsum('bhsk,bhsv->bhkv', k_dec, vb))
        return new_state, o_intra + o_inter

    state0 = jnp.zeros((B, H, K, V), jnp.float32)
    _, o = lax.scan(step, state0, (to_chunks(q), to_chunks(k), to_chunks(v), to_chunks(logf)))
    return o.transpose(1, 0, 3, 2, 4).reshape(B, S, H, V)


def hgrn2(q, f, i, g, lb, gnorm_w):
    B, S = q.shape[0], q.shape[1]
    qf = jax.nn.silu(q.astype(jnp.float32))
    forget = lb + (1.0 - lb) * jax.nn.sigmoid(f.astype(jnp.float32))
    k_in = 1.0 - forget
    logf = jnp.log(forget)
    o = chunk_gla(qf, k_in, i.astype(jnp.float32), logf)
    o = rms_norm(o, gnorm_w, RMS_EPS) * jax.nn.silu(g.astype(jnp.float32))
    return o.reshape(B, S, N_HGRN_HEADS * HGRN_V_DIM).astype(q.dtype)


def token_mix(h, positions, w_in, lq1, lk1, lq2, lk2, subln_w, lb, gnorm_w, w_out, layer_idx):
    B, S, _ = h.shape
    proj = h @ w_in
    parts = []
    start = 0
    for size in PROJ_SIZES:
        parts.append(proj[..., start:start + size])
        start += size
    dq, dk, dv, hq, hf, hi, hg = parts
    lambda_init = 0.8 - 0.6 * math.exp(-0.3 * layer_idx)
    a = diff_attention(
        dq.reshape(B, S, 2 * N_DIFF_HEADS, DIFF_HEAD_DIM),
        dk.reshape(B, S, 2 * N_DIFF_HEADS, DIFF_HEAD_DIM),
        dv.reshape(B, S, N_DIFF_HEADS, DIFF_V_DIM),
        positions, lq1, lk1, lq2, lk2, subln_w, lambda_init)
    r = hgrn2(
        hq.reshape(B, S, N_HGRN_HEADS, HGRN_EXPAND),
        hf.reshape(B, S, N_HGRN_HEADS, HGRN_EXPAND),
        hi.reshape(B, S, N_HGRN_HEADS, HGRN_V_DIM),
        hg.reshape(B, S, N_HGRN_HEADS, HGRN_V_DIM),
        lb.reshape(N_HGRN_HEADS, HGRN_EXPAND), gnorm_w)
    mixed = jnp.concatenate([a.astype(h.dtype), r.astype(h.dtype)], axis=-1)
    return mixed @ w_out


def hier_moe(h, w_gr, b_gr, w_er, b_er, w_gate, w_up, w_down):
    B, S, D = h.shape
    N = B * S
    t = h.reshape(N, D)
    g_logits = (t @ w_gr).astype(jnp.float32) + b_gr.astype(jnp.float32)
    g_prob = jax.nn.softmax(g_logits, axis=-1)
    g_sel = jnp.argmax(g_logits, axis=-1)
    p_g = jnp.take_along_axis(g_prob, g_sel[:, None], axis=-1)[:, 0]
    e_logits = ((t @ w_er).astype(jnp.float32).reshape(N, N_GROUPS, EXPERTS_PER_GROUP)
                + b_er.astype(jnp.float32))
    e_in = jnp.take_along_axis(e_logits, g_sel[:, None, None], axis=1)[:, 0]
    top_v, top_i = lax.top_k(e_in, TOP_K)
    weight = p_g[:, None] * jax.nn.softmax(top_v, axis=-1)
    flat_idx = g_sel[:, None] * EXPERTS_PER_GROUP + top_i
    comb = jnp.einsum('nk,nke->ne', weight,
                      jax.nn.one_hot(flat_idx, N_GROUPS * EXPERTS_PER_GROUP, dtype=jnp.float32))
    comb = comb.reshape(N, N_GROUPS, EXPERTS_PER_GROUP).astype(t.dtype)
    y = jnp.zeros((N, D), jnp.float32)
    for gi in range(N_GROUPS):
        a = jnp.einsum('nd,edf->nef', t, w_gate[gi])
        u = jnp.einsum('nd,edf->nef', t, w_up[gi])
        hid = jax.nn.silu(a) * u * comb[:, gi, :, None]
        y = y + jnp.einsum('nef,efd->nd', hid, w_down[gi]).astype(jnp.float32)
    return y.astype(h.dtype).reshape(B, S, D)


def setup_inputs(seed: int = 0) -> dict:
    key = jax.random.key(seed)
    ks = jax.random.split(key, 24)
    f32 = jnp.float32

    def nrm(k, shape, scale):
        return jax.random.normal(k, shape, f32) * scale

    G, E, F = N_GROUPS, EXPERTS_PER_GROUP, D_EXPERT
    positions = (jnp.arange(SEQ, dtype=jnp.int32)[None, :]
                 + jax.random.randint(ks[2], (BATCH, 1), 0, MAX_POS_OFFSET, dtype=jnp.int32))
    return {
        "x": nrm(ks[0], (BATCH, SEQ, D_MODEL), 1.0),
        "c": nrm(ks[1], (BATCH, D_MODEL), 1.0),
        "positions": positions,
        "w_ada": nrm(ks[3], (DEPTH, D_MODEL, 6 * D_MODEL), 0.5 * D_MODEL ** -0.5),
        "b_ada": nrm(ks[4], (DEPTH, 6 * D_MODEL), 0.02),
        "norm1_w": 1.0 + nrm(ks[5], (DEPTH, D_MODEL), 0.02),
        "w_in": nrm(ks[6], (DEPTH, D_MODEL, D_IN_PROJ), D_MODEL ** -0.5),
        "lambda_q1": nrm(ks[7], (DEPTH, DIFF_HEAD_DIM), 0.1),
        "lambda_k1": nrm(ks[8], (DEPTH, DIFF_HEAD_DIM), 0.1),
        "lambda_q2": nrm(ks[9], (DEPTH, DIFF_HEAD_DIM), 0.1),
        "lambda_k2": nrm(ks[10], (DEPTH, DIFF_HEAD_DIM), 0.1),
        "subln_w": 1.0 + nrm(ks[11], (DEPTH, DIFF_V_DIM), 0.02),
        "hgrn_lb_logits": nrm(ks[12], (DEPTH + 1, N_HGRN_HEADS * HGRN_EXPAND), 0.1),
        "gnorm_w": 1.0 + nrm(ks[13], (DEPTH, HGRN_V_DIM), 0.02),
        "w_out": nrm(ks[14], (DEPTH, D_MIX, D_MODEL), D_MIX ** -0.5),
        "norm2_w": 1.0 + nrm(ks[15], (DEPTH, D_MODEL), 0.02),
        "w_group_router": nrm(ks[16], (DEPTH, D_MODEL, G), D_MODEL ** -0.5),
        "b_group_router": nrm(ks[17], (DEPTH, G), 0.01),
        "w_expert_router": nrm(ks[18], (DEPTH, D_MODEL, G * E), D_MODEL ** -0.5),
        "b_expert_router": nrm(ks[19], (DEPTH, G, E), 0.01),
        "w_gate": nrm(ks[20], (DEPTH, G, E, D_MODEL, F), D_MODEL ** -0.5),
        "w_up": nrm(ks[21], (DEPTH, G, E, D_MODEL, F), D_MODEL ** -0.5),
        "w_down": nrm(ks[22], (DEPTH, G, E, F, D_MODEL), F ** -0.5),
        "final_norm_w": 1.0 + nrm(ks[23], (D_MODEL,), 0.02),
    }


def reference(x, c, positions, w_ada, b_ada, norm1_w, w_in, lambda_q1, lambda_k1, lambda_q2,
              lambda_k2, subln_w, hgrn_lb_logits, gnorm_w, w_out, norm2_w, w_group_router,
              b_group_router, w_expert_router, b_expert_router, w_gate, w_up, w_down,
              final_norm_w):
    lb_all = jnp.cumsum(jax.nn.softmax(hgrn_lb_logits.astype(jnp.float32), axis=0), axis=0)
    c_act = jax.nn.silu(c)
    for l in range(DEPTH):
        mod = c_act @ w_ada[l] + b_ada[l]
        sh1, sc1, g1, sh2, sc2, g2 = jnp.split(mod, 6, axis=-1)
        h = rms_norm(x, norm1_w[l], RMS_EPS) * (1.0 + sc1[:, None, :]) + sh1[:, None, :]
        mix = token_mix(h, positions, w_in[l], lambda_q1[l], lambda_k1[l], lambda_q2[l],
                        lambda_k2[l], subln_w[l], lb_all[l], gnorm_w[l], w_out[l], l)
        x = x + g1[:, None, :] * mix
        h = rms_norm(x, norm2_w[l], RMS_EPS) * (1.0 + sc2[:, None, :]) + sh2[:, None, :]
        ffn = hier_moe(h, w_group_router[l], b_group_router[l], w_expert_router[l],
                       b_expert_router[l], w_gate[l], w_up[l], w_down[l])
        x = x + g2[:, None, :] * ffn
    return rms_norm(x, final_norm_w, RMS_EPS)
```

```cpp
#include <hip/hip_runtime.h>
#include <hip/hip_bf16.h>
#include <cstdio>
#include <cstdint>
#include <cmath>
namespace pg8 {
#define PG8_LAS __attribute__((address_space(3)))
typedef unsigned short bf16_t;
typedef short bf16x8 __attribute__((ext_vector_type(8)));
typedef float f32x4 __attribute__((ext_vector_type(4)));
typedef unsigned u32x4 __attribute__((ext_vector_type(4)));
constexpr int BM = 256, BK = 64, HALF = 128, HTB = HALF * BK * 2  , STAGE_BYTES = 8 * HTB, NXCD = 8, WGM = 8;
__host__ __device__ __forceinline__ int lds_byte(int r, int c) { const int st = (r >> 4) * 2 + (c >> 5), rr = r & 15, cc = c & 31, ob = rr * 64 + cc * 2; return st * 1024 + (ob ^ (((ob >> 9) & 1) << 5)); }
__host__ __device__ __forceinline__ void stage_rc(int b, int& R, int& C) { const int st = b / 1024, sb = b % 1024, swz = sb ^ (((sb >> 9) & 1) << 5); R = (st >> 1) * 16 + swz / 64; C = (st & 1) * 32 + (swz % 64) / 2; }
struct Unit { int pm, pn; const char* A; const char* B; const int* gidx; int rows; int e; int base; };
__device__ __forceinline__ unsigned cvt_pk_bf16(float lo, float hi) { unsigned r; asm volatile("v_cvt_pk_bf16_f32 %0, %1, %2" : "=v"(r) : "v"(lo), "v"(hi)); return r; }
template <class Epi, class Sched, bool GATHER, bool ALIGN_EPI>
__device__ __forceinline__ void gemm_phase(PG8_LAS unsigned char* lds, const int K, const Sched& S, const Epi& E) {
    constexpr bool SP2 = true;
    const int tid = threadIdx.x, wid = __builtin_amdgcn_readfirstlane(tid >> 6), lane = tid & 63, wr = wid >> 2, wc = wid & 3, fr = lane & 15, fq = lane >> 4;
    const int nt = K / BK;
    unsigned voffB[2]; int RA[2], CA[2];
#pragma unroll
    for (int i = 0; i < 2; ++i) { int R, C; stage_rc(tid * 16 + i * 8192, R, C); RA[i] = R; CA[i] = C; voffB[i] = (unsigned)(R * K + C) * 2u; }
#define PG8_SETVOFF(dst, u) do { _Pragma("unroll") for (int _h = 0; _h < 2; ++_h) _Pragma("unroll") for (int _i = 0; _i < 2; ++_i) { int _r = _h * HALF + RA[_i]; \
        if constexpr (GATHER) { _r = _r < (u).rows ? _r : (u).rows - 1; _r = (u).gidx[_r] >> 1; } \
        dst[_h][_i] = (unsigned)(_r * K + CA[_i]) * 2u; } } while (0)
    const size_t kstep = (size_t)(BK * 2);
    const size_t hstep = (size_t)HALF * K * 2;
    const unsigned ldsw = (unsigned)wid * 1024u;
    const int aoff = lds_byte(wr * 64 + fr, fq * 8), boff = lds_byte(wc * 32 + fr, fq * 8);
#define PG8_SA(b, h) (((b) * 2 + (h)) * HTB)
#define PG8_SB(b, h) ((4 + (b) * 2 + (h)) * HTB)
#define PG8_STAGE(bufoff, gbase, voff) do { _Pragma("unroll") for (int _i = 0; _i < 2; ++_i) \
        __builtin_amdgcn_global_load_lds((const unsigned*)((const char*)(gbase) + (voff)[_i]), (PG8_LAS unsigned*)(lds + (bufoff) + ldsw + _i * 8192), 16, 0, 0); } while (0)
#define PG8_STAGEA(bufoff, gbase, h) PG8_STAGE(bufoff, gbase, vA[h])
#define PG8_LDA(dst, b, h) do { _Pragma("unroll") for (int m = 0; m < 4; ++m) _Pragma("unroll") for (int k = 0; k < 2; ++k) dst[m][k] = *(const PG8_LAS bf16x8*)(lds + PG8_SA(b, h) + aoff + m * 2048 + k * 1024); } while (0)
#define PG8_LDB(dst, b, h) do { _Pragma("unroll") for (int n = 0; n < 2; ++n) _Pragma("unroll") for (int k = 0; k < 2; ++k) dst[n][k] = *(const PG8_LAS bf16x8*)(lds + PG8_SB(b, h) + boff + n * 2048 + k * 1024); } while (0)
#define PG8_MMA(ai, bj, At, Bt) do { __builtin_amdgcn_s_setprio(1); _Pragma("unroll") for (int m = 0; m < 4; ++m) _Pragma("unroll") for (int n = 0; n < 2; ++n) _Pragma("unroll") for (int k = 0; k < 2; ++k) \
        acc[ai][bj][m][n] = __builtin_amdgcn_mfma_f32_16x16x32_bf16(Bt[n][k], At[m][k], acc[ai][bj][m][n], 0, 0, 0); __builtin_amdgcn_s_setprio(0); } while (0)
#define PG8_WAIT_V(n) asm volatile("s_waitcnt vmcnt(" #n ")" ::: "memory")
#define PG8_WAIT_L(n) asm volatile("s_waitcnt lgkmcnt(" #n ")" ::: "memory")
#define PG8_BAR __builtin_amdgcn_s_barrier()
#define PG8_SCHED __builtin_amdgcn_sched_barrier(0)
    Unit cur, nxt; int ui = 0;
    if (!S.next(0, cur)) return;
    f32x4 acc[2][2][4][2];
#pragma unroll
    for (int a = 0; a < 2; ++a)
#pragma unroll
        for (int b = 0; b < 2; ++b)
#pragma unroll
            for (int m = 0; m < 4; ++m)
#pragma unroll
                for (int n = 0; n < 2; ++n) acc[a][b][m][n] = (f32x4){0.f, 0.f, 0.f, 0.f};
    bf16x8 At[4][2], B0[2][2], B1[2][2];
    const char* cA = cur.A; const char* cB = cur.B;
    unsigned vA[2][2], vN[2][2];
    PG8_SETVOFF(vA, cur);
    if constexpr (SP2) {
        PG8_STAGE(PG8_SB(0, 0), cB, voffB); PG8_STAGE(PG8_SB(0, 1), cB + hstep, voffB); PG8_STAGEA(PG8_SA(0, 0), cA, 0); PG8_STAGEA(PG8_SA(0, 1), cA, 1);
        if (wr == 1) PG8_BAR;
        PG8_WAIT_V(2); PG8_BAR;
        PG8_STAGE(PG8_SB(1, 0), cB + kstep, voffB); PG8_STAGEA(PG8_SA(1, 0), cA + kstep, 0); PG8_STAGE(PG8_SB(1, 1), cB + hstep + kstep, voffB);
        PG8_WAIT_V(6); PG8_BAR;
    }
    for (;;) {
        const bool has_next = S.next(ui + 1, nxt);
        const char* nA = has_next ? nxt.A : cA; const char* nB = has_next ? nxt.B : cB;
        for (int t = 0; t < nt; t += 2) {
            const bool last = (t == nt - 2);
            const char* a1 = cA + (size_t)(t + 1) * kstep;
            const char* a2 = last ? nA : cA + (size_t)(t + 2) * kstep; const char* b2 = last ? nB : cB + (size_t)(t + 2) * kstep;
            const char* a3 = a2 + kstep; const char* b3 = b2 + kstep;
            if (last) { if (has_next) { PG8_SETVOFF(vN, nxt); } else { _Pragma("unroll") for (int _h = 0; _h < 2; ++_h) _Pragma("unroll") for (int _i = 0; _i < 2; ++_i) vN[_h][_i] = vA[_h][_i]; } }
            if constexpr (SP2) {
            PG8_LDB(B0, 0, 0); PG8_LDB(B1, 0, 1); PG8_SCHED; PG8_LDA(At, 0, 0); PG8_STAGEA(PG8_SA(1, 1), a1, 1);
            if (last) { _Pragma("unroll") for (int _h = 0; _h < 2; ++_h) _Pragma("unroll") for (int _i = 0; _i < 2; ++_i) vA[_h][_i] = vN[_h][_i]; }
            PG8_WAIT_V(8); PG8_WAIT_L(0); PG8_BAR; PG8_MMA(0, 0, At, B0); PG8_MMA(0, 1, At, B1); PG8_BAR; PG8_SCHED;
            PG8_LDA(At, 0, 1); PG8_STAGE(PG8_SB(0, 0), b2, voffB); PG8_STAGE(PG8_SB(0, 1), b2 + hstep, voffB); PG8_STAGEA(PG8_SA(0, 0), a2, 0);
            PG8_WAIT_V(8); PG8_WAIT_L(0); PG8_BAR; PG8_MMA(1, 0, At, B0); PG8_MMA(1, 1, At, B1); PG8_BAR; PG8_SCHED;
            PG8_LDB(B0, 1, 0); PG8_LDB(B1, 1, 1); PG8_SCHED; PG8_LDA(At, 1, 0); PG8_STAGEA(PG8_SA(0, 1), a2, 1);
            PG8_WAIT_V(8); PG8_WAIT_L(0); PG8_BAR; PG8_MMA(0, 0, At, B0); PG8_MMA(0, 1, At, B1); PG8_BAR; PG8_SCHED;
            PG8_LDA(At, 1, 1); PG8_STAGE(PG8_SB(1, 0), b3, voffB); PG8_STAGE(PG8_SB(1, 1), b3 + hstep, voffB); PG8_STAGEA(PG8_SA(1, 0), a3, 0);
            PG8_WAIT_V(8); PG8_WAIT_L(0); PG8_BAR; PG8_MMA(1, 0, At, B0); PG8_MMA(1, 1, At, B1); PG8_BAR; PG8_SCHED;
            }
        }
        if constexpr (ALIGN_EPI) { if (wr == 0) PG8_BAR; }
        E(acc, cur, wr, wc, fr, fq);
        if (!has_next) break;
#pragma unroll
        for (int a = 0; a < 2; ++a)
#pragma unroll
            for (int b = 0; b < 2; ++b)
#pragma unroll
                for (int m = 0; m < 4; ++m)
#pragma unroll
                    for (int n = 0; n < 2; ++n) acc[a][b][m][n] = (f32x4){0.f, 0.f, 0.f, 0.f};
        cur = nxt; cA = nA; cB = nB; ++ui;
        if constexpr (ALIGN_EPI) { if (wr == 1) PG8_BAR; }
    }
    PG8_WAIT_V(0);
    if constexpr (!ALIGN_EPI) { if (wr == 0) PG8_BAR; }
    PG8_BAR;
#undef PG8_SA
#undef PG8_SB
#undef PG8_STAGE
#undef PG8_STAGEA
#undef PG8_SETVOFF
#undef PG8_LDA
#undef PG8_LDB
#undef PG8_MMA
#undef PG8_WAIT_V
#undef PG8_WAIT_L
#undef PG8_BAR
#undef PG8_SCHED
}
}
#include <hip/hip_bf16.h>
#include <cmath>
namespace attn_body {
using bf16=__hip_bfloat16;
using bf16x8=__attribute__((ext_vector_type(8)))short;
using s16x4=__attribute__((ext_vector_type(4)))short;
using f32x16=__attribute__((ext_vector_type(16)))float;
using u32x4=__attribute__((ext_vector_type(4)))unsigned;
constexpr int SEQ=2048,D=64,QKP=512,VP=512,OP=1024;
constexpr int NW=8,QBLK=32,QB=QBLK*NW,KVBLK=64,NQB=SEQ/QB;
constexpr int ATTN_UNIT_ROWS=QB;
__device__ __forceinline__ int crow(int r,int hi){return (r&3)+8*(r>>2)+4*hi;}
#define SBAR() __builtin_amdgcn_sched_barrier(0)
__device__ __forceinline__ void cmask(f32x16&p0,f32x16&p1,int jb,int qrel,int hi){
  const float NEG=-INFINITY; int kb=64*jb+4*hi;
  #pragma unroll
  for(int r=0;r<16;++r){int kv=kb+(r&3)+8*(r>>2); if(kv>qrel)p0[r]=NEG; if(kv+32>qrel)p1[r]=NEG;}
}

constexpr int NSLOT=3, SLOTB=8192;
constexpr int LDS_K=0, LDS_V=NSLOT*SLOTB, LDS_WS=2*NSLOT*SLOTB, LDS_OST=LDS_WS+NW*64*4, LDS_BYTES=LDS_OST+NW*4096;
constexpr float C2=0.125f*1.4426950408889634f;
__device__ __forceinline__ void glds16(const void*gsrc,unsigned lds_dst){unsigned keep;
  asm volatile("s_mov_b32 %0, m0\n\ts_mov_b32 m0, %2\n\ts_nop 0\n\tglobal_load_lds_dwordx4 %1, off\n\ts_mov_b32 m0, %0":"=&s"(keep):"v"(gsrc),"s"(lds_dst):"memory");}
__device__ __forceinline__ float max3f(float a,float b,float c){float r;asm("v_max3_f32 %0, %1, %2, %3":"=v"(r):"v"(a),"v"(b),"v"(c));return r;}
__device__ __forceinline__ float max2f(float a,float b){float r;asm("v_max_f32_e32 %0, %1, %2":"=v"(r):"v"(a),"v"(b));return r;}
__device__ __forceinline__ float fadd_s(float a,float b){float r;asm("v_add_f32_e32 %0, %1, %2":"=v"(r):"v"(a),"v"(b));return r;}
__device__ __forceinline__ float fsub_s(float a,float b){float r;asm("v_sub_f32_e32 %0, %1, %2":"=v"(r):"v"(a),"v"(b));return r;}
typedef float f32x2_t __attribute__((ext_vector_type(2))); typedef __bf16 bf16x2_t __attribute__((ext_vector_type(2)));
__device__ __forceinline__ unsigned cvtpk_s(float lo,float hi){f32x2_t v={lo,hi};bf16x2_t b=__builtin_convertvector(v,bf16x2_t);return __builtin_bit_cast(unsigned,b);}
#define WAIT_BAR(N) asm volatile("s_waitcnt vmcnt(" #N ") lgkmcnt(0)\n\ts_barrier":::"memory")

__device__ __forceinline__ void qkt(f32x16&p0,f32x16&p1,const char*Kslot,const bf16x8*qr,const f32x16&negm,int r32,int hi){
  const char*kb=Kslot+hi*1024+r32*16;
  #pragma unroll
  for(int d0=0;d0<4;++d0){
    const bf16x8 b0=*reinterpret_cast<const bf16x8*>(kb+d0*2048);
    const bf16x8 b1=*reinterpret_cast<const bf16x8*>(kb+d0*2048+512);
    if(d0==0){p0=__builtin_amdgcn_mfma_f32_32x32x16_bf16(b0,qr[0],negm,0,0,0);p1=__builtin_amdgcn_mfma_f32_32x32x16_bf16(b1,qr[0],negm,0,0,0);}
    else{p0=__builtin_amdgcn_mfma_f32_32x32x16_bf16(b0,qr[d0],p0,0,0,0);p1=__builtin_amdgcn_mfma_f32_32x32x16_bf16(b1,qr[d0],p1,0,0,0);}}
}
typedef __attribute__((address_space(3))) const char* lds_cptr;
typedef short v4i16_t __attribute__((ext_vector_type(4)));
__device__ __forceinline__ void kload8(bf16x8*kf,lds_cptr kp){
  kf[0]=*(const __attribute__((address_space(3))) bf16x8*)(kp);      kf[1]=*(const __attribute__((address_space(3))) bf16x8*)(kp+512);
  kf[2]=*(const __attribute__((address_space(3))) bf16x8*)(kp+2048); kf[3]=*(const __attribute__((address_space(3))) bf16x8*)(kp+2560);
  kf[4]=*(const __attribute__((address_space(3))) bf16x8*)(kp+4096); kf[5]=*(const __attribute__((address_space(3))) bf16x8*)(kp+4608);
  kf[6]=*(const __attribute__((address_space(3))) bf16x8*)(kp+6144); kf[7]=*(const __attribute__((address_space(3))) bf16x8*)(kp+6656);
}
__device__ __forceinline__ void kload2(bf16x8*kf,lds_cptr kp,int j){ kf[2*j]=*(const __attribute__((address_space(3))) bf16x8*)(kp+j*2048); kf[2*j+1]=*(const __attribute__((address_space(3))) bf16x8*)(kp+j*2048+512); }
__device__ __forceinline__ s16x4 vtr(lds_cptr p){ return __builtin_bit_cast(s16x4,__builtin_amdgcn_ds_read_tr16_b64_v4i16((__attribute__((address_space(3))) v4i16_t*)p)); }
__device__ __forceinline__ float rowmax(const f32x16&p0,const f32x16&p1){
  float a=max3f(p0[0],p0[1],p1[0]),b=max3f(p0[2],p0[3],p1[1]);a=max3f(a,p1[2],p1[3]);
  #pragma unroll
  for(int r=4;r<16;r+=4){a=max3f(a,p0[r],p0[r+1]);b=max3f(b,p0[r+2],p0[r+3]);a=max3f(a,p1[r],p1[r+1]);b=max3f(b,p1[r+2],p1[r+3]);}
  const float m=max2f(a,b);
  auto rr=__builtin_amdgcn_permlane32_swap(__float_as_uint(m),__float_as_uint(m),false,false);
  return max2f(__uint_as_float(rr[0]),__uint_as_float(rr[1]));
}
__device__ __forceinline__ void pv(f32x16*o,int vb,bf16x8 pa0,bf16x8 pa1,bf16x8 pa2,bf16x8 pa3){
  #pragma unroll
  for(int d0=0;d0<2;++d0){s16x4 lo[4],hi[4];
    #pragma unroll
    for(int ks=0;ks<4;++ks){
      asm volatile("ds_read_b64_tr_b16 %0,%1 offset:%c2":"=&v"(lo[ks]):"v"(vb),"i"(d0*4096+ks*1024):"memory");
      asm volatile("ds_read_b64_tr_b16 %0,%1 offset:%c2":"=&v"(hi[ks]):"v"(vb),"i"(d0*4096+ks*1024+512):"memory");}
    asm volatile("s_waitcnt lgkmcnt(0)":::"memory");SBAR();
    #define PK(k) (bf16x8){lo[k][0],lo[k][1],lo[k][2],lo[k][3],hi[k][0],hi[k][1],hi[k][2],hi[k][3]}
    o[d0]=__builtin_amdgcn_mfma_f32_32x32x16_bf16(pa0,PK(0),o[d0],0,0,0);
    o[d0]=__builtin_amdgcn_mfma_f32_32x32x16_bf16(pa1,PK(1),o[d0],0,0,0);
    o[d0]=__builtin_amdgcn_mfma_f32_32x32x16_bf16(pa2,PK(2),o[d0],0,0,0);
    o[d0]=__builtin_amdgcn_mfma_f32_32x32x16_bf16(pa3,PK(3),o[d0],0,0,0);
    #undef PK
  }
}

#ifndef ATTN_STORE16
#define ATTN_STORE16(p,v) (*(u32x4*)(p)=(v))
#endif
template<int THRL> __device__ __forceinline__ void attn_unit(int b,int qcol,int vcol,int ocol,int qb,const bf16*Q,const bf16*__restrict__ K,const bf16*__restrict__ V,bf16*O,char*shm){
  const int tid=threadIdx.x,lane=tid&63,r32=lane&31,hi=lane>>5; const int wid=__builtin_amdgcn_readfirstlane(tid>>6);
  const long rowbase=(long)b*SEQ; const int q0=qb*QB;
  const bf16*Qw=Q+(rowbase+q0+wid*QBLK)*QKP+qcol;
  const bf16*Kh=K+rowbase*QKP+qcol,*Vh=V+rowbase*VP+vcol;
  const unsigned lds0=(unsigned)(uintptr_t)shm;
  float*wsf=(float*)(shm+LDS_WS)+wid*64;
  const bf16*ksrc=Kh+(long)lane*QKP+wid*8;
  const bf16*vsrc=Vh+(long)(16*(wid&3)+(lane>>2))*VP+(wid>>2)*32+(lane&3)*8;
  const unsigned kdst=lds0+LDS_K+wid*1024, vdst=lds0+LDS_V+wid*1024;
  #define DMA_K(t,slot) glds16(ksrc+(long)(t)*KVBLK*QKP,(unsigned)__builtin_amdgcn_readfirstlane(kdst+(slot)))
  #define DMA_V(t,slot) glds16(vsrc+(long)(t)*KVBLK*VP,(unsigned)__builtin_amdgcn_readfirstlane(vdst+(slot)))
  const int vb0=(int)(lds0+LDS_V)+((lane>>4)&1)*32+(lane&3)*8+(4*hi+((lane&15)>>2))*64;
  const char*Kbase=shm+LDS_K; bf16x8 kf[8];
  const lds_cptr shm3=(lds_cptr)shm; const lds_cptr kp0=shm3+LDS_K+hi*1024+r32*16; const lds_cptr vp0=shm3+LDS_V+((lane>>4)&1)*32+(lane&3)*8+(4*hi+((lane&15)>>2))*64;
  const int NT=(q0+QB)/KVBLK;
  DMA_K(0,0);DMA_V(0,0);DMA_K(1,SLOTB);
  bf16x8 qr[4];
  #pragma unroll
  for(int d0=0;d0<4;++d0)qr[d0]=*reinterpret_cast<const bf16x8*>(&Qw[(long)r32*QKP+d0*16+hi*8]);
  float mhat=0.f,l_reg=0.f;f32x16 o[2];o[0]=f32x16{};o[1]=f32x16{};f32x16 negm=f32x16{};asm volatile("":"+v"(negm));
  const int qrel=wid*QBLK+r32;
  #define CMASK(P0,P1,t) do{int jb_=(t)-(NT-4); if(jb_>=0)cmask(P0,P1,jb_,qrel,hi);}while(0)
  bool resc=false;
  #define START(P0,P1) do{ const float rm=rowmax(P0,P1); resc=false; \
    { const float dl=rm; mhat=fadd_s(mhat,dl); \
      _Pragma("unroll") for(int r=0;r<16;++r){P0[r]=fsub_s(P0[r],dl);P1[r]=fsub_s(P1[r],dl);} \
      _Pragma("unroll") for(int r=0;r<16;++r)negm[r]=-mhat; asm volatile("":"+v"(negm)); } \
    _Pragma("unroll") for(int r=0;r<16;++r)P0[r]=__builtin_amdgcn_exp2f(P0[r]); }while(0)
  #define RESC() do{ if(resc){ asm volatile("s_waitcnt lgkmcnt(0)":::"memory"); \
      _Pragma("unroll") for(int d_=0;d_<2;++d_) _Pragma("unroll") for(int r=0;r<16;++r)o[d_][r]*=wsf[crow(r,hi)]; } }while(0)
  f32x16 pA0,pA1,pB0,pB1;
  int sl_prev=0,sl_cur=0,sl_next=SLOTB;
  #define ROT() do{sl_prev=sl_cur;sl_cur=sl_next;sl_next=(sl_next==(NSLOT-1)*SLOTB)?0:sl_next+SLOTB;}while(0)
  DMA_K(2,2*SLOTB);
  WAIT_BAR(3);
  qkt(pA0,pA1,Kbase,qr,negm,r32,hi);asm volatile("s_nop 15\n\ts_nop 7":"+v"(pA0),"+v"(pA1));CMASK(pA0,pA1,0);
  START(pA0,pA1);
  _Pragma("unroll") for(int r=0;r<16;++r)pA1[r]=__builtin_amdgcn_exp2f(pA1[r]);
  WAIT_BAR(0);
  DMA_K(3,0);DMA_V(1,SLOTB);
  ROT();
  kload8(kf,kp0+sl_cur);
  WAIT_BAR(2);
  s16x4 vlo[8],vhi[8]; u32x4 pw0,pw1,pw2,pw3;
  #define PKW(P,B) cvtpk_s(P[B],P[B+1])
  #define PAF(k) __builtin_bit_cast(bf16x8,pw##k)
  #define VFR(i) (bf16x8){vlo[i][0],vlo[i][1],vlo[i][2],vlo[i][3],vhi[i][0],vhi[i][1],vhi[i][2],vhi[i][3]}
  #define PIN(x) asm volatile("":"+v"(x))
  #define MX3(a,b,c) __builtin_fmaxf(__builtin_fmaxf((a),(b)),(c))
  #define GAPA(MF,A0,A1,A2,A3,W0,W1,PW) do{ MF; sacc+=A0; sacc+=A1; sacc+=A2; sacc+=A3; PIN(sacc); W0; W1; PIN(PW); SBAR(); }while(0)
  #define EX(v) __builtin_amdgcn_exp2f(v)
  #define GAPB(MF,X,B) do{ MF; X[B]=EX(X[B]); X[B+1]=EX(X[B+1]); X[B+2]=EX(X[B+2]); X[B+3]=EX(X[B+3]); PIN(X); SBAR(); }while(0)
  #define VRD(i) do{ vlo[i]=vtr(vp_+(((i)>>2)*4096+((i)&3)*1024)); vhi[i]=vtr(vp_+(((i)>>2)*4096+((i)&3)*1024+512)); }while(0)
  #define KRD(G,j) do{ if(G){ kload2(kf,kp0+sl_next,j); SBAR(); } }while(0)
  #define STEP(C0,C1,P0,P1,t,GK,GV,GL) do{ SBAR(); \
    const lds_cptr vp_=vp0+sl_prev; \
    VRD(0); SBAR(); float sacc=(P0[0]+P0[1]); \
    GAPA(C0=__builtin_amdgcn_mfma_f32_32x32x16_bf16(kf[0],qr[0],negm,0,0,0), P0[2],P0[3],P0[4],P0[5],     pw0[0]=PKW(P0,0), pw0[1]=PKW(P0,2), pw0); \
    VRD(4); SBAR(); GAPA(C1=__builtin_amdgcn_mfma_f32_32x32x16_bf16(kf[1],qr[0],negm,0,0,0), P0[6],P0[7],P0[8],P0[9],     pw0[2]=PKW(P0,4), pw0[3]=PKW(P0,6), pw0); \
    VRD(1); SBAR(); GAPA(C0=__builtin_amdgcn_mfma_f32_32x32x16_bf16(kf[2],qr[1],C0,0,0,0),   P0[10],P0[11],P0[12],P0[13], pw1[0]=PKW(P0,8), pw1[1]=PKW(P0,10), pw1); \
    VRD(5); SBAR(); GAPA(C1=__builtin_amdgcn_mfma_f32_32x32x16_bf16(kf[3],qr[1],C1,0,0,0),   P0[14],P0[15],P1[0],P1[1],   pw1[2]=PKW(P0,12),pw1[3]=PKW(P0,14), pw1); \
    VRD(2); SBAR(); GAPA(C0=__builtin_amdgcn_mfma_f32_32x32x16_bf16(kf[4],qr[2],C0,0,0,0),   P1[2],P1[3],P1[4],P1[5],     pw2[0]=PKW(P1,0), pw2[1]=PKW(P1,2), pw2); \
    VRD(6); SBAR(); GAPA(C1=__builtin_amdgcn_mfma_f32_32x32x16_bf16(kf[5],qr[2],C1,0,0,0),   P1[6],P1[7],P1[8],P1[9],     pw2[2]=PKW(P1,4), pw2[3]=PKW(P1,6), pw2); \
    VRD(3); SBAR(); GAPA(C0=__builtin_amdgcn_mfma_f32_32x32x16_bf16(kf[6],qr[3],C0,0,0,0),   P1[10],P1[11],P1[12],P1[13], pw3[0]=PKW(P1,8), pw3[1]=PKW(P1,10), pw3); \
    VRD(7); SBAR(); GAPA(C1=__builtin_amdgcn_mfma_f32_32x32x16_bf16(kf[7],qr[3],C1,0,0,0),   P1[14],P1[15],0.f,0.f,       pw3[2]=PKW(P1,12),pw3[3]=PKW(P1,14), pw3); \
    l_reg+=sacc; \
    if(GK){DMA_K((t)+3,sl_cur);} if(GV){DMA_V((t)+1,sl_next);} \
    CMASK(C0,C1,t); \
    { float a=MX3(C0[0],C0[1],C1[0]),b=MX3(C0[2],C0[3],C1[1]); a=MX3(a,C1[2],C1[3]); \
      _Pragma("unroll") for(int r=4;r<16;r+=4){a=MX3(a,C0[r],C0[r+1]);b=MX3(b,C0[r+2],C0[r+3]);a=MX3(a,C1[r],C1[r+1]);b=MX3(b,C1[r+2],C1[r+3]);} \
      float rm=__builtin_fmaxf(a,b); { auto rr=__builtin_amdgcn_permlane32_swap(__float_as_uint(rm),__float_as_uint(rm),false,false); rm=__builtin_fmaxf(__uint_as_float(rr[0]),__uint_as_float(rr[1])); } \
      resc=false; \
      if(__builtin_expect(__any(rm>(float)THRL),0)){ const float dl=__builtin_fmaxf(rm,0.f); mhat+=dl; \
        _Pragma("unroll") for(int r=0;r<16;++r){C0[r]-=dl;C1[r]-=dl;} \
        _Pragma("unroll") for(int r=0;r<16;++r)negm[r]=-mhat; asm volatile("":"+v"(negm)); \
        const float f=__builtin_amdgcn_exp2f(-dl); l_reg*=f; if(hi==0)wsf[r32]=f; resc=true; } } \
    SBAR(); \
    GAPB(o[0]=__builtin_amdgcn_mfma_f32_32x32x16_bf16(PAF(0),VFR(0),o[0],0,0,0), C0,0); \
    GAPB(o[1]=__builtin_amdgcn_mfma_f32_32x32x16_bf16(PAF(0),VFR(4),o[1],0,0,0), C0,4); \
    KRD(GL,0); GAPB(o[0]=__builtin_amdgcn_mfma_f32_32x32x16_bf16(PAF(1),VFR(1),o[0],0,0,0), C0,8); \
    KRD(GL,1); GAPB(o[1]=__builtin_amdgcn_mfma_f32_32x32x16_bf16(PAF(1),VFR(5),o[1],0,0,0), C0,12); \
    KRD(GL,2); GAPB(o[0]=__builtin_amdgcn_mfma_f32_32x32x16_bf16(PAF(2),VFR(2),o[0],0,0,0), C1,0); \
    KRD(GL,3); GAPB(o[1]=__builtin_amdgcn_mfma_f32_32x32x16_bf16(PAF(2),VFR(6),o[1],0,0,0), C1,4); \
    GAPB(o[0]=__builtin_amdgcn_mfma_f32_32x32x16_bf16(PAF(3),VFR(3),o[0],0,0,0), C1,8); \
    GAPB(o[1]=__builtin_amdgcn_mfma_f32_32x32x16_bf16(PAF(3),VFR(7),o[1],0,0,0), C1,12); \
    }while(0)
  int t=1;
  #undef CMASK
  #define CMASK(P0,P1,t) do{}while(0)
  for(;t+5<NT;t+=2){
    STEP(pB0,pB1,pA0,pA1,t,true,true,true);     WAIT_BAR(2); RESC(); ROT();
    STEP(pA0,pA1,pB0,pB1,t+1,true,true,true);   WAIT_BAR(2); RESC(); ROT();
  }
  #undef CMASK
  #define CMASK(P0,P1,t) do{int jb_=(t)-(NT-4); if(jb_>=0)cmask(P0,P1,jb_,qrel,hi);}while(0)
  #define ENDW(tt) do{ if((tt)+3<NT){WAIT_BAR(2);} else if((tt)+2<NT){WAIT_BAR(1);} else {WAIT_BAR(0);} }while(0)
  for(;t+1<NT;t+=2){
    STEP(pB0,pB1,pA0,pA1,t,(t+3<NT),(t+1<NT),(t+1<NT));       ENDW(t);   RESC(); ROT();
    STEP(pA0,pA1,pB0,pB1,t+1,(t+4<NT),(t+2<NT),(t+2<NT));     ENDW(t+1); RESC(); ROT();
  }
  STEP(pB0,pB1,pA0,pA1,NT-1,false,false,false); RESC();
  { float sacc=pB0[0]+pB0[1]; _Pragma("unroll") for(int r=2;r<16;++r)sacc+=pB0[r]; _Pragma("unroll") for(int r=0;r<16;++r)sacc+=pB1[r]; l_reg+=sacc;
    pw0=(u32x4){PKW(pB0,0),PKW(pB0,2),PKW(pB0,4),PKW(pB0,6)};pw1=(u32x4){PKW(pB0,8),PKW(pB0,10),PKW(pB0,12),PKW(pB0,14)};pw2=(u32x4){PKW(pB1,0),PKW(pB1,2),PKW(pB1,4),PKW(pB1,6)};pw3=(u32x4){PKW(pB1,8),PKW(pB1,10),PKW(pB1,12),PKW(pB1,14)};
    SBAR(); pv(o,vb0+sl_cur,PAF(0),PAF(1),PAF(2),PAF(3)); }
  #undef PKW
  #undef PAF
  #undef VFR
  #undef PIN
  #undef MX3
  #undef GAPA
  #undef GAPB
  #undef EX
  #undef VRD
  #undef KRD
  #undef STEP
  #undef ENDW
  {auto rr=__builtin_amdgcn_permlane32_swap(__float_as_uint(l_reg),__float_as_uint(l_reg),false,false);l_reg=__uint_as_float(rr[0])+__uint_as_float(rr[1]);}
  if(hi==0)wsf[32+r32]=l_reg;asm volatile("s_waitcnt lgkmcnt(0)":::"memory");
  float rli[16];
  #pragma unroll
  for(int r=0;r<16;++r)rli[r]=__builtin_amdgcn_rcpf(wsf[32+crow(r,hi)]);
  bf16*Ow=O+(rowbase+q0+wid*QBLK)*OP+ocol;
  { bf16*stg=(bf16*)(shm+LDS_OST)+wid*2048;
    #pragma unroll
    for(int r=0;r<16;++r){const int orow=crow(r,hi);
      #pragma unroll
      for(int d0=0;d0<2;++d0)stg[orow*64+d0*32+r32]=__float2bfloat16(o[d0][r]*rli[r]);}
    asm volatile("s_waitcnt lgkmcnt(0)":::"memory");
    #pragma unroll
    for(int i=0;i<4;++i){const int row=i*8+(lane>>3),ch=lane&7; const u32x4 v=*(const u32x4*)(stg+row*64+ch*8); ATTN_STORE16(Ow+(long)row*OP+ch*8,v);} }
  asm volatile("s_waitcnt lgkmcnt(0)\n\ts_barrier":::"memory");
  #undef DMA_K
  #undef DMA_V
  #undef CMASK
  #undef START
  #undef RESC
  #undef ROT
}
constexpr int ATTN_LDS_BYTES=LDS_BYTES;
#undef SBAR
#undef WAIT_BAR
}

#define GAS __attribute__((address_space(1)))
#define LAS __attribute__((address_space(3)))
typedef unsigned short bf16;
typedef unsigned v4u __attribute__((ext_vector_type(4)));
typedef float f32x4 __attribute__((ext_vector_type(4)));
typedef short bf16x8 __attribute__((ext_vector_type(8)));
typedef GAS unsigned gu32;
typedef GAS unsigned long long gu64;
#define RLX_AGENT __ATOMIC_RELAXED, __HIP_MEMORY_SCOPE_AGENT
#define LDS_WAIT() asm volatile("s_waitcnt lgkmcnt(0)" ::: "memory")
#define VM_WAIT() asm volatile("s_waitcnt vmcnt(0)" ::: "memory")
__device__ __forceinline__ unsigned long long rt() { return __builtin_amdgcn_s_memrealtime(); }
__device__ __forceinline__ unsigned f2bf(float f) { unsigned u = __builtin_bit_cast(unsigned, f); return (u + 0x7fffu + ((u >> 16) & 1u)) >> 16; }
__device__ __forceinline__ unsigned pk2(float lo, float hi) { return f2bf(lo) | (f2bf(hi) << 16); }

#define XB_TMO      128
#define XB_XCNT(j)  (256  + 64 * (j))
#define XB_XSUB(j)  (1280 + 64 * (j))
#define XB_XGEN(j)  (2304 + 64 * (j))
#define XB_TOP      3328
#define XB_TOPGEN   3392
#define XCD_BAR_WORDS 3456
#define XB_SPIN_CAP (1u << 18)

__device__ __forceinline__ unsigned xb_ld(unsigned* p)              { return __hip_atomic_load(p, __ATOMIC_RELAXED, __HIP_MEMORY_SCOPE_AGENT); }
__device__ __forceinline__ unsigned xb_add(unsigned* p, unsigned v) { return __hip_atomic_fetch_add(p, v, __ATOMIC_RELAXED, __HIP_MEMORY_SCOPE_AGENT); }
__device__ __forceinline__ unsigned xb_xcc_id() { return (unsigned)__builtin_amdgcn_s_getreg((3 << 11) | 20) & 0xFu; }
#define XB_SPIN(cond, bar) do { unsigned _sp = 0; while (cond) { __builtin_amdgcn_s_sleep(1); \
    if ((++_sp & 255u) == 0u) { if (xb_ld(&(bar)[XB_TMO])) break; if (_sp > XB_SPIN_CAP) { atomicAdd(&(bar)[XB_TMO], 1u); break; } } } } while (0)

struct XcdBarrier {
    unsigned* bar; unsigned x;
    volatile LAS unsigned* st;
};

__device__ __forceinline__ XcdBarrier xcd_barrier_post(unsigned* bar, volatile LAS unsigned* st) {
    XcdBarrier b; b.bar = bar; b.x = xb_xcc_id(); b.st = st;
    if (threadIdx.x == 0) (void)xb_add(&bar[XB_XCNT(b.x)], 1u);
    return b;
}
__device__ __forceinline__ void xcd_barrier_complete(unsigned* bar, unsigned x, unsigned& nloc, unsigned& nx) {
    const unsigned G = gridDim.x * gridDim.y * gridDim.z;
    unsigned sum, cnt, mine, sp = 0u;
    for (;;) {
        sum = 0u; cnt = 0u; mine = 0u;
#pragma unroll
        for (unsigned j = 0; j < 16; ++j) { const unsigned c = xb_ld(&bar[XB_XCNT(j)]); sum += c; cnt += (c > 0u) ? 1u : 0u; mine = (j == x) ? c : mine; }
        if (sum == G) break;
        __builtin_amdgcn_s_sleep(1);
        if ((++sp & 255u) == 0u) { if (xb_ld(&bar[XB_TMO])) break; if (sp > XB_SPIN_CAP) { atomicAdd(&bar[XB_TMO], 1u); break; } }
    }
    nloc = mine > 0u ? mine : 1u; nx = cnt > 0u ? cnt : 1u;
}

__device__ __forceinline__ void xcd_barrier(const XcdBarrier& b) {
    asm volatile("s_waitcnt vmcnt(0)" ::: "memory");
    __syncthreads();
    if (threadIdx.x == 0) {
        unsigned* bar = b.bar;
        __builtin_amdgcn_s_waitcnt(0);
        unsigned nloc = b.st[0], nx = b.st[1];
        if (nloc == 0u) { xcd_barrier_complete(bar, b.x, nloc, nx); b.st[0] = nloc; b.st[1] = nx; }
        const unsigned old = xb_add(&bar[XB_XSUB(b.x)], 1u);
        const unsigned gen = old / nloc;
        if (old + 1u == (gen + 1u) * nloc) {
            __builtin_amdgcn_fence(__ATOMIC_RELEASE, "agent");
            asm volatile("s_waitcnt vmcnt(0)" ::: "memory");
            const unsigned og = xb_add(&bar[XB_TOP], 1u);
            const unsigned tg = og / nx;
            if (og + 1u == (tg + 1u) * nx) xb_add(&bar[XB_TOPGEN], 1u);
            else XB_SPIN(xb_ld(&bar[XB_TOPGEN]) == tg, bar);
            __builtin_amdgcn_fence(__ATOMIC_ACQUIRE, "agent");
            xb_add(&bar[XB_XGEN(b.x)], 1u);
            asm volatile("s_waitcnt vmcnt(0)" ::: "memory");
        } else {
            XB_SPIN(xb_ld(&bar[XB_XGEN(b.x)]) == gen, bar);
            __builtin_amdgcn_fence(__ATOMIC_ACQUIRE, "agent");
            asm volatile("s_waitcnt vmcnt(0)" ::: "memory");
        }
    }
    __syncthreads();
}

constexpr int NWAVES = 8;
constexpr int D = 1024, NB = 8, SEQ = 2048, M = NB * SEQ, NPROJ = 3584, NE = 32, FF = 512, NCH = SEQ / 64, NMOD = 6 * D;
constexpr int LCAP = 16384;
constexpr float RMS_EPS = 1e-6f, SUBLN_EPS = 1e-5f, LAMBDA_INIT = 0.2f;
#ifndef MK_N_LAUNCHES
#define MK_N_LAUNCHES 1
#endif
constexpr int NPH = 11;
constexpr size_t MiB = 1u << 20;
constexpr size_t WS_CTL = 0, CTL_ZERO_BYTES = 1 * MiB;
constexpr size_t WS_MOD = 1 * MiB;
constexpr size_t WS_EL = 1 * MiB + 512 * 1024;
constexpr size_t WS_ELIST = 2 * MiB, WS_WLIST = 4 * MiB;
constexpr size_t WS_WIN = 6 * MiB;
constexpr size_t WS_WOUT = 13 * MiB;
constexpr size_t WS_WGU = 16 * MiB;
constexpr size_t WS_UST = 16 * MiB;
constexpr size_t WS_WD = 80 * MiB;
constexpr size_t WS_MIXED = 80 * MiB;
constexpr size_t WS_RA = 112 * MiB;
constexpr size_t WS_Q = 144 * MiB, WS_K = 160 * MiB, WS_V = 176 * MiB, WS_QP = 192 * MiB, WS_KP = 208 * MiB, WS_VI = 224 * MiB, WS_SG = 240 * MiB;
constexpr size_t WS_PART = 144 * MiB;
constexpr size_t WS_HID = 208 * MiB;
constexpr size_t WS_END = 256 * MiB;
constexpr int CW_BAR = 4096;
constexpr int CW_CNT = 8192;
constexpr int RING_BYTES = 131072;
constexpr int LDSCTL_OFF = 147456;
constexpr int MISC_OFF = LDSCTL_OFF + 320;
constexpr int SCHED_OFF = LDSCTL_OFF + 1024;
constexpr int LDS_BYTES = 163840;

typedef unsigned u32x2v __attribute__((ext_vector_type(2)));
__device__ __forceinline__ float wave_sum(float v) {
#pragma unroll
    for (int o = 1; o < 64; o <<= 1) v += __shfl_xor(v, o);
    return v;
}
__device__ __forceinline__ float bf_lo(unsigned w) { return __uint_as_float(w << 16); }
__device__ __forceinline__ float bf_hi(unsigned w) { return __uint_as_float(w & 0xffff0000u); }
__device__ __forceinline__ float sigmoidf_(float x) { return 1.f / (1.f + __expf(-x)); }

struct Args { const float* in[24]; float* out; unsigned char* ws; int ph_lo, ph_hi; };

struct DenseOrder {
    int nM, nN, nwg, G, c; const char* Abase; const char* Bbase; size_t tstep; int pn_off, pn_cut, pn_shift;
    __device__ __forceinline__ void init(int M_, int N_, int K_, int G_, int c_, const void* A_, const void* B_, int off_ = 0, int cut_ = 1 << 30, int shift_ = 0) { nM = M_ / 256; nN = N_ / 256; nwg = nM * nN; G = G_; c = c_; Abase = (const char*)A_; Bbase = (const char*)B_; tstep = (size_t)256 * K_ * 2; pn_off = off_; pn_cut = cut_; pn_shift = shift_; }
    __device__ __forceinline__ bool next(int i, pg8::Unit& u) const {
        const long L = (long)i * G + c; if (L >= nwg) return false;
        int wgid = (int)L; { const int q = nwg / 8, r = nwg % 8, xcd = wgid % 8, off = wgid / 8; wgid = (xcd < r ? xcd * (q + 1) : r * (q + 1) + (xcd - r) * q) + off; }
        const int nig = 8 * nN, gid = wgid / nig, fm = gid * 8, gsz = (nM - fm) < 8 ? (nM - fm) : 8;
        u.pm = fm + ((wgid % nig) % gsz); { const int idx = (wgid % nig) / gsz; u.pn = idx + pn_off + (idx >= pn_cut ? pn_shift : 0); }
        u.A = Abase + (size_t)u.pm * tstep; u.B = Bbase + (size_t)u.pn * tstep; u.gidx = nullptr; u.rows = 256; u.e = 0; u.base = 0; return true;
    }
};
struct MoeOrder {
    const LAS int* tab; int G, c; int down; const char* Abase; const char* Bbase; const int* elist;
    __device__ __forceinline__ bool next(int i, pg8::Unit& u) const {
        const int L = i * G + c; const int T = tab[32];
        if (L >= T * 4) return false;
        const int tile = L >> 2, sub = L & 3; int e = 0;
#pragma unroll 1
        for (int j = 1; j < 32; ++j) e = (tab[j] <= tile) ? j : e;
        const int rt = tile - tab[e], cnt = tab[66 + e], rb = tab[33 + e] + 256 * rt;
        u.pm = rt; u.pn = sub; u.e = e; u.base = rb; u.rows = (cnt - 256 * rt) < 256 ? (cnt - 256 * rt) : 256; u.gidx = elist + e * LCAP + 256 * rt;
        if (down) { u.A = Abase + (size_t)rb * (FF * 2); u.B = Bbase + ((size_t)e * 1024 + 256 * sub) * (FF * 2); }
        else      { u.A = Abase;                          u.B = Bbase + ((size_t)(e * 4 + sub) * 256) * (D * 2); }
        return true;
    }
};
__device__ __forceinline__ void sched_tables(LAS int* tab, gu32* cntw, int tid) {
    if (tid == 0) { int ts = 0, rb = 0;
        for (int e = 0; e < 32; ++e) { int cn = (int)__hip_atomic_load(cntw + e, RLX_AGENT); cn = cn > LCAP ? LCAP : cn; tab[e] = ts; tab[33 + e] = rb; tab[66 + e] = cn; ts += (cn + 255) >> 8; rb += cn; }
        tab[32] = ts; tab[65] = rb; }
    __syncthreads();
}

using pg8::u32x4; using pg8::cvt_pk_bf16;
__device__ __forceinline__ float silu_(float v) { return v / (1.f + __expf(-v)); }
constexpr float QSCALE = 0.125f * 1.4426950408889634f;
template <int EMASK> struct EpiInProj {
    bf16* R1; float* EL; const int* pos; const float* lbl;
    static constexpr size_t RSTR = (size_t)M * 512;
    __device__ __forceinline__ void operator()(f32x4 (&acc)[2][2][4][2], const pg8::Unit& u, int wr, int wc, int fr, int fq) const {
        asm volatile("" : "+v"(fr), "+v"(fq));
        const int pn = u.pn, rowb = u.pm * 256 + wr * 64 + fr;
        if ((EMASK & 1) && pn < 4) {
            const int part = pn >> 1, th = pn & 1; bf16* dst = R1 + (size_t)part * RSTR; const float qs = part ? 1.f : QSCALE;
            const int i0 = 16 * (wc & 1) + 4 * fq, dm0 = 32 * (wc & 1) + 8 * fq;
            float invf[4];
#pragma unroll
            for (int j = 0; j < 4; ++j) invf[j] = exp2f(-(float)(i0 + j) * 0.41524101186092029f);
#pragma unroll
            for (int ai = 0; ai < 2; ++ai)
#pragma unroll
                for (int m = 0; m < 4; ++m) { const int row = rowb + ai * 128 + m * 16; const float p = (float)pos[row]; float cs[4], sn[4];
#pragma unroll
                    for (int j = 0; j < 4; ++j) { float rev = p * invf[j] * 0.15915494309189535f; rev -= floorf(rev); sn[j] = __builtin_amdgcn_sinf(rev); cs[j] = __builtin_amdgcn_cosf(rev); }
#pragma unroll
                    for (int bj = 0; bj < 2; ++bj) { const int head = 4 * th + 2 * bj + (wc >> 1); const f32x4 x1 = acc[ai][bj][m][0], x2 = acc[ai][bj][m][1]; float o1[4], o2[4];
#pragma unroll
                        for (int j = 0; j < 4; ++j) { o1[j] = (x1[j] * cs[j] - x2[j] * sn[j]) * qs; o2[j] = (x2[j] * cs[j] + x1[j] * sn[j]) * qs; }
                        u32x4 w; w.x = cvt_pk_bf16(o1[0], o1[1]); w.y = cvt_pk_bf16(o1[2], o1[3]); w.z = cvt_pk_bf16(o2[0], o2[1]); w.w = cvt_pk_bf16(o2[2], o2[3]);
                        *(u32x4*)(dst + (size_t)row * 512 + head * 64 + dm0) = w; } }
        } else if ((EMASK & 2) && (pn < 6 || pn >= 10)) {
            bf16* dst = R1 + (size_t)(pn < 6 ? 2 : (pn < 12 ? 5 : 6)) * RSTR; const int cb = ((pn < 6 ? pn - 4 : (pn < 12 ? pn - 10 : pn - 12)) * 256) + wc * 32 + 8 * fq; const bool act = pn >= 12;
#pragma unroll
            for (int ai = 0; ai < 2; ++ai)
#pragma unroll
                for (int m = 0; m < 4; ++m) { const int row = rowb + ai * 128 + m * 16;
#pragma unroll
                    for (int bj = 0; bj < 2; ++bj) { f32x4 v0 = acc[ai][bj][m][0], v1 = acc[ai][bj][m][1];
                        if (act) {
#pragma unroll
                            for (int j = 0; j < 4; ++j) { v0[j] = silu_(v0[j]); v1[j] = silu_(v1[j]); } }
                        u32x4 w; w.x = cvt_pk_bf16(v0[0], v0[1]); w.y = cvt_pk_bf16(v0[2], v0[3]); w.z = cvt_pk_bf16(v1[0], v1[1]); w.w = cvt_pk_bf16(v1[2], v1[3]);
                        *(u32x4*)(dst + (size_t)row * 512 + cb + bj * 128) = w; } }
        } else if (EMASK & 4) {
            const int hh = pn - 6, k0 = wc * 32 + 8 * fq; float lb[2][4];
#pragma unroll
            for (int n = 0; n < 2; ++n)
#pragma unroll
                for (int j = 0; j < 4; ++j) { const int k = hh * 128 + k0 + 4 * n + j; lb[n][j] = 1.f / (1.f + __expf(lbl[512 + k] - lbl[k])); }
#pragma unroll
            for (int ai = 0; ai < 2; ++ai) {
#pragma unroll
                for (int m = 0; m < 4; ++m)
#pragma unroll
                    for (int n = 0; n < 2; ++n)
#pragma unroll
                        for (int j = 0; j < 4; ++j) { const float f = acc[ai][1][m][n][j]; const float t = __expf(fminf(-f, 80.f)); acc[ai][1][m][n][j] = (1.f - lb[n][j]) * (t / (1.f + t)); }
                const int chunk = u.pm * 4 + ai * 2 + wr;
#pragma unroll
                for (int n = 0; n < 2; ++n)
#pragma unroll
                    for (int j = 0; j < 4; ++j) { float carry = 0.f;
#pragma unroll
                        for (int m = 0; m < 4; ++m) { const float kin = acc[ai][1][m][n][j]; float x = __logf(1.f - kin);
#pragma unroll
                            for (int d = 1; d < 16; d <<= 1) { const float y = __shfl_up(x, d, 16); if (fr >= d) x += y; }
                            x += carry; carry = __shfl(x, 15, 16);
                            acc[ai][0][m][n][j] = silu_(acc[ai][0][m][n][j]) * __expf(x); acc[ai][1][m][n][j] = kin * __expf(-x); }
                        if (fr == 0) EL[(size_t)(chunk * 4 + hh) * 128 + k0 + 4 * n + j] = __expf(carry); }
#pragma unroll
                for (int m = 0; m < 4; ++m) { const int row = rowb + ai * 128 + m * 16; const f32x4 q0 = acc[ai][0][m][0], q1 = acc[ai][0][m][1], k0v = acc[ai][1][m][0], k1v = acc[ai][1][m][1];
                    u32x4 w; w.x = cvt_pk_bf16(q0[0], q0[1]); w.y = cvt_pk_bf16(q0[2], q0[3]); w.z = cvt_pk_bf16(q1[0], q1[1]); w.w = cvt_pk_bf16(q1[2], q1[3]);
                    *(u32x4*)(R1 + 3 * RSTR + (size_t)row * 512 + hh * 128 + k0) = w;
                    w.x = cvt_pk_bf16(k0v[0], k0v[1]); w.y = cvt_pk_bf16(k0v[2], k0v[3]); w.z = cvt_pk_bf16(k1v[0], k1v[1]); w.w = cvt_pk_bf16(k1v[2], k1v[3]);
                    *(u32x4*)(R1 + 4 * RSTR + (size_t)row * 512 + hh * 128 + k0) = w; } }
        }
    }
};
struct EpiOut {
    const float* x; const float* mod; float* out;
    __device__ __forceinline__ void operator()(f32x4 (&acc)[2][2][4][2], const pg8::Unit& u, int wr, int wc, int fr, int fq) const {
        const int rowb = u.pm * 256 + wr * 64 + fr, b = u.pm >> 3;
#pragma unroll
        for (int bj = 0; bj < 2; ++bj)
#pragma unroll
            for (int n = 0; n < 2; ++n) { const int col = u.pn * 256 + bj * 128 + wc * 32 + n * 16 + 4 * fq; const f32x4 g = *(const f32x4*)(mod + b * NMOD + 2 * D + col);
#pragma unroll
                for (int ai = 0; ai < 2; ++ai)
#pragma unroll
                    for (int m = 0; m < 4; ++m) { const size_t off = (size_t)(rowb + ai * 128 + m * 16) * D + col; *(f32x4*)(out + off) = *(const f32x4*)(x + off) + g * acc[ai][bj][m][n]; } }
    }
};
struct EpiGU {
    bf16* HID; const float* wlist;
    __device__ __forceinline__ void operator()(f32x4 (&acc)[2][2][4][2], const pg8::Unit& u, int wr, int wc, int fr, int fq) const {
        const int sb = wr * 64 + fr, cb = u.pn * 128 + wc * 32 + 8 * fq;
#pragma unroll
        for (int ai = 0; ai < 2; ++ai)
#pragma unroll
            for (int m = 0; m < 4; ++m) { const int s = sb + ai * 128 + m * 16;
                if (s < u.rows) { const float w = wlist[u.e * LCAP + u.pm * 256 + s]; const f32x4 g0 = acc[ai][0][m][0], g1 = acc[ai][0][m][1], u0 = acc[ai][1][m][0], u1 = acc[ai][1][m][1]; float h0[4], h1[4];
#pragma unroll
                    for (int j = 0; j < 4; ++j) { h0[j] = silu_(g0[j]) * u0[j] * w; h1[j] = silu_(g1[j]) * u1[j] * w; }
                    u32x4 o; o.x = cvt_pk_bf16(h0[0], h0[1]); o.y = cvt_pk_bf16(h0[2], h0[3]); o.z = cvt_pk_bf16(h1[0], h1[1]); o.w = cvt_pk_bf16(h1[2], h1[3]);
                    *(u32x4*)(HID + (size_t)(u.base + s) * FF + cb) = o; } }
    }
};
struct EpiDN {
    bf16* PART; const int* elist;
    __device__ __forceinline__ void operator()(f32x4 (&acc)[2][2][4][2], const pg8::Unit& u, int wr, int wc, int fr, int fq) const {
        const int sb = wr * 64 + fr, cb = u.pn * 256 + wc * 32 + 8 * fq;
#pragma unroll
        for (int ai = 0; ai < 2; ++ai)
#pragma unroll
            for (int m = 0; m < 4; ++m) { const int s = sb + ai * 128 + m * 16;
                if (s < u.rows) { const int ent = elist[u.e * LCAP + u.pm * 256 + s];
#pragma unroll
                    for (int bj = 0; bj < 2; ++bj) { const f32x4 v0 = acc[ai][bj][m][0], v1 = acc[ai][bj][m][1];
                        u32x4 o; o.x = cvt_pk_bf16(v0[0], v0[1]); o.y = cvt_pk_bf16(v0[2], v0[3]); o.z = cvt_pk_bf16(v1[0], v1[1]); o.w = cvt_pk_bf16(v1[2], v1[3]);
                        *(u32x4*)(PART + (size_t)ent * D + cb + bj * 128) = o; } } }
    }
};

__device__ __forceinline__ void transpose_item(const float* W, int ldw, int scol, bf16* dst_rows, int Kd, int k0, LAS float* scr, int lane) {
#pragma unroll 8
    for (int i = 0; i < 32; ++i) { const int kk = 2 * i + (lane >> 5); scr[kk * 33 + (lane & 31)] = W[(size_t)(k0 + kk) * ldw + scol]; }
    LDS_WAIT(); asm volatile("" ::: "memory");
    const int c = lane & 7;
#pragma unroll
    for (int j = 0; j < 4; ++j) { const int n = (lane >> 3) + 8 * j; const LAS float* s = scr + (8 * c) * 33 + n;
        v4u o; o.x = pk2(s[0 * 33], s[1 * 33]); o.y = pk2(s[2 * 33], s[3 * 33]); o.z = pk2(s[4 * 33], s[5 * 33]); o.w = pk2(s[6 * 33], s[7 * 33]);
        *(GAS v4u*)(dst_rows + (size_t)n * Kd + k0 + 8 * c) = o; }
    LDS_WAIT(); asm volatile("" ::: "memory");
}
__device__ __forceinline__ int plain32(int q) { return 8 * ((q >> 2) & 3) + 4 * (q >> 4) + (q & 3); }
__device__ __forceinline__ int win_col(int P) {
    const int pn = P >> 8, p = P & 255, bj = p >> 7, wc = (p >> 5) & 3, n = (p >> 4) & 1, fq = (p >> 2) & 3, j = p & 3;
    if (pn < 4) { const int part = pn >> 1, th = pn & 1, head = 4 * th + 2 * bj + (wc >> 1), d = 32 * n + 16 * (wc & 1) + 4 * fq + j; return part * 512 + head * 64 + d; }
    const int lc = 128 * bj + 32 * wc + 8 * fq + 4 * n + j;
    if (pn < 6) return 1024 + (pn - 4) * 256 + lc;
    if (pn < 10) { const int hh = pn - 6, kk = 32 * wc + 8 * fq + 4 * n + j; return (bj ? 2048 : 1536) + hh * 128 + kk; }
    if (pn < 12) return 2560 + (pn - 10) * 256 + lc;
    return 3072 + (pn - 12) * 256 + lc;
}

struct Ctx { LAS unsigned char* lds; unsigned char* ws; int vcu, G; };
#define PHASE_IDS const int tid_ = threadIdx.x, lane_ = tid_ & 63, wave_ = __builtin_amdgcn_readfirstlane(tid_ >> 6)

__device__ __forceinline__ void phase0(const Args& a, const Ctx& X) {
    PHASE_IDS;
    const float* c = a.in[1]; const float* w_ada = a.in[3]; const float* b_ada = a.in[4];
    LAS float* cs = (LAS float*)X.lds;
    LAS float* part = (LAS float*)(X.lds + 32768);
    float* mod = (float*)(X.ws + WS_MOD);
    if (X.vcu < 192) {
        for (int i = tid_; i < 8192; i += 512) cs[i] = silu_(c[i]);
        __syncthreads();
        for (int item = X.vcu; item < 192; item += X.G) {
            const int n0 = 32 * item, krow = lane_ >> 3, c4 = lane_ & 7; f32x4 acc[8];
#pragma unroll
            for (int b = 0; b < 8; ++b) acc[b] = (f32x4){0.f, 0.f, 0.f, 0.f};
#pragma unroll 4
            for (int it = 0; it < 16; ++it) { const int k = 128 * wave_ + 8 * it + krow; const f32x4 wv = *(const f32x4*)(w_ada + (size_t)k * NMOD + n0 + 4 * c4);
#pragma unroll
                for (int b = 0; b < 8; ++b) acc[b] += wv * cs[b * 1024 + k]; }
#pragma unroll
            for (int b = 0; b < 8; ++b)
#pragma unroll
                for (int j = 0; j < 4; ++j) { float v = acc[b][j]; v += __shfl_xor(v, 8); v += __shfl_xor(v, 16); v += __shfl_xor(v, 32); acc[b][j] = v; }
            if (lane_ < 8) {
#pragma unroll
                for (int b = 0; b < 8; ++b) *(LAS f32x4*)(part + (wave_ * 8 + b) * 32 + 4 * c4) = acc[b]; }
            __syncthreads();
            if (tid_ < 256) { const int b = tid_ >> 5, col = tid_ & 31; float s = b_ada[n0 + col];
#pragma unroll
                for (int w = 0; w < 8; ++w) s += part[(w * 8 + b) * 32 + col];
                mod[b * NMOD + n0 + col] = s; }
            __syncthreads();
        }
    }
    LAS float* scr = (LAS float*)(X.lds + 65536 + wave_ * 8448);
    const int gw = X.vcu * NWAVES + wave_, NGW = X.G * NWAVES;
    constexpr int I_IN = (NPROJ / 32) * 16, I_OUT = (D / 32) * 16;
    for (int it = gw; it < I_IN + I_OUT; it += NGW) {
        if (it < I_IN) { const int G32 = it >> 4, kb = it & 15; transpose_item(a.in[6], NPROJ, win_col(32 * G32 + (lane_ & 31)), (bf16*)(X.ws + WS_WIN) + (size_t)(32 * G32) * D, D, 64 * kb, scr, lane_); }
        else { const int r = it - I_IN, G32 = r >> 4, kb = r & 15; transpose_item(a.in[14], D, 32 * G32 + (lane_ & 31), (bf16*)(X.ws + WS_WOUT) + (size_t)(32 * G32) * D, D, 64 * kb, scr, lane_); }
    }
}
__device__ __forceinline__ void phase1(const Args& a, const Ctx& X) {
    PHASE_IDS;
    const float* x = a.in[0]; const float* nw = a.in[5]; const float* mod = (const float*)(X.ws + WS_MOD); bf16* H1 = (bf16*)(X.ws + WS_RA);
    const int gw = X.vcu * NWAVES + wave_, NGW = X.G * NWAVES;
    for (int m = gw; m < M; m += NGW) { const int b = m >> 11; const f32x4* xr = (const f32x4*)(x + (size_t)m * D) + lane_; f32x4 v[4]; float ss = 0.f;
#pragma unroll
        for (int j = 0; j < 4; ++j) { v[j] = xr[64 * j]; ss += (v[j].x * v[j].x + v[j].y * v[j].y) + (v[j].z * v[j].z + v[j].w * v[j].w); }
        const float rstd = 1.f / sqrtf(wave_sum(ss) * (1.f / D) + RMS_EPS);
#pragma unroll
        for (int j = 0; j < 4; ++j) { const int k = 256 * j + 4 * lane_; const f32x4 w = *(const f32x4*)(nw + k), sh = *(const f32x4*)(mod + b * NMOD + k), sc = *(const f32x4*)(mod + b * NMOD + D + k);
            const f32x4 h = v[j] * rstd * w * (sc + 1.f) + sh; u32x2v o; o.x = cvt_pk_bf16(h.x, h.y); o.y = cvt_pk_bf16(h.z, h.w); *(u32x2v*)(H1 + (size_t)m * D + k) = o; }
    }
}
__device__ __forceinline__ bf16x8 frag16(const LAS bf16* A, int ld, int r0, int k0, int lane) { return *(const LAS bf16x8*)(A + (r0 + (lane & 15)) * ld + k0 + 8 * (lane >> 4)); }
#define MFMA16(a, b, c) __builtin_amdgcn_mfma_f32_16x16x32_bf16(a, b, c, 0, 0, 0)
__device__ __forceinline__ void stage_T(const bf16* src, LAS bf16* dst, int wave, int lane) {
#pragma unroll
    for (int cc = 0; cc < 2; ++cc) { const int c = wave + 8 * cc; const v4u q = *(const v4u*)(src + (size_t)lane * 512 + 8 * c);
        dst[(8 * c + 0) * 72 + lane] = (bf16)(q.x & 0xffffu); dst[(8 * c + 1) * 72 + lane] = (bf16)(q.x >> 16); dst[(8 * c + 2) * 72 + lane] = (bf16)(q.y & 0xffffu); dst[(8 * c + 3) * 72 + lane] = (bf16)(q.y >> 16);
        dst[(8 * c + 4) * 72 + lane] = (bf16)(q.z & 0xffffu); dst[(8 * c + 5) * 72 + lane] = (bf16)(q.z >> 16); dst[(8 * c + 6) * 72 + lane] = (bf16)(q.w & 0xffffu); dst[(8 * c + 7) * 72 + lane] = (bf16)(q.w >> 16); }
}
__device__ __forceinline__ void phase3(const Args& a, const Ctx& X) {
    PHASE_IDS;
    LAS bf16* VT = (LAS bf16*)X.lds; LAS bf16* KT = (LAS bf16*)(X.lds + 18432);
    const bf16* VI = (const bf16*)(X.ws + WS_VI); const bf16* KP = (const bf16*)(X.ws + WS_KP); bf16* UST = (bf16*)(X.ws + WS_UST);
    for (int un = X.vcu; un < 1024; un += X.G) { const int c = un & 31, h = (un >> 5) & 3, b = un >> 7; const size_t row0 = (size_t)b * SEQ + c * 64;
        stage_T(VI + row0 * 512 + h * 128, VT, wave_, lane_); stage_T(KP + row0 * 512 + h * 128, KT, wave_, lane_);
        __syncthreads();
        f32x4 acc[8];
#pragma unroll
        for (int kt = 0; kt < 8; ++kt) acc[kt] = (f32x4){0.f, 0.f, 0.f, 0.f};
#pragma unroll
        for (int ks = 0; ks < 2; ++ks) { const bf16x8 af = frag16(VT, 72, 16 * wave_, 32 * ks, lane_);
#pragma unroll
            for (int kt = 0; kt < 8; ++kt) acc[kt] = MFMA16(af, frag16(KT, 72, 16 * kt, 32 * ks, lane_), acc[kt]); }
        bf16* U = UST + (size_t)un * 16384;
#pragma unroll
        for (int kt = 0; kt < 8; ++kt)
#pragma unroll
            for (int j = 0; j < 4; ++j) U[(16 * wave_ + (lane_ >> 4) * 4 + j) * 128 + 16 * kt + (lane_ & 15)] = (bf16)f2bf(acc[kt][j]);
        __syncthreads();
    }
}
__device__ __forceinline__ void phase4_scan(const Args& a, const Ctx& X) {
    PHASE_IDS;
    bf16* UST = (bf16*)(X.ws + WS_UST); const float* EL = (const float*)(X.ws + WS_EL);
    for (int g = X.vcu * 512 + tid_; g < 32 * 4096; g += X.G * 512) { const int bh = g >> 12, rem = g & 4095, v = rem >> 5, k4 = (rem & 31) * 4, h = bh & 3, b = bh >> 2;
        f32x4 S = (f32x4){0.f, 0.f, 0.f, 0.f};
#pragma unroll 4
        for (int c = 0; c < NCH; ++c) { u32x2v* p = (u32x2v*)(UST + (size_t)(bh * 32 + c) * 16384 + v * 128 + k4); const u32x2v uw = *p; const f32x4 e = *(const f32x4*)(EL + (size_t)((b * 32 + c) * 4 + h) * 128 + k4);
            u32x2v o; o.x = cvt_pk_bf16(S.x, S.y); o.y = cvt_pk_bf16(S.z, S.w); *p = o;
            S.x = e.x * (S.x + bf_lo(uw.x)); S.y = e.y * (S.y + bf_hi(uw.x)); S.z = e.z * (S.z + bf_lo(uw.y)); S.w = e.w * (S.w + bf_hi(uw.y)); }
    }
}
struct AttnUnitU { int bvh; int qb; };
struct AttnOrder {
  int vcu;
  __device__ __forceinline__ bool next(int i, AttnUnitU& u) const { if (i >= 4) return false; const int s0 = 2 * (vcu & 1); u.bvh = vcu >> 1; u.qb = (i == 0) ? s0 : (i == 1) ? 7 - s0 : (i == 2) ? s0 + 1 : 6 - s0; return true; }
};
struct AttnT { const attn_body::bf16* Q; const attn_body::bf16* K; const attn_body::bf16* V; attn_body::bf16* O; };
template <class Sched> __device__ __forceinline__ void attn_phase_(char* lds, const AttnT& T, const Sched& S) {
  AttnUnitU u;
  for (int i = 0; S.next(i, u); ++i) { const int vh = u.bvh & 1, qh = (u.bvh >> 1) & 7, b = u.bvh >> 4; attn_body::attn_unit<8>(b, qh * 64, (qh >> 1) * 128 + vh * 64, qh * 128 + vh * 64, u.qb, T.Q, T.K, T.V, T.O, lds); }
}
__device__ __forceinline__ void phase4_attn(const Args& a, const Ctx& X, char* ldsg) {
    const AttnT T{(const attn_body::bf16*)(X.ws + WS_Q), (const attn_body::bf16*)(X.ws + WS_K), (const attn_body::bf16*)(X.ws + WS_V), (attn_body::bf16*)(X.ws + WS_RA)};
    const AttnOrder S{X.vcu};
    attn_phase_<AttnOrder>(ldsg, T, S);
}
__device__ __forceinline__ void phase5_hgrn(const Args& a, const Ctx& X) {
    PHASE_IDS;
    LAS bf16* QS = (LAS bf16*)X.lds; LAS bf16* KS = (LAS bf16*)(X.lds + 17408); LAS bf16* VT = (LAS bf16*)(X.lds + 34816); LAS bf16* STs = (LAS bf16*)(X.lds + 53248);
    LAS bf16* PS = (LAS bf16*)(X.lds + 88064); LAS float* OS = (LAS float*)(X.lds + 97280);
    const bf16* QP = (const bf16*)(X.ws + WS_QP); const bf16* KP = (const bf16*)(X.ws + WS_KP); const bf16* VI = (const bf16*)(X.ws + WS_VI); const bf16* SG = (const bf16*)(X.ws + WS_SG);
    const bf16* UST = (const bf16*)(X.ws + WS_UST); bf16* MIXED = (bf16*)(X.ws + WS_MIXED); const float* gnw = a.in[13];
    for (int un = X.vcu; un < 1024; un += X.G) { const int c = un & 31, h = (un >> 5) & 3, b = un >> 7; const size_t row0 = (size_t)b * SEQ + c * 64;
#pragma unroll
        for (int i = 0; i < 2; ++i) { const int idx = tid_ + 512 * i, row = idx >> 4, ch = idx & 15;
            *(LAS v4u*)(QS + row * 136 + ch * 8) = *(const v4u*)(QP + (row0 + row) * 512 + h * 128 + ch * 8); *(LAS v4u*)(KS + row * 136 + ch * 8) = *(const v4u*)(KP + (row0 + row) * 512 + h * 128 + ch * 8); }
#pragma unroll
        for (int i = 0; i < 4; ++i) { const int idx = tid_ + 512 * i, row = idx >> 4, ch = idx & 15; *(LAS v4u*)(STs + row * 136 + ch * 8) = *(const v4u*)(UST + (size_t)un * 16384 + row * 128 + ch * 8); }
        stage_T(VI + row0 * 512 + h * 128, VT, wave_, lane_);
        __syncthreads();
        { const int tt = wave_ >> 1; f32x4 s2[2];
#pragma unroll
          for (int x = 0; x < 2; ++x) s2[x] = (f32x4){0.f, 0.f, 0.f, 0.f};
#pragma unroll
          for (int ks = 0; ks < 4; ++ks) { const bf16x8 af = frag16(QS, 136, 16 * tt, 32 * ks, lane_);
#pragma unroll
              for (int x = 0; x < 2; ++x) s2[x] = MFMA16(af, frag16(KS, 136, 16 * (2 * (wave_ & 1) + x), 32 * ks, lane_), s2[x]); }
#pragma unroll
          for (int x = 0; x < 2; ++x) { const int st = 2 * (wave_ & 1) + x;
#pragma unroll
              for (int j = 0; j < 4; ++j) { const int t = 16 * tt + (lane_ >> 4) * 4 + j, s = 16 * st + (lane_ & 15); PS[t * 72 + s] = (bf16)f2bf(s <= t ? s2[x][j] : 0.f); } } }
        __syncthreads();
        { f32x4 o[4];
#pragma unroll
          for (int tt = 0; tt < 4; ++tt) o[tt] = (f32x4){0.f, 0.f, 0.f, 0.f};
#pragma unroll
          for (int ks = 0; ks < 2; ++ks) { const bf16x8 bfr = frag16(VT, 72, 16 * wave_, 32 * ks, lane_);
#pragma unroll
              for (int tt = 0; tt < 4; ++tt) o[tt] = MFMA16(frag16(PS, 72, 16 * tt, 32 * ks, lane_), bfr, o[tt]); }
#pragma unroll
          for (int ks = 0; ks < 4; ++ks) { const bf16x8 bfr = frag16(STs, 136, 16 * wave_, 32 * ks, lane_);
#pragma unroll
              for (int tt = 0; tt < 4; ++tt) o[tt] = MFMA16(frag16(QS, 136, 16 * tt, 32 * ks, lane_), bfr, o[tt]); }
#pragma unroll
          for (int tt = 0; tt < 4; ++tt)
#pragma unroll
              for (int j = 0; j < 4; ++j) OS[(16 * tt + (lane_ >> 4) * 4 + j) * 132 + 16 * wave_ + (lane_ & 15)] = o[tt][j]; }
        __syncthreads();
#pragma unroll
        for (int r = 0; r < 8; ++r) { const int t = 8 * wave_ + r; const float o0 = OS[t * 132 + 2 * lane_], o1 = OS[t * 132 + 2 * lane_ + 1];
            const float rstd = 1.f / sqrtf(wave_sum(o0 * o0 + o1 * o1) * (1.f / 128.f) + RMS_EPS); const unsigned sg = *(const unsigned*)(SG + (row0 + t) * 512 + h * 128 + 2 * lane_);
            *(unsigned*)(MIXED + (row0 + t) * 1024 + 512 + h * 128 + 2 * lane_) = cvt_pk_bf16(o0 * rstd * gnw[2 * lane_] * bf_lo(sg), o1 * rstd * gnw[2 * lane_ + 1] * bf_hi(sg)); }
        __syncthreads();
    }
}
__device__ __forceinline__ void phase5_comb(const Args& a, const Ctx& X) {
    PHASE_IDS;
    const bf16* AO = (const bf16*)(X.ws + WS_RA); bf16* MIXED = (bf16*)(X.ws + WS_MIXED); const float* sw = a.in[11];
    const float d1 = wave_sum(a.in[7][lane_] * a.in[8][lane_]), d2 = wave_sum(a.in[9][lane_] * a.in[10][lane_]); const float lam = expf(d1) - expf(d2) + LAMBDA_INIT;
    const int gw = X.vcu * NWAVES + wave_, NGW = X.G * NWAVES, hh = lane_ >> 4, ds = (lane_ & 15) * 8;
    float swv[8];
#pragma unroll
    for (int i = 0; i < 8; ++i) swv[i] = sw[ds + i] * (1.f - LAMBDA_INIT);
    for (int m = gw; m < M; m += NGW) { const v4u p1 = *(const v4u*)(AO + (size_t)m * 1024 + (2 * hh) * 128 + ds), p2 = *(const v4u*)(AO + (size_t)m * 1024 + (2 * hh + 1) * 128 + ds); float v[8];
        v[0] = bf_lo(p1.x) - lam * bf_lo(p2.x); v[1] = bf_hi(p1.x) - lam * bf_hi(p2.x); v[2] = bf_lo(p1.y) - lam * bf_lo(p2.y); v[3] = bf_hi(p1.y) - lam * bf_hi(p2.y);
        v[4] = bf_lo(p1.z) - lam * bf_lo(p2.z); v[5] = bf_hi(p1.z) - lam * bf_hi(p2.z); v[6] = bf_lo(p1.w) - lam * bf_lo(p2.w); v[7] = bf_hi(p1.w) - lam * bf_hi(p2.w);
        float ss = 0.f;
#pragma unroll
        for (int i = 0; i < 8; ++i) ss += v[i] * v[i];
        ss += __shfl_xor(ss, 1); ss += __shfl_xor(ss, 2); ss += __shfl_xor(ss, 4); ss += __shfl_xor(ss, 8);
        const float rstd = 1.f / sqrtf(ss * (1.f / 128.f) + SUBLN_EPS);
        v4u o; o.x = cvt_pk_bf16(v[0] * rstd * swv[0], v[1] * rstd * swv[1]); o.y = cvt_pk_bf16(v[2] * rstd * swv[2], v[3] * rstd * swv[3]);
        o.z = cvt_pk_bf16(v[4] * rstd * swv[4], v[5] * rstd * swv[5]); o.w = cvt_pk_bf16(v[6] * rstd * swv[6], v[7] * rstd * swv[7]);
        *(v4u*)(MIXED + (size_t)m * 1024 + hh * 128 + ds) = o; }
}
__device__ __forceinline__ void phase7_route(const Args& a, const Ctx& X, gu32* ctl) {
    PHASE_IDS;
    LAS float* WT = (LAS float*)X.lds;
    const float* wgr = a.in[16]; const float* bgr = a.in[17]; const float* wer = a.in[18]; const float* ber = a.in[19]; const float* nw = a.in[15];
    const float* x1 = a.out; const float* mod = (const float*)(X.ws + WS_MOD); bf16* H2 = (bf16*)(X.ws + WS_RA);
    int* elist = (int*)(X.ws + WS_ELIST); float* wlist = (float*)(X.ws + WS_WLIST);
#pragma unroll 4
    for (int i = 0; i < 16; ++i) { const int idx = tid_ + 512 * i, k = idx & 1023, o4 = idx >> 10; const f32x4 w = *(const f32x4*)(wer + k * 32 + 4 * o4);
        WT[(4 + 4 * o4 + 0) * 1024 + k] = w.x; WT[(4 + 4 * o4 + 1) * 1024 + k] = w.y; WT[(4 + 4 * o4 + 2) * 1024 + k] = w.z; WT[(4 + 4 * o4 + 3) * 1024 + k] = w.w; }
#pragma unroll
    for (int i = 0; i < 2; ++i) { const int k = tid_ + 512 * i; const f32x4 w = *(const f32x4*)(wgr + k * 4); WT[0 * 1024 + k] = w.x; WT[1 * 1024 + k] = w.y; WT[2 * 1024 + k] = w.z; WT[3 * 1024 + k] = w.w; }
    __syncthreads();
    const int gw = X.vcu * NWAVES + wave_, NGW = X.G * NWAVES;
    for (int m = gw; m < M; m += NGW) { const int b = m >> 11; const f32x4* xr = (const f32x4*)(x1 + (size_t)m * D) + lane_; f32x4 h[4]; float ss = 0.f;
#pragma unroll
        for (int j = 0; j < 4; ++j) { h[j] = xr[64 * j]; ss += (h[j].x * h[j].x + h[j].y * h[j].y) + (h[j].z * h[j].z + h[j].w * h[j].w); }
        const float rstd = 1.f / sqrtf(wave_sum(ss) * (1.f / D) + RMS_EPS);
#pragma unroll
        for (int j = 0; j < 4; ++j) { const int k = 256 * j + 4 * lane_; const f32x4 w = *(const f32x4*)(nw + k), sh = *(const f32x4*)(mod + b * NMOD + 3 * D + k), sc = *(const f32x4*)(mod + b * NMOD + 4 * D + k);
            h[j] = h[j] * rstd * w * (sc + 1.f) + sh; u32x2v o; o.x = cvt_pk_bf16(h[j].x, h[j].y); o.y = cvt_pk_bf16(h[j].z, h[j].w); *(u32x2v*)(H2 + (size_t)m * D + k) = o; }
        float gl[4];
#pragma unroll
        for (int g = 0; g < 4; ++g) { float s = 0.f;
#pragma unroll
            for (int j = 0; j < 4; ++j) { const f32x4 w = *(const LAS f32x4*)(WT + g * 1024 + 256 * j + 4 * lane_); s += (h[j].x * w.x + h[j].y * w.y) + (h[j].z * w.z + h[j].w * w.w); }
            gl[g] = wave_sum(s) + bgr[g]; }
        int gs = 0; float gm = gl[0];
#pragma unroll
        for (int g = 1; g < 4; ++g) if (gl[g] > gm) { gm = gl[g]; gs = g; }
        float den = 0.f;
#pragma unroll
        for (int g = 0; g < 4; ++g) den += expf(gl[g] - gm);
        const float pg = 1.f / den;
        float el[8]; const LAS float* WE = WT + (4 + 8 * gs) * 1024;
#pragma unroll
        for (int i = 0; i < 8; ++i) { float s = 0.f;
#pragma unroll
            for (int j = 0; j < 4; ++j) { const f32x4 w = *(const LAS f32x4*)(WE + i * 1024 + 256 * j + 4 * lane_); s += (h[j].x * w.x + h[j].y * w.y) + (h[j].z * w.z + h[j].w * w.w); }
            el[i] = wave_sum(s) + ber[gs * 8 + i]; }
        int i1 = 0; float m1 = el[0];
#pragma unroll
        for (int i = 1; i < 8; ++i) if (el[i] > m1) { m1 = el[i]; i1 = i; }
        int i2 = -1; float m2 = -INFINITY;
#pragma unroll
        for (int i = 0; i < 8; ++i) if (i != i1 && (i2 < 0 || el[i] > m2)) { m2 = el[i]; i2 = i; }
        const float t = expf(m2 - m1), w1 = pg / (1.f + t), w2 = pg * t / (1.f + t);
        if (lane_ == 0) { const int e1 = gs * 8 + i1, e2 = gs * 8 + i2;
            const unsigned s1 = __hip_atomic_fetch_add(ctl + CW_CNT + e1, 1u, RLX_AGENT); if (s1 < (unsigned)LCAP) { elist[e1 * LCAP + s1] = 2 * m; wlist[e1 * LCAP + s1] = w1; }
            const unsigned s2 = __hip_atomic_fetch_add(ctl + CW_CNT + e2, 1u, RLX_AGENT); if (s2 < (unsigned)LCAP) { elist[e2 * LCAP + s2] = 2 * m + 1; wlist[e2 * LCAP + s2] = w2; } }
    }
}
__device__ __forceinline__ void phase7_conv(const Args& a, const Ctx& X) {
    PHASE_IDS;
    LAS float* scr = (LAS float*)(X.lds + wave_ * 8448);
    const int gw = X.vcu * NWAVES + wave_, NGW = X.G * NWAVES;
    constexpr int I_GU = 32 * 4 * 8 * 16, I_DN = 32 * 32 * 8;
    for (int it = gw; it < I_GU + I_DN; it += NGW) {
        if (it < I_GU) { const int kb = it & 15, g8 = (it >> 4) & 7, sub = (it >> 7) & 3, e = it >> 9, bj = g8 >> 2, wc = g8 & 3;
            const float* W = (bj ? a.in[21] : a.in[20]) + (size_t)e * D * FF; const int scol = 128 * sub + 32 * wc + plain32(lane_ & 31);
            transpose_item(W, FF, scol, (bf16*)(X.ws + WS_WGU) + ((size_t)(e * 4 + sub) * 256 + 32 * g8) * D, D, 64 * kb, scr, lane_); }
        else { const int r = it - I_GU, kb = r & 7, G32 = (r >> 3) & 31, e = r >> 8; const float* W = a.in[22] + (size_t)e * FF * D; const int scol = 32 * G32 + plain32(lane_ & 31);
            transpose_item(W, D, scol, (bf16*)(X.ws + WS_WD) + ((size_t)e * 1024 + 32 * G32) * FF, FF, 64 * kb, scr, lane_); }
    }
}
__device__ __forceinline__ void phase10(const Args& a, const Ctx& X) {
    PHASE_IDS;
    float* out = a.out; const float* mod = (const float*)(X.ws + WS_MOD); const bf16* PART = (const bf16*)(X.ws + WS_PART); const float* fw = a.in[23];
    const int gw = X.vcu * NWAVES + wave_, NGW = X.G * NWAVES;
    for (int m = gw; m < M; m += NGW) { const int b = m >> 11; f32x4* xr = (f32x4*)(out + (size_t)m * D) + lane_; f32x4 y[4]; float ss = 0.f;
#pragma unroll
        for (int j = 0; j < 4; ++j) { const int k = 256 * j + 4 * lane_; const f32x4 g = *(const f32x4*)(mod + b * NMOD + 5 * D + k);
            const u32x2v p0 = *(const u32x2v*)(PART + (size_t)(2 * m) * D + k), p1 = *(const u32x2v*)(PART + (size_t)(2 * m + 1) * D + k);
            f32x4 f; f.x = bf_lo(p0.x) + bf_lo(p1.x); f.y = bf_hi(p0.x) + bf_hi(p1.x); f.z = bf_lo(p0.y) + bf_lo(p1.y); f.w = bf_hi(p0.y) + bf_hi(p1.y);
            y[j] = xr[64 * j] + g * f; ss += (y[j].x * y[j].x + y[j].y * y[j].y) + (y[j].z * y[j].z + y[j].w * y[j].w); }
        const float rstd = 1.f / sqrtf(wave_sum(ss) * (1.f / D) + RMS_EPS);
#pragma unroll
        for (int j = 0; j < 4; ++j) { const int k = 256 * j + 4 * lane_; xr[64 * j] = y[j] * rstd * *(const f32x4*)(fw + k); }
    }
}

__global__ void __launch_bounds__(NWAVES * 64, 2) hymba_fwd(Args args) {
    extern __shared__ __attribute__((aligned(16))) unsigned char lds[];
    Ctx X; X.lds = (LAS unsigned char*)lds; X.ws = args.ws;
    X.G = gridDim.x; { const int bx = blockIdx.x; X.vcu = (X.G % 8 == 0) ? (bx % 8) * (X.G / 8) + bx / 8 : bx; }
    gu32* ctl = (gu32*)(args.ws + WS_CTL);
    for (int u = threadIdx.x; u < (LDS_BYTES - LDSCTL_OFF) / 4; u += NWAVES * 64) ((LAS unsigned*)(X.lds + LDSCTL_OFF))[u] = 0u;
    __syncthreads();
    if (MK_N_LAUNCHES == 1) (void)xcd_barrier_post((unsigned*)(ctl + CW_BAR), (volatile LAS unsigned*)(X.lds + MISC_OFF) + 8);
    const int lo = args.ph_lo, hi = args.ph_hi;
#ifndef PH_MASK
#define PH_MASK 0x7ff
#endif
#define IN(k) ((((PH_MASK) >> (k)) & 1) && lo <= (k) && (k) < hi)
#define SEAM(k) do { if (IN(k) && IN((k) + 1)) { XcdBarrier bar_; bar_.bar = (unsigned*)((gu32*)(args.ws + WS_CTL) + CW_BAR); bar_.x = xb_xcc_id(); bar_.st = (volatile LAS unsigned*)(X.lds + MISC_OFF) + 8; xcd_barrier(bar_); } } while (0)
    LAS int* tab = (LAS int*)(X.lds + SCHED_OFF);
    if (IN(0)) { phase0(args, X); } SEAM(0);
    if (IN(1)) { phase1(args, X); } SEAM(1);
    if (IN(2)) {
        { DenseOrder S; S.init(M, 2560, D, X.G, (int)blockIdx.x, args.ws + WS_RA, args.ws + WS_WIN, 0, 6, 4);
          EpiInProj<3> E{(bf16*)(args.ws + WS_Q), (float*)(args.ws + WS_EL), (const int*)args.in[2], args.in[12]};
          pg8::gemm_phase<EpiInProj<3>, DenseOrder, false, true>(X.lds, D, S, E); }
        { DenseOrder S; S.init(M, 1024, D, X.G, (int)blockIdx.x, args.ws + WS_RA, args.ws + WS_WIN, 6);
          EpiInProj<4> E{(bf16*)(args.ws + WS_Q), (float*)(args.ws + WS_EL), (const int*)args.in[2], args.in[12]};
          pg8::gemm_phase<EpiInProj<4>, DenseOrder, false, true>(X.lds, D, S, E); } } SEAM(2);
    if (IN(3)) { phase3(args, X); } SEAM(3);
    if (IN(4)) { phase4_scan(args, X); phase4_attn(args, X, (char*)lds); } SEAM(4);
    if (IN(5)) { phase5_hgrn(args, X); phase5_comb(args, X); } SEAM(5);
    if (IN(6)) { DenseOrder S; S.init(M, D, D, X.G, (int)blockIdx.x, args.ws + WS_MIXED, args.ws + WS_WOUT);
        EpiOut E{args.in[0], (const float*)(args.ws + WS_MOD), args.out};
        pg8::gemm_phase<EpiOut, DenseOrder, false, true>(X.lds, D, S, E); } SEAM(6);
    if (IN(7)) { phase7_route(args, X, ctl); __syncthreads(); phase7_conv(args, X); } SEAM(7);
    if (IN(8)) { sched_tables(tab, ctl + CW_CNT, (int)threadIdx.x);
        MoeOrder S{tab, X.G, (int)blockIdx.x, 0, (const char*)(args.ws + WS_RA), (const char*)(args.ws + WS_WGU), (const int*)(args.ws + WS_ELIST)};
        EpiGU E{(bf16*)(args.ws + WS_HID), (const float*)(args.ws + WS_WLIST)};
        pg8::gemm_phase<EpiGU, MoeOrder, true, true>(X.lds, D, S, E); } SEAM(8);
    if (IN(9)) { sched_tables(tab, ctl + CW_CNT, (int)threadIdx.x);
        MoeOrder S{tab, X.G, (int)blockIdx.x, 1, (const char*)(args.ws + WS_HID), (const char*)(args.ws + WS_WD), (const int*)(args.ws + WS_ELIST)};
        EpiDN E{(bf16*)(args.ws + WS_PART), (const int*)(args.ws + WS_ELIST)};
        pg8::gemm_phase<EpiDN, MoeOrder, false, true>(X.lds, FF, S, E); } SEAM(9);
    if (IN(10)) { phase10(args, X); }
#undef IN
#undef SEAM
}

extern "C" void kernel_launch(void* const* d_in, const int* in_sizes, int n_in, void* d_out, int out_size, void* d_ws, size_t ws_size, hipStream_t stream) {
    static int grid = 0;
    if (grid == 0) {
        if (n_in != 24 || in_sizes[0] != M * D || out_size != M * D || ws_size < WS_END) { fprintf(stderr, "kernel_launch: unexpected shapes (n_in %d, in0 %d, out %d, ws %zu); nothing launched\n", n_in, n_in > 0 ? in_sizes[0] : -1, out_size, ws_size); grid = -1; return; }
        int dev = 0, cus = 0, per_cu = 0;
        if (hipGetDevice(&dev) != hipSuccess || hipDeviceGetAttribute(&cus, hipDeviceAttributeMultiprocessorCount, dev) != hipSuccess) { fprintf(stderr, "kernel_launch: device query failed\n"); grid = -1; return; }
        if (hipFuncSetAttribute((const void*)hymba_fwd, hipFuncAttributeMaxDynamicSharedMemorySize, LDS_BYTES) != hipSuccess) { fprintf(stderr, "kernel_launch: hipFuncSetAttribute failed\n"); grid = -1; return; }
        if (hipOccupancyMaxActiveBlocksPerMultiprocessor(&per_cu, (const void*)hymba_fwd, NWAVES * 64, LDS_BYTES) != hipSuccess || per_cu < 1) { fprintf(stderr, "kernel_launch: occupancy query reports %d workgroups per CU\n", per_cu); (void)hipGetLastError(); grid = -1; return; }
        if (cus != 256) { fprintf(stderr, "kernel_launch: built for a 256-CU device, found %d CUs; nothing launched\n", cus); grid = -1; return; }
        grid = cus;
    }
    if (grid < 0) return;
    (void)hipMemsetAsync((char*)d_ws + WS_CTL, 0, CTL_ZERO_BYTES, stream);
    Args a{};
    for (int i = 0; i < 24; ++i) a.in[i] = (const float*)d_in[i];
    a.out = (float*)d_out; a.ws = (unsigned char*)d_ws;
    if (MK_N_LAUNCHES == 1) { a.ph_lo = 0; a.ph_hi = NPH; hipLaunchKernelGGL(hymba_fwd, dim3(grid), dim3(NWAVES * 64), LDS_BYTES, stream, a); }
    else { for (int p = 0; p < NPH; ++p) { a.ph_lo = p; a.ph_hi = p + 1; hipLaunchKernelGGL(hymba_fwd, dim3(grid), dim3(NWAVES * 64), LDS_BYTES, stream, a); } }
}
```

```cpp
#include <hip/hip_runtime.h>
#include <hip/hip_bf16.h>
#include <cstdio>
#include <cstdint>
#include <cmath>
namespace pg8 {
#define PG8_LAS __attribute__((address_space(3)))
typedef unsigned short bf16_t;
typedef short bf16x8 __attribute__((ext_vector_type(8)));
typedef float f32x4 __attribute__((ext_vector_type(4)));
typedef unsigned u32x4 __attribute__((ext_vector_type(4)));
constexpr int BM = 256, BK = 64, HALF = 128, HTB = HALF * BK * 2  , STAGE_BYTES = 8 * HTB, NXCD = 8, WGM = 8;
__host__ __device__ __forceinline__ int lds_byte(int r, int c) { const int st = (r >> 4) * 2 + (c >> 5), rr = r & 15, cc = c & 31, ob = rr * 64 + cc * 2; return st * 1024 + (ob ^ (((ob >> 9) & 1) << 5)); }
__host__ __device__ __forceinline__ void stage_rc(int b, int& R, int& C) { const int st = b / 1024, sb = b % 1024, swz = sb ^ (((sb >> 9) & 1) << 5); R = (st >> 1) * 16 + swz / 64; C = (st & 1) * 32 + (swz % 64) / 2; }
struct Unit { int pm, pn; const char* A; const char* B; const int* gidx; int rows; int e; int base; };
__device__ __forceinline__ unsigned cvt_pk_bf16(float lo, float hi) { unsigned r; asm volatile("v_cvt_pk_bf16_f32 %0, %1, %2" : "=v"(r) : "v"(lo), "v"(hi)); return r; }
template <class Epi, class Sched, bool GATHER, bool ALIGN_EPI>
__device__ __forceinline__ void gemm_phase(PG8_LAS unsigned char* lds, const int K, const Sched& S, const Epi& E) {
    constexpr bool SP2 = true;
    const int tid = threadIdx.x, wid = __builtin_amdgcn_readfirstlane(tid >> 6), lane = tid & 63, wr = wid >> 2, wc = wid & 3, fr = lane & 15, fq = lane >> 4;
    const int nt = K / BK;
    unsigned voffB[2]; int RA[2], CA[2];
#pragma unroll
    for (int i = 0; i < 2; ++i) { int R, C; stage_rc(tid * 16 + i * 8192, R, C); RA[i] = R; CA[i] = C; voffB[i] = (unsigned)(R * K + C) * 2u; }
#define PG8_SETVOFF(dst, u) do { _Pragma("unroll") for (int _h = 0; _h < 2; ++_h) _Pragma("unroll") for (int _i = 0; _i < 2; ++_i) { int _r = _h * HALF + RA[_i]; \
        if constexpr (GATHER) { _r = _r < (u).rows ? _r : (u).rows - 1; _r = (u).gidx[_r] >> 1; } \
        dst[_h][_i] = (unsigned)(_r * K + CA[_i]) * 2u; } } while (0)
    const size_t kstep = (size_t)(BK * 2);
    const size_t hstep = (size_t)HALF * K * 2;
    const unsigned ldsw = (unsigned)wid * 1024u;
    const int aoff = lds_byte(wr * 64 + fr, fq * 8), boff = lds_byte(wc * 32 + fr, fq * 8);
#define PG8_SA(b, h) (((b) * 2 + (h)) * HTB)
#define PG8_SB(b, h) ((4 + (b) * 2 + (h)) * HTB)
#define PG8_STAGE(bufoff, gbase, voff) do { _Pragma("unroll") for (int _i = 0; _i < 2; ++_i) \
        __builtin_amdgcn_global_load_lds((const unsigned*)((const char*)(gbase) + (voff)[_i]), (PG8_LAS unsigned*)(lds + (bufoff) + ldsw + _i * 8192), 16, 0, 0); } while (0)
#define PG8_STAGEA(bufoff, gbase, h) PG8_STAGE(bufoff, gbase, vA[h])
#define PG8_LDA(dst, b, h) do { _Pragma("unroll") for (int m = 0; m < 4; ++m) _Pragma("unroll") for (int k = 0; k < 2; ++k) dst[m][k] = *(const PG8_LAS bf16x8*)(lds + PG8_SA(b, h) + aoff + m * 2048 + k * 1024); } while (0)
#define PG8_LDB(dst, b, h) do { _Pragma("unroll") for (int n = 0; n < 2; ++n) _Pragma("unroll") for (int k = 0; k < 2; ++k) dst[n][k] = *(const PG8_LAS bf16x8*)(lds + PG8_SB(b, h) + boff + n * 2048 + k * 1024); } while (0)
#define PG8_MMA(ai, bj, At, Bt) do { __builtin_amdgcn_s_setprio(1); _Pragma("unroll") for (int m = 0; m < 4; ++m) _Pragma("unroll") for (int n = 0; n < 2; ++n) _Pragma("unroll") for (int k = 0; k < 2; ++k) \
        acc[ai][bj][m][n] = __builtin_amdgcn_mfma_f32_16x16x32_bf16(Bt[n][k], At[m][k], acc[ai][bj][m][n], 0, 0, 0); __builtin_amdgcn_s_setprio(0); } while (0)
#define PG8_WAIT_V(n) asm volatile("s_waitcnt vmcnt(" #n ")" ::: "memory")
#define PG8_WAIT_L(n) asm volatile("s_waitcnt lgkmcnt(" #n ")" ::: "memory")
#define PG8_BAR __builtin_amdgcn_s_barrier()
#define PG8_SCHED __builtin_amdgcn_sched_barrier(0)
    Unit cur, nxt; int ui = 0;
    if (!S.next(0, cur)) return;
    f32x4 acc[2][2][4][2];
#pragma unroll
    for (int a = 0; a < 2; ++a)
#pragma unroll
        for (int b = 0; b < 2; ++b)
#pragma unroll
            for (int m = 0; m < 4; ++m)
#pragma unroll
                for (int n = 0; n < 2; ++n) acc[a][b][m][n] = (f32x4){0.f, 0.f, 0.f, 0.f};
    bf16x8 At[4][2], B0[2][2], B1[2][2];
    const char* cA = cur.A; const char* cB = cur.B;
    unsigned vA[2][2], vN[2][2];
    PG8_SETVOFF(vA, cur);
    if constexpr (SP2) {
        PG8_STAGE(PG8_SB(0, 0), cB, voffB); PG8_STAGE(PG8_SB(0, 1), cB + hstep, voffB); PG8_STAGEA(PG8_SA(0, 0), cA, 0); PG8_STAGEA(PG8_SA(0, 1), cA, 1);
        if (wr == 1) PG8_BAR;
        PG8_WAIT_V(2); PG8_BAR;
        PG8_STAGE(PG8_SB(1, 0), cB + kstep, voffB); PG8_STAGEA(PG8_SA(1, 0), cA + kstep, 0); PG8_STAGE(PG8_SB(1, 1), cB + hstep + kstep, voffB);
        PG8_WAIT_V(6); PG8_BAR;
    }
    for (;;) {
        const bool has_next = S.next(ui + 1, nxt);
        const char* nA = has_next ? nxt.A : cA; const char* nB = has_next ? nxt.B : cB;
        for (int t = 0; t < nt; t += 2) {
            const bool last = (t == nt - 2);
            const char* a1 = cA + (size_t)(t + 1) * kstep;
            const char* a2 = last ? nA : cA + (size_t)(t + 2) * kstep; const char* b2 = last ? nB : cB + (size_t)(t + 2) * kstep;
            const char* a3 = a2 + kstep; const char* b3 = b2 + kstep;
            if (last) { if (has_next) { PG8_SETVOFF(vN, nxt); } else { _Pragma("unroll") for (int _h = 0; _h < 2; ++_h) _Pragma("unroll") for (int _i = 0; _i < 2; ++_i) vN[_h][_i] = vA[_h][_i]; } }
            if constexpr (SP2) {
            PG8_LDB(B0, 0, 0); PG8_LDB(B1, 0, 1); PG8_SCHED; PG8_LDA(At, 0, 0); PG8_STAGEA(PG8_SA(1, 1), a1, 1);
            if (last) { _Pragma("unroll") for (int _h = 0; _h < 2; ++_h) _Pragma("unroll") for (int _i = 0; _i < 2; ++_i) vA[_h][_i] = vN[_h][_i]; }
            PG8_WAIT_V(8); PG8_WAIT_L(0); PG8_BAR; PG8_MMA(0, 0, At, B0); PG8_MMA(0, 1, At, B1); PG8_BAR; PG8_SCHED;
            PG8_LDA(At, 0, 1); PG8_STAGE(PG8_SB(0, 0), b2, voffB); PG8_STAGE(PG8_SB(0, 1), b2 + hstep, voffB); PG8_STAGEA(PG8_SA(0, 0), a2, 0);
            PG8_WAIT_V(8); PG8_WAIT_L(0); PG8_BAR; PG8_MMA(1, 0, At, B0); PG8_MMA(1, 1, At, B1); PG8_BAR; PG8_SCHED;
            PG8_LDB(B0, 1, 0); PG8_LDB(B1, 1, 1); PG8_SCHED; PG8_LDA(At, 1, 0); PG8_STAGEA(PG8_SA(0, 1), a2, 1);
            PG8_WAIT_V(8); PG8_WAIT_L(0); PG8_BAR; PG8_MMA(0, 0, At, B0); PG8_MMA(0, 1, At, B1); PG8_BAR; PG8_SCHED;
            PG8_LDA(At, 1, 1); PG8_STAGE(PG8_SB(1, 0), b3, voffB); PG8_STAGE(PG8_SB(1, 1), b3 + hstep, voffB); PG8_STAGEA(PG8_SA(1, 0), a3, 0);
            PG8_WAIT_V(8); PG8_WAIT_L(0); PG8_BAR; PG8_MMA(1, 0, At, B0); PG8_MMA(1, 1, At, B1); PG8_BAR; PG8_SCHED;
            }
        }
        if constexpr (ALIGN_EPI) { if (wr == 0) PG8_BAR; }
        E(acc, cur, wr, wc, fr, fq);
        if (!has_next) break;
#pragma unroll
        for (int a = 0; a < 2; ++a)
#pragma unroll
            for (int b = 0; b < 2; ++b)
#pragma unroll
                for (int m = 0; m < 4; ++m)
#pragma unroll
                    for (int n = 0; n < 2; ++n) acc[a][b][m][n] = (f32x4){0.f, 0.f, 0.f, 0.f};
        cur = nxt; cA = nA; cB = nB; ++ui;
        if constexpr (ALIGN_EPI) { if (wr == 1) PG8_BAR; }
    }
    PG8_WAIT_V(0);
    if constexpr (!ALIGN_EPI) { if (wr == 0) PG8_BAR; }
    PG8_BAR;
#undef PG8_SA
#undef PG8_SB
#undef PG8_STAGE
#undef PG8_STAGEA
#undef PG8_SETVOFF
#undef PG8_LDA
#undef PG8_LDB
#undef PG8_MMA
#undef PG8_WAIT_V
#undef PG8_WAIT_L
#undef PG8_BAR
#undef PG8_SCHED
}
}
#include <hip/hip_bf16.h>
#include <cmath>
namespace attn_body {
using bf16=__hip_bfloat16;
using bf16x8=__attribute__((ext_vector_type(8)))short;
using s16x4=__attribute__((ext_vector_type(4)))short;
using f32x16=__attribute__((ext_vector_type(16)))float;
using u32x4=__attribute__((ext_vector_type(4)))unsigned;
constexpr int SEQ=2048,D=64,QKP=512,VP=512,OP=1024;
constexpr int NW=8,QBLK=32,QB=QBLK*NW,KVBLK=64,NQB=SEQ/QB;
constexpr int ATTN_UNIT_ROWS=QB;
__device__ __forceinline__ int crow(int r,int hi){return (r&3)+8*(r>>2)+4*hi;}
#define SBAR() __builtin_amdgcn_sched_barrier(0)
__device__ __forceinline__ void cmask(f32x16&p0,f32x16&p1,int jb,int qrel,int hi){
  const float NEG=-INFINITY; int kb=64*jb+4*hi;
  #pragma unroll
  for(int r=0;r<16;++r){int kv=kb+(r&3)+8*(r>>2); if(kv>qrel)p0[r]=NEG; if(kv+32>qrel)p1[r]=NEG;}
}

constexpr int NSLOT=3, SLOTB=8192;
constexpr int LDS_K=0, LDS_V=NSLOT*SLOTB, LDS_WS=2*NSLOT*SLOTB, LDS_OST=LDS_WS+NW*64*4, LDS_BYTES=LDS_OST+NW*4096;
constexpr float C2=0.125f*1.4426950408889634f;
__device__ __forceinline__ void glds16(const void*gsrc,unsigned lds_dst){unsigned keep;
  asm volatile("s_mov_b32 %0, m0\n\ts_mov_b32 m0, %2\n\ts_nop 0\n\tglobal_load_lds_dwordx4 %1, off\n\ts_mov_b32 m0, %0":"=&s"(keep):"v"(gsrc),"s"(lds_dst):"memory");}
__device__ __forceinline__ float max3f(float a,float b,float c){float r;asm("v_max3_f32 %0, %1, %2, %3":"=v"(r):"v"(a),"v"(b),"v"(c));return r;}
__device__ __forceinline__ float max2f(float a,float b){float r;asm("v_max_f32_e32 %0, %1, %2":"=v"(r):"v"(a),"v"(b));return r;}
__device__ __forceinline__ float fadd_s(float a,float b){float r;asm("v_add_f32_e32 %0, %1, %2":"=v"(r):"v"(a),"v"(b));return r;}
__device__ __forceinline__ float fsub_s(float a,float b){float r;asm("v_sub_f32_e32 %0, %1, %2":"=v"(r):"v"(a),"v"(b));return r;}
typedef float f32x2_t __attribute__((ext_vector_type(2))); typedef __bf16 bf16x2_t __attribute__((ext_vector_type(2)));
__device__ __forceinline__ unsigned cvtpk_s(float lo,float hi){f32x2_t v={lo,hi};bf16x2_t b=__builtin_convertvector(v,bf16x2_t);return __builtin_bit_cast(unsigned,b);}
#define WAIT_BAR(N) asm volatile("s_waitcnt vmcnt(" #N ") lgkmcnt(0)\n\ts_barrier":::"memory")

__device__ __forceinline__ void qkt(f32x16&p0,f32x16&p1,const char*Kslot,const bf16x8*qr,const f32x16&negm,int r32,int hi){
  const char*kb=Kslot+hi*1024+r32*16;
  #pragma unroll
  for(int d0=0;d0<4;++d0){
    const bf16x8 b0=*reinterpret_cast<const bf16x8*>(kb+d0*2048);
    const bf16x8 b1=*reinterpret_cast<const bf16x8*>(kb+d0*2048+512);
    if(d0==0){p0=__builtin_amdgcn_mfma_f32_32x32x16_bf16(b0,qr[0],negm,0,0,0);p1=__builtin_amdgcn_mfma_f32_32x32x16_bf16(b1,qr[0],negm,0,0,0);}
    else{p0=__builtin_amdgcn_mfma_f32_32x32x16_bf16(b0,qr[d0],p0,0,0,0);p1=__builtin_amdgcn_mfma_f32_32x32x16_bf16(b1,qr[d0],p1,0,0,0);}}
}
typedef __attribute__((address_space(3))) const char* lds_cptr;
typedef short v4i16_t __attribute__((ext_vector_type(4)));
__device__ __forceinline__ void kload8(bf16x8*kf,lds_cptr kp){
  kf[0]=*(const __attribute__((address_space(3))) bf16x8*)(kp);      kf[1]=*(const __attribute__((address_space(3))) bf16x8*)(kp+512);
  kf[2]=*(const __attribute__((address_space(3))) bf16x8*)(kp+2048); kf[3]=*(const __attribute__((address_space(3))) bf16x8*)(kp+2560);
  kf[4]=*(const __attribute__((address_space(3))) bf16x8*)(kp+4096); kf[5]=*(const __attribute__((address_space(3))) bf16x8*)(kp+4608);
  kf[6]=*(const __attribute__((address_space(3))) bf16x8*)(kp+6144); kf[7]=*(const __attribute__((address_space(3))) bf16x8*)(kp+6656);
}
__device__ __forceinline__ void kload2(bf16x8*kf,lds_cptr kp,int j){ kf[2*j]=*(const __attribute__((address_space(3))) bf16x8*)(kp+j*2048); kf[2*j+1]=*(const __attribute__((address_space(3))) bf16x8*)(kp+j*2048+512); }
__device__ __forceinline__ s16x4 vtr(lds_cptr p){ return __builtin_bit_cast(s16x4,__builtin_amdgcn_ds_read_tr16_b64_v4i16((__attribute__((address_space(3))) v4i16_t*)p)); }
__device__ __forceinline__ float rowmax(const f32x16&p0,const f32x16&p1){
  float a=max3f(p0[0],p0[1],p1[0]),b=max3f(p0[2],p0[3],p1[1]);a=max3f(a,p1[2],p1[3]);
  #pragma unroll
  for(int r=4;r<16;r+=4){a=max3f(a,p0[r],p0[r+1]);b=max3f(b,p0[r+2],p0[r+3]);a=max3f(a,p1[r],p1[r+1]);b=max3f(b,p1[r+2],p1[r+3]);}
  const float m=max2f(a,b);
  auto rr=__builtin_amdgcn_permlane32_swap(__float_as_uint(m),__float_as_uint(m),false,false);
  return max2f(__uint_as_float(rr[0]),__uint_as_float(rr[1]));
}
__device__ __forceinline__ void pv(f32x16*o,int vb,bf16x8 pa0,bf16x8 pa1,bf16x8 pa2,bf16x8 pa3){
  #pragma unroll
  for(int d0=0;d0<2;++d0){s16x4 lo[4],hi[4];
    #pragma unroll
    for(int ks=0;ks<4;++ks){
      asm volatile("ds_read_b64_tr_b16 %0,%1 offset:%c2":"=&v"(lo[ks]):"v"(vb),"i"(d0*4096+ks*1024):"memory");
      asm volatile("ds_read_b64_tr_b16 %0,%1 offset:%c2":"=&v"(hi[ks]):"v"(vb),"i"(d0*4096+ks*1024+512):"memory");}
    asm volatile("s_waitcnt lgkmcnt(0)":::"memory");SBAR();
    #define PK(k) (bf16x8){lo[k][0],lo[k][1],lo[k][2],lo[k][3],hi[k][0],hi[k][1],hi[k][2],hi[k][3]}
    o[d0]=__builtin_amdgcn_mfma_f32_32x32x16_bf16(pa0,PK(0),o[d0],0,0,0);
    o[d0]=__builtin_amdgcn_mfma_f32_32x32x16_bf16(pa1,PK(1),o[d0],0,0,0);
    o[d0]=__builtin_amdgcn_mfma_f32_32x32x16_bf16(pa2,PK(2),o[d0],0,0,0);
    o[d0]=__builtin_amdgcn_mfma_f32_32x32x16_bf16(pa3,PK(3),o[d0],0,0,0);
    #undef PK
  }
}

#ifndef ATTN_STORE16
#define ATTN_STORE16(p,v) (*(u32x4*)(p)=(v))
#endif
template<int THRL> __device__ __forceinline__ void attn_unit(int b,int qcol,int vcol,int ocol,int qb,const bf16*Q,const bf16*__restrict__ K,const bf16*__restrict__ V,bf16*O,char*shm){
  const int tid=threadIdx.x,lane=tid&63,r32=lane&31,hi=lane>>5; const int wid=__builtin_amdgcn_readfirstlane(tid>>6);
  const long rowbase=(long)b*SEQ; const int q0=qb*QB;
  const bf16*Qw=Q+(rowbase+q0+wid*QBLK)*QKP+qcol;
  const bf16*Kh=K+rowbase*QKP+qcol,*Vh=V+rowbase*VP+vcol;
  const unsigned lds0=(unsigned)(uintptr_t)shm;
  float*wsf=(float*)(shm+LDS_WS)+wid*64;
  const bf16*ksrc=Kh+(long)lane*QKP+wid*8;
  const bf16*vsrc=Vh+(long)(16*(wid&3)+(lane>>2))*VP+(wid>>2)*32+(lane&3)*8;
  const unsigned kdst=lds0+LDS_K+wid*1024, vdst=lds0+LDS_V+wid*1024;
  #define DMA_K(t,slot) glds16(ksrc+(long)(t)*KVBLK*QKP,(unsigned)__builtin_amdgcn_readfirstlane(kdst+(slot)))
  #define DMA_V(t,slot) glds16(vsrc+(long)(t)*KVBLK*VP,(unsigned)__builtin_amdgcn_readfirstlane(vdst+(slot)))
  const int vb0=(int)(lds0+LDS_V)+((lane>>4)&1)*32+(lane&3)*8+(4*hi+((lane&15)>>2))*64;
  const char*Kbase=shm+LDS_K; bf16x8 kf[8];
  const lds_cptr shm3=(lds_cptr)shm; const lds_cptr kp0=shm3+LDS_K+hi*1024+r32*16; const lds_cptr vp0=shm3+LDS_V+((lane>>4)&1)*32+(lane&3)*8+(4*hi+((lane&15)>>2))*64;
  const int NT=(q0+QB)/KVBLK;
  DMA_K(0,0);DMA_V(0,0);DMA_K(1,SLOTB);
  bf16x8 qr[4];
  #pragma unroll
  for(int d0=0;d0<4;++d0)qr[d0]=*reinterpret_cast<const bf16x8*>(&Qw[(long)r32*QKP+d0*16+hi*8]);
  float mhat=0.f,l_reg=0.f;f32x16 o[2];o[0]=f32x16{};o[1]=f32x16{};f32x16 negm=f32x16{};asm volatile("":"+v"(negm));
  const int qrel=wid*QBLK+r32;
  #define CMASK(P0,P1,t) do{int jb_=(t)-(NT-4); if(jb_>=0)cmask(P0,P1,jb_,qrel,hi);}while(0)
  bool resc=false;
  #define START(P0,P1) do{ const float rm=rowmax(P0,P1); resc=false; \
    { const float dl=rm; mhat=fadd_s(mhat,dl); \
      _Pragma("unroll") for(int r=0;r<16;++r){P0[r]=fsub_s(P0[r],dl);P1[r]=fsub_s(P1[r],dl);} \
      _Pragma("unroll") for(int r=0;r<16;++r)negm[r]=-mhat; asm volatile("":"+v"(negm)); } \
    _Pragma("unroll") for(int r=0;r<16;++r)P0[r]=__builtin_amdgcn_exp2f(P0[r]); }while(0)
  #define RESC() do{ if(resc){ asm volatile("s_waitcnt lgkmcnt(0)":::"memory"); \
      _Pragma("unroll") for(int d_=0;d_<2;++d_) _Pragma("unroll") for(int r=0;r<16;++r)o[d_][r]*=wsf[crow(r,hi)]; } }while(0)
  f32x16 pA0,pA1,pB0,pB1;
  int sl_prev=0,sl_cur=0,sl_next=SLOTB;
  #define ROT() do{sl_prev=sl_cur;sl_cur=sl_next;sl_next=(sl_next==(NSLOT-1)*SLOTB)?0:sl_next+SLOTB;}while(0)
  DMA_K(2,2*SLOTB);
  WAIT_BAR(3);
  qkt(pA0,pA1,Kbase,qr,negm,r32,hi);asm volatile("s_nop 15\n\ts_nop 7":"+v"(pA0),"+v"(pA1));CMASK(pA0,pA1,0);
  START(pA0,pA1);
  _Pragma("unroll") for(int r=0;r<16;++r)pA1[r]=__builtin_amdgcn_exp2f(pA1[r]);
  WAIT_BAR(0);
  DMA_K(3,0);DMA_V(1,SLOTB);
  ROT();
  kload8(kf,kp0+sl_cur);
  WAIT_BAR(2);
  s16x4 vlo[8],vhi[8]; u32x4 pw0,pw1,pw2,pw3;
  #define PKW(P,B) cvtpk_s(P[B],P[B+1])
  #define PAF(k) __builtin_bit_cast(bf16x8,pw##k)
  #define VFR(i) (bf16x8){vlo[i][0],vlo[i][1],vlo[i][2],vlo[i][3],vhi[i][0],vhi[i][1],vhi[i][2],vhi[i][3]}
  #define PIN(x) asm volatile("":"+v"(x))
  #define MX3(a,b,c) __builtin_fmaxf(__builtin_fmaxf((a),(b)),(c))
  #define GAPA(MF,A0,A1,A2,A3,W0,W1,PW) do{ MF; sacc+=A0; sacc+=A1; sacc+=A2; sacc+=A3; PIN(sacc); W0; W1; PIN(PW); SBAR(); }while(0)
  #define EX(v) __builtin_amdgcn_exp2f(v)
  #define GAPB(MF,X,B) do{ MF; X[B]=EX(X[B]); X[B+1]=EX(X[B+1]); X[B+2]=EX(X[B+2]); X[B+3]=EX(X[B+3]); PIN(X); SBAR(); }while(0)
  #define VRD(i) do{ vlo[i]=vtr(vp_+(((i)>>2)*4096+((i)&3)*1024)); vhi[i]=vtr(vp_+(((i)>>2)*4096+((i)&3)*1024+512)); }while(0)
  #define KRD(G,j) do{ if(G){ kload2(kf,kp0+sl_next,j); SBAR(); } }while(0)
  #define STEP(C0,C1,P0,P1,t,GK,GV,GL) do{ SBAR(); \
    const lds_cptr vp_=vp0+sl_prev; \
    VRD(0); SBAR(); float sacc=(P0[0]+P0[1]); \
    GAPA(C0=__builtin_amdgcn_mfma_f32_32x32x16_bf16(kf[0],qr[0],negm,0,0,0), P0[2],P0[3],P0[4],P0[5],     pw0[0]=PKW(P0,0), pw0[1]=PKW(P0,2), pw0); \
    VRD(4); SBAR(); GAPA(C1=__builtin_amdgcn_mfma_f32_32x32x16_bf16(kf[1],qr[0],negm,0,0,0), P0[6],P0[7],P0[8],P0[9],     pw0[2]=PKW(P0,4), pw0[3]=PKW(P0,6), pw0); \
    VRD(1); SBAR(); GAPA(C0=__builtin_amdgcn_mfma_f32_32x32x16_bf16(kf[2],qr[1],C0,0,0,0),   P0[10],P0[11],P0[12],P0[13], pw1[0]=PKW(P0,8), pw1[1]=PKW(P0,10), pw1); \
    VRD(5); SBAR(); GAPA(C1=__builtin_amdgcn_mfma_f32_32x32x16_bf16(kf[3],qr[1],C1,0,0,0),   P0[14],P0[15],P1[0],P1[1],   pw1[2]=PKW(P0,12),pw1[3]=PKW(P0,14), pw1); \
    VRD(2); SBAR(); GAPA(C0=__builtin_amdgcn_mfma_f32_32x32x16_bf16(kf[4],qr[2],C0,0,0,0),   P1[2],P1[3],P1[4],P1[5],     pw2[0]=PKW(P1,0), pw2[1]=PKW(P1,2), pw2); \
    VRD(6); SBAR(); GAPA(C1=__builtin_amdgcn_mfma_f32_32x32x16_bf16(kf[5],qr[2],C1,0,0,0),   P1[6],P1[7],P1[8],P1[9],     pw2[2]=PKW(P1,4), pw2[3]=PKW(P1,6), pw2); \
    VRD(3); SBAR(); GAPA(C0=__builtin_amdgcn_mfma_f32_32x32x16_bf16(kf[6],qr[3],C0,0,0,0),   P1[10],P1[11],P1[12],P1[13], pw3[0]=PKW(P1,8), pw3[1]=PKW(P1,10), pw3); \
    VRD(7); SBAR(); GAPA(C1=__builtin_amdgcn_mfma_f32_32x32x16_bf16(kf[7],qr[3],C1,0,0,0),   P1[14],P1[15],0.f,0.f,       pw3[2]=PKW(P1,12),pw3[3]=PKW(P1,14), pw3); \
    l_reg+=sacc; \
    if(GK){DMA_K((t)+3,sl_cur);} if(GV){DMA_V((t)+1,sl_next);} \
    CMASK(C0,C1,t); \
    { float a=MX3(C0[0],C0[1],C1[0]),b=MX3(C0[2],C0[3],C1[1]); a=MX3(a,C1[2],C1[3]); \
      _Pragma("unroll") for(int r=4;r<16;r+=4){a=MX3(a,C0[r],C0[r+1]);b=MX3(b,C0[r+2],C0[r+3]);a=MX3(a,C1[r],C1[r+1]);b=MX3(b,C1[r+2],C1[r+3]);} \
      float rm=__builtin_fmaxf(a,b); { auto rr=__builtin_amdgcn_permlane32_swap(__float_as_uint(rm),__float_as_uint(rm),false,false); rm=__builtin_fmaxf(__uint_as_float(rr[0]),__uint_as_float(rr[1])); } \
      resc=false; \
      if(__builtin_expect(__any(rm>(float)THRL),0)){ const float dl=__builtin_fmaxf(rm,0.f); mhat+=dl; \
        _Pragma("unroll") for(int r=0;r<16;++r){C0[r]-=dl;C1[r]-=dl;} \
        _Pragma("unroll") for(int r=0;r<16;++r)negm[r]=-mhat; asm volatile("":"+v"(negm)); \
        const float f=__builtin_amdgcn_exp2f(-dl); l_reg*=f; if(hi==0)wsf[r32]=f; resc=true; } } \
    SBAR(); \
    GAPB(o[0]=__builtin_amdgcn_mfma_f32_32x32x16_bf16(PAF(0),VFR(0),o[0],0,0,0), C0,0); \
    GAPB(o[1]=__builtin_amdgcn_mfma_f32_32x32x16_bf16(PAF(0),VFR(4),o[1],0,0,0), C0,4); \
    KRD(GL,0); GAPB(o[0]=__builtin_amdgcn_mfma_f32_32x32x16_bf16(PAF(1),VFR(1),o[0],0,0,0), C0,8); \
    KRD(GL,1); GAPB(o[1]=__builtin_amdgcn_mfma_f32_32x32x16_bf16(PAF(1),VFR(5),o[1],0,0,0), C0,12); \
    KRD(GL,2); GAPB(o[0]=__builtin_amdgcn_mfma_f32_32x32x16_bf16(PAF(2),VFR(2),o[0],0,0,0), C1,0); \
    KRD(GL,3); GAPB(o[1]=__builtin_amdgcn_mfma_f32_32x32x16_bf16(PAF(2),VFR(6),o[1],0,0,0), C1,4); \
    GAPB(o[0]=__builtin_amdgcn_mfma_f32_32x32x16_bf16(PAF(3),VFR(3),o[0],0,0,0), C1,8); \
    GAPB(o[1]=__builtin_amdgcn_mfma_f32_32x32x16_bf16(PAF(3),VFR(7),o[1],0,0,0), C1,12); \
    }while(0)
  int t=1;
  #undef CMASK
  #define CMASK(P0,P1,t) do{}while(0)
  for(;t+5<NT;t+=2){
    STEP(pB0,pB1,pA0,pA1,t,true,true,true);     WAIT_BAR(2); RESC(); ROT();
    STEP(pA0,pA1,pB0,pB1,t+1,true,true,true);   WAIT_BAR(2); RESC(); ROT();
  }
  #undef CMASK
  #define CMASK(P0,P1,t) do{int jb_=(t)-(NT-4); if(jb_>=0)cmask(P0,P1,jb_,qrel,hi);}while(0)
  #define ENDW(tt) do{ if((tt)+3<NT){WAIT_BAR(2);} else if((tt)+2<NT){WAIT_BAR(1);} else {WAIT_BAR(0);} }while(0)
  for(;t+1<NT;t+=2){
    STEP(pB0,pB1,pA0,pA1,t,(t+3<NT),(t+1<NT),(t+1<NT));       ENDW(t);   RESC(); ROT();
    STEP(pA0,pA1,pB0,pB1,t+1,(t+4<NT),(t+2<NT),(t+2<NT));     ENDW(t+1); RESC(); ROT();
  }
  STEP(pB0,pB1,pA0,pA1,NT-1,false,false,false); RESC();
  { float sacc=pB0[0]+pB0[1]; _Pragma("unroll") for(int r=2;r<16;++r)sacc+=pB0[r]; _Pragma("unroll") for(int r=0;r<16;++r)sacc+=pB1[r]; l_reg+=sacc;
    pw0=(u32x4){PKW(pB0,0),PKW(pB0,2),PKW(pB0,4),PKW(pB0,6)};pw1=(u32x4){PKW(pB0,8),PKW(pB0,10),PKW(pB0,12),PKW(pB0,14)};pw2=(u32x4){PKW(pB1,0),PKW(pB1,2),PKW(pB1,4),PKW(pB1,6)};pw3=(u32x4){PKW(pB1,8),PKW(pB1,10),PKW(pB1,12),PKW(pB1,14)};
    SBAR(); pv(o,vb0+sl_cur,PAF(0),PAF(1),PAF(2),PAF(3)); }
  #undef PKW
  #undef PAF
  #undef VFR
  #undef PIN
  #undef MX3
  #undef GAPA
  #undef GAPB
  #undef EX
  #undef VRD
  #undef KRD
  #undef STEP
  #undef ENDW
  {auto rr=__builtin_amdgcn_permlane32_swap(__float_as_uint(l_reg),__float_as_uint(l_reg),false,false);l_reg=__uint_as_float(rr[0])+__uint_as_float(rr[1]);}
  if(hi==0)wsf[32+r32]=l_reg;asm volatile("s_waitcnt lgkmcnt(0)":::"memory");
  float rli[16];
  #pragma unroll
  for(int r=0;r<16;++r)rli[r]=__builtin_amdgcn_rcpf(wsf[32+crow(r,hi)]);
  bf16*Ow=O+(rowbase+q0+wid*QBLK)*OP+ocol;
  { bf16*stg=(bf16*)(shm+LDS_OST)+wid*2048;
    #pragma unroll
    for(int r=0;r<16;++r){const int orow=crow(r,hi);
      #pragma unroll
      for(int d0=0;d0<2;++d0)stg[orow*64+d0*32+r32]=__float2bfloat16(o[d0][r]*rli[r]);}
    asm volatile("s_waitcnt lgkmcnt(0)":::"memory");
    #pragma unroll
    for(int i=0;i<4;++i){const int row=i*8+(lane>>3),ch=lane&7; const u32x4 v=*(const u32x4*)(stg+row*64+ch*8); ATTN_STORE16(Ow+(long)row*OP+ch*8,v);} }
  asm volatile("s_waitcnt lgkmcnt(0)\n\ts_barrier":::"memory");
  #undef DMA_K
  #undef DMA_V
  #undef CMASK
  #undef START
  #undef RESC
  #undef ROT
}
constexpr int ATTN_LDS_BYTES=LDS_BYTES;
#undef SBAR
#undef WAIT_BAR
}

#define GAS __attribute__((address_space(1)))
#define LAS __attribute__((address_space(3)))
typedef unsigned short bf16;
typedef unsigned v4u __attribute__((ext_vector_type(4)));
typedef float f32x4 __attribute__((ext_vector_type(4)));
typedef short bf16x8 __attribute__((ext_vector_type(8)));
typedef GAS unsigned gu32;
typedef GAS unsigned long long gu64;
#define RLX_AGENT __ATOMIC_RELAXED, __HIP_MEMORY_SCOPE_AGENT
#define LDS_WAIT() asm volatile("s_waitcnt lgkmcnt(0)" ::: "memory")
#define VM_WAIT() asm volatile("s_waitcnt vmcnt(0)" ::: "memory")
__device__ __forceinline__ unsigned long long rt() { return __builtin_amdgcn_s_memrealtime(); }
__device__ __forceinline__ unsigned f2bf(float f) { unsigned u = __builtin_bit_cast(unsigned, f); return (u + 0x7fffu + ((u >> 16) & 1u)) >> 16; }
__device__ __forceinline__ unsigned pk2(float lo, float hi) { return f2bf(lo) | (f2bf(hi) << 16); }

#define XB_TMO      128
#define XB_XCNT(j)  (256  + 64 * (j))
#define XB_XSUB(j)  (1280 + 64 * (j))
#define XB_XGEN(j)  (2304 + 64 * (j))
#define XB_TOP      3328
#define XB_TOPGEN   3392
#define XCD_BAR_WORDS 3456
#define XB_SPIN_CAP (1u << 18)

__device__ __forceinline__ unsigned xb_ld(unsigned* p)              { return __hip_atomic_load(p, __ATOMIC_RELAXED, __HIP_MEMORY_SCOPE_AGENT); }
__device__ __forceinline__ unsigned xb_add(unsigned* p, unsigned v) { return __hip_atomic_fetch_add(p, v, __ATOMIC_RELAXED, __HIP_MEMORY_SCOPE_AGENT); }
__device__ __forceinline__ unsigned xb_xcc_id() { return (unsigned)__builtin_amdgcn_s_getreg((3 << 11) | 20) & 0xFu; }
#define XB_SPIN(cond, bar) do { unsigned _sp = 0; while (cond) { __builtin_amdgcn_s_sleep(1); \
    if ((++_sp & 255u) == 0u) { if (xb_ld(&(bar)[XB_TMO])) break; if (_sp > XB_SPIN_CAP) { atomicAdd(&(bar)[XB_TMO], 1u); break; } } } } while (0)

struct XcdBarrier {
    unsigned* bar; unsigned x;
    volatile LAS unsigned* st;
};

__device__ __forceinline__ XcdBarrier xcd_barrier_post(unsigned* bar, volatile LAS unsigned* st) {
    XcdBarrier b; b.bar = bar; b.x = xb_xcc_id(); b.st = st;
    if (threadIdx.x == 0) (void)xb_add(&bar[XB_XCNT(b.x)], 1u);
    return b;
}
__device__ __forceinline__ void xcd_barrier_complete(unsigned* bar, unsigned x, unsigned& nloc, unsigned& nx) {
    const unsigned G = gridDim.x * gridDim.y * gridDim.z;
    unsigned sum, cnt, mine, sp = 0u;
    for (;;) {
        sum = 0u; cnt = 0u; mine = 0u;
#pragma unroll
        for (unsigned j = 0; j < 16; ++j) { const unsigned c = xb_ld(&bar[XB_XCNT(j)]); sum += c; cnt += (c > 0u) ? 1u : 0u; mine = (j == x) ? c : mine; }
        if (sum == G) break;
        __builtin_amdgcn_s_sleep(1);
        if ((++sp & 255u) == 0u) { if (xb_ld(&bar[XB_TMO])) break; if (sp > XB_SPIN_CAP) { atomicAdd(&bar[XB_TMO], 1u); break; } }
    }
    nloc = mine > 0u ? mine : 1u; nx = cnt > 0u ? cnt : 1u;
}

__device__ __forceinline__ void xcd_barrier(const XcdBarrier& b) {
    asm volatile("s_waitcnt vmcnt(0)" ::: "memory");
    __syncthreads();
    if (threadIdx.x == 0) {
        unsigned* bar = b.bar;
        __builtin_amdgcn_s_waitcnt(0);
        unsigned nloc = b.st[0], nx = b.st[1];
        if (nloc == 0u) { xcd_barrier_complete(bar, b.x, nloc, nx); b.st[0] = nloc; b.st[1] = nx; }
        const unsigned old = xb_add(&bar[XB_XSUB(b.x)], 1u);
        const unsigned gen = old / nloc;
        if (old + 1u == (gen + 1u) * nloc) {
            __builtin_amdgcn_fence(__ATOMIC_RELEASE, "agent");
            asm volatile("s_waitcnt vmcnt(0)" ::: "memory");
            const unsigned og = xb_add(&bar[XB_TOP], 1u);
            const unsigned tg = og / nx;
            if (og + 1u == (tg + 1u) * nx) xb_add(&bar[XB_TOPGEN], 1u);
            else XB_SPIN(xb_ld(&bar[XB_TOPGEN]) == tg, bar);
            __builtin_amdgcn_fence(__ATOMIC_ACQUIRE, "agent");
            xb_add(&bar[XB_XGEN(b.x)], 1u);
            asm volatile("s_waitcnt vmcnt(0)" ::: "memory");
        } else {
            XB_SPIN(xb_ld(&bar[XB_XGEN(b.x)]) == gen, bar);
            __builtin_amdgcn_fence(__ATOMIC_ACQUIRE, "agent");
            asm volatile("s_waitcnt vmcnt(0)" ::: "memory");
        }
    }
    __syncthreads();
}

constexpr int NWAVES = 8;
constexpr int D = 1024, NB = 8, SEQ = 2048, M = NB * SEQ, NPROJ = 3584, NE = 32, FF = 512, NCH = SEQ / 64, NMOD = 6 * D;
constexpr int LCAP = 16384;
constexpr float RMS_EPS = 1e-6f, SUBLN_EPS = 1e-5f, LAMBDA_INIT = 0.2f;
#ifndef MK_N_LAUNCHES
#define MK_N_LAUNCHES 1
#endif
constexpr int NPH = 11;
constexpr size_t MiB = 1u << 20;
constexpr size_t WS_CTL = 0, CTL_ZERO_BYTES = 1 * MiB;
constexpr size_t WS_MOD = 1 * MiB;
constexpr size_t WS_EL = 1 * MiB + 512 * 1024;
constexpr size_t WS_ELIST = 2 * MiB, WS_WLIST = 4 * MiB;
constexpr size_t WS_WIN = 6 * MiB;
constexpr size_t WS_WOUT = 13 * MiB;
constexpr size_t WS_WGU = 16 * MiB;
constexpr size_t WS_UST = 16 * MiB;
constexpr size_t WS_WD = 80 * MiB;
constexpr size_t WS_MIXED = 80 * MiB;
constexpr size_t WS_RA = 112 * MiB;
constexpr size_t WS_Q = 144 * MiB, WS_K = 160 * MiB, WS_V = 176 * MiB, WS_QP = 192 * MiB, WS_KP = 208 * MiB, WS_VI = 224 * MiB, WS_SG = 240 * MiB;
constexpr size_t WS_PART = 144 * MiB;
constexpr size_t WS_HID = 208 * MiB;
constexpr size_t WS_END = 256 * MiB;
constexpr int CW_BAR = 4096;
constexpr int CW_CNT = 8192;
constexpr int RING_BYTES = 131072;
constexpr int LDSCTL_OFF = 147456;
constexpr int MISC_OFF = LDSCTL_OFF + 320;
constexpr int SCHED_OFF = LDSCTL_OFF + 1024;
constexpr int LDS_BYTES = 163840;

typedef unsigned u32x2v __attribute__((ext_vector_type(2)));
__device__ __forceinline__ float wave_sum(float v) {
#pragma unroll
    for (int o = 1; o < 64; o <<= 1) v += __shfl_xor(v, o);
    return v;
}
__device__ __forceinline__ float bf_lo(unsigned w) { return __uint_as_float(w << 16); }
__device__ __forceinline__ float bf_hi(unsigned w) { return __uint_as_float(w & 0xffff0000u); }
__device__ __forceinline__ float sigmoidf_(float x) { return 1.f / (1.f + __expf(-x)); }

struct Args { const float* in[24]; float* out; unsigned char* ws; int ph_lo, ph_hi; };

struct DenseOrder {
    int nM, nN, nwg, G, c; const char* Abase; const char* Bbase; size_t tstep; int pn_off, pn_cut, pn_shift;
    __device__ __forceinline__ void init(int M_, int N_, int K_, int G_, int c_, const void* A_, const void* B_, int off_ = 0, int cut_ = 1 << 30, int shift_ = 0) { nM = M_ / 256; nN = N_ / 256; nwg = nM * nN; G = G_; c = c_; Abase = (const char*)A_; Bbase = (const char*)B_; tstep = (size_t)256 * K_ * 2; pn_off = off_; pn_cut = cut_; pn_shift = shift_; }
    __device__ __forceinline__ bool next(int i, pg8::Unit& u) const {
        const long L = (long)i * G + c; if (L >= nwg) return false;
        int wgid = (int)L; { const int q = nwg / 8, r = nwg % 8, xcd = wgid % 8, off = wgid / 8; wgid = (xcd < r ? xcd * (q + 1) : r * (q + 1) + (xcd - r) * q) + off; }
        const int nig = 8 * nN, gid = wgid / nig, fm = gid * 8, gsz = (nM - fm) < 8 ? (nM - fm) : 8;
        u.pm = fm + ((wgid % nig) % gsz); { const int idx = (wgid % nig) / gsz; u.pn = idx + pn_off + (idx >= pn_cut ? pn_shift : 0); }
        u.A = Abase + (size_t)u.pm * tstep; u.B = Bbase + (size_t)u.pn * tstep; u.gidx = nullptr; u.rows = 256; u.e = 0; u.base = 0; return true;
    }
};
struct MoeOrder {
    const LAS int* tab; int G, c; int down; const char* Abase; const char* Bbase; const int* elist;
    __device__ __forceinline__ bool next(int i, pg8::Unit& u) const {
#ifndef MOE_REP
#define MOE_REP 1
#endif
        int L = i * G + c; const int T = tab[32];
        if (L >= T * 4 * MOE_REP) return false;
        if (MOE_REP > 1 && L >= T * 4) L -= T * 4;
        const int tile = L >> 2, sub = L & 3; int e = 0;
#pragma unroll 1
        for (int j = 1; j < 32; ++j) e = (tab[j] <= tile) ? j : e;
        const int rt = tile - tab[e], cnt = tab[66 + e], rb = tab[33 + e] + 256 * rt;
        u.pm = rt; u.pn = sub; u.e = e; u.base = rb; u.rows = (cnt - 256 * rt) < 256 ? (cnt - 256 * rt) : 256; u.gidx = elist + e * LCAP + 256 * rt;
        if (down) { u.A = Abase + (size_t)rb * (FF * 2); u.B = Bbase + ((size_t)e * 1024 + 256 * sub) * (FF * 2); }
        else      { u.A = Abase;                          u.B = Bbase + ((size_t)(e * 4 + sub) * 256) * (D * 2); }
        return true;
    }
};
__device__ __forceinline__ void sched_tables(LAS int* tab, gu32* cntw, int tid) {
    if (tid == 0) { int ts = 0, rb = 0;
        for (int e = 0; e < 32; ++e) { int cn = (int)__hip_atomic_load(cntw + 64 * e, RLX_AGENT); cn = cn > LCAP ? LCAP : cn; tab[e] = ts; tab[33 + e] = rb; tab[66 + e] = cn; ts += (cn + 255) >> 8; rb += cn; }
        tab[32] = ts; tab[65] = rb; }
    __syncthreads();
}

using pg8::u32x4; using pg8::cvt_pk_bf16;
__device__ __forceinline__ float silu_(float v) { return v / (1.f + __expf(-v)); }
constexpr float QSCALE = 0.125f * 1.4426950408889634f;
template <int EMASK> struct EpiInProj {
    bf16* R1; float* EL; const int* pos; const float* lbl;
    static constexpr size_t RSTR = (size_t)M * 512;
    __device__ __forceinline__ void operator()(f32x4 (&acc)[2][2][4][2], const pg8::Unit& u, int wr, int wc, int fr, int fq) const {
        asm volatile("" : "+v"(fr), "+v"(fq));
        const int pn = u.pn, rowb = u.pm * 256 + wr * 64 + fr;
        if ((EMASK & 1) && pn < 4) {
            const int part = pn >> 1, th = pn & 1; bf16* dst = R1 + (size_t)part * RSTR; const float qs = part ? 1.f : QSCALE;
            const int i0 = 16 * (wc & 1) + 4 * fq, dm0 = 32 * (wc & 1) + 8 * fq;
            float invf[4];
#pragma unroll
            for (int j = 0; j < 4; ++j) invf[j] = exp2f(-(float)(i0 + j) * 0.41524101186092029f);
#pragma unroll
            for (int ai = 0; ai < 2; ++ai)
#pragma unroll
                for (int m = 0; m < 4; ++m) { const int row = rowb + ai * 128 + m * 16; const float p = (float)pos[row]; float cs[4], sn[4];
#pragma unroll
                    for (int j = 0; j < 4; ++j) { float rev = p * invf[j] * 0.15915494309189535f; rev -= floorf(rev); sn[j] = __builtin_amdgcn_sinf(rev); cs[j] = __builtin_amdgcn_cosf(rev); }
#pragma unroll
                    for (int bj = 0; bj < 2; ++bj) { const int head = 4 * th + 2 * bj + (wc >> 1); const f32x4 x1 = acc[ai][bj][m][0], x2 = acc[ai][bj][m][1]; float o1[4], o2[4];
#pragma unroll
                        for (int j = 0; j < 4; ++j) { o1[j] = (x1[j] * cs[j] - x2[j] * sn[j]) * qs; o2[j] = (x2[j] * cs[j] + x1[j] * sn[j]) * qs; }
                        u32x4 w; w.x = cvt_pk_bf16(o1[0], o1[1]); w.y = cvt_pk_bf16(o1[2], o1[3]); w.z = cvt_pk_bf16(o2[0], o2[1]); w.w = cvt_pk_bf16(o2[2], o2[3]);
                        *(u32x4*)(dst + (size_t)row * 512 + head * 64 + dm0) = w; } }
        } else if ((EMASK & 2) && (pn < 6 || pn >= 10)) {
            bf16* dst = R1 + (size_t)(pn < 6 ? 2 : (pn < 12 ? 5 : 6)) * RSTR; const int cb = ((pn < 6 ? pn - 4 : (pn < 12 ? pn - 10 : pn - 12)) * 256) + wc * 32 + 8 * fq; const bool act = pn >= 12;
#pragma unroll
            for (int ai = 0; ai < 2; ++ai)
#pragma unroll
                for (int m = 0; m < 4; ++m) { const int row = rowb + ai * 128 + m * 16;
#pragma unroll
                    for (int bj = 0; bj < 2; ++bj) { f32x4 v0 = acc[ai][bj][m][0], v1 = acc[ai][bj][m][1];
                        if (act) {
#pragma unroll
                            for (int j = 0; j < 4; ++j) { v0[j] = silu_(v0[j]); v1[j] = silu_(v1[j]); } }
                        u32x4 w; w.x = cvt_pk_bf16(v0[0], v0[1]); w.y = cvt_pk_bf16(v0[2], v0[3]); w.z = cvt_pk_bf16(v1[0], v1[1]); w.w = cvt_pk_bf16(v1[2], v1[3]);
                        *(u32x4*)(dst + (size_t)row * 512 + cb + bj * 128) = w; } }
        } else if (EMASK & 4) {
            const int hh = pn - 6, k0 = wc * 32 + 8 * fq; float lb[2][4];
#pragma unroll
            for (int n = 0; n < 2; ++n)
#pragma unroll
                for (int j = 0; j < 4; ++j) { const int k = hh * 128 + k0 + 4 * n + j; lb[n][j] = 1.f / (1.f + __expf(lbl[512 + k] - lbl[k])); }
#pragma unroll
            for (int ai = 0; ai < 2; ++ai) {
#pragma unroll
                for (int m = 0; m < 4; ++m)
#pragma unroll
                    for (int n = 0; n < 2; ++n)
#pragma unroll
                        for (int j = 0; j < 4; ++j) { const float f = acc[ai][1][m][n][j]; const float t = __expf(fminf(-f, 80.f)); acc[ai][1][m][n][j] = (1.f - lb[n][j]) * (t / (1.f + t)); }
                const int chunk = u.pm * 4 + ai * 2 + wr;
#pragma unroll
                for (int n = 0; n < 2; ++n)
#pragma unroll
                    for (int j = 0; j < 4; ++j) { float carry = 0.f;
#pragma unroll
                        for (int m = 0; m < 4; ++m) { const float kin = acc[ai][1][m][n][j]; float x = __logf(1.f - kin);
#pragma unroll
                            for (int d = 1; d < 16; d <<= 1) { const float y = __shfl_up(x, d, 16); if (fr >= d) x += y; }
                            x += carry; carry = __shfl(x, 15, 16);
                            acc[ai][0][m][n][j] = silu_(acc[ai][0][m][n][j]) * __expf(x); acc[ai][1][m][n][j] = kin * __expf(-x); }
                        if (fr == 0) EL[(size_t)(chunk * 4 + hh) * 128 + k0 + 4 * n + j] = __expf(carry); }
#pragma unroll
                for (int m = 0; m < 4; ++m) { const int row = rowb + ai * 128 + m * 16; const f32x4 q0 = acc[ai][0][m][0], q1 = acc[ai][0][m][1], k0v = acc[ai][1][m][0], k1v = acc[ai][1][m][1];
                    u32x4 w; w.x = cvt_pk_bf16(q0[0], q0[1]); w.y = cvt_pk_bf16(q0[2], q0[3]); w.z = cvt_pk_bf16(q1[0], q1[1]); w.w = cvt_pk_bf16(q1[2], q1[3]);
                    *(u32x4*)(R1 + 3 * RSTR + (size_t)row * 512 + hh * 128 + k0) = w;
                    w.x = cvt_pk_bf16(k0v[0], k0v[1]); w.y = cvt_pk_bf16(k0v[2], k0v[3]); w.z = cvt_pk_bf16(k1v[0], k1v[1]); w.w = cvt_pk_bf16(k1v[2], k1v[3]);
                    *(u32x4*)(R1 + 4 * RSTR + (size_t)row * 512 + hh * 128 + k0) = w; } }
        }
    }
};
struct EpiOut {
    const float* x; const float* mod; float* out;
    __device__ __forceinline__ void operator()(f32x4 (&acc)[2][2][4][2], const pg8::Unit& u, int wr, int wc, int fr, int fq) const {
        const int rowb = u.pm * 256 + wr * 64 + fr, b = u.pm >> 3;
#pragma unroll
        for (int bj = 0; bj < 2; ++bj)
#pragma unroll
            for (int n = 0; n < 2; ++n) { const int col = u.pn * 256 + bj * 128 + wc * 32 + n * 16 + 4 * fq; const f32x4 g = *(const f32x4*)(mod + b * NMOD + 2 * D + col);
#pragma unroll
                for (int ai = 0; ai < 2; ++ai)
#pragma unroll
                    for (int m = 0; m < 4; ++m) { const size_t off = (size_t)(rowb + ai * 128 + m * 16) * D + col; *(f32x4*)(out + off) = *(const f32x4*)(x + off) + g * acc[ai][bj][m][n]; } }
    }
};
struct EpiGU {
    bf16* HID; const float* wlist;
    __device__ __forceinline__ void operator()(f32x4 (&acc)[2][2][4][2], const pg8::Unit& u, int wr, int wc, int fr, int fq) const {
        const int sb = wr * 64 + fr, cb = u.pn * 128 + wc * 32 + 8 * fq;
#pragma unroll
        for (int ai = 0; ai < 2; ++ai)
#pragma unroll
            for (int m = 0; m < 4; ++m) { const int s = sb + ai * 128 + m * 16;
                if (s < u.rows) { const float w = wlist[u.e * LCAP + u.pm * 256 + s]; const f32x4 g0 = acc[ai][0][m][0], g1 = acc[ai][0][m][1], u0 = acc[ai][1][m][0], u1 = acc[ai][1][m][1]; float h0[4], h1[4];
#pragma unroll
                    for (int j = 0; j < 4; ++j) { h0[j] = silu_(g0[j]) * u0[j] * w; h1[j] = silu_(g1[j]) * u1[j] * w; }
                    u32x4 o; o.x = cvt_pk_bf16(h0[0], h0[1]); o.y = cvt_pk_bf16(h0[2], h0[3]); o.z = cvt_pk_bf16(h1[0], h1[1]); o.w = cvt_pk_bf16(h1[2], h1[3]);
                    *(u32x4*)(HID + (size_t)(u.base + s) * FF + cb) = o; } }
    }
};
struct EpiDN {
    bf16* PART; const int* elist;
    __device__ __forceinline__ void operator()(f32x4 (&acc)[2][2][4][2], const pg8::Unit& u, int wr, int wc, int fr, int fq) const {
        const int sb = wr * 64 + fr, cb = u.pn * 256 + wc * 32 + 8 * fq;
#pragma unroll
        for (int ai = 0; ai < 2; ++ai)
#pragma unroll
            for (int m = 0; m < 4; ++m) { const int s = sb + ai * 128 + m * 16;
                if (s < u.rows) { const int ent = elist[u.e * LCAP + u.pm * 256 + s];
#pragma unroll
                    for (int bj = 0; bj < 2; ++bj) { const f32x4 v0 = acc[ai][bj][m][0], v1 = acc[ai][bj][m][1];
                        u32x4 o; o.x = cvt_pk_bf16(v0[0], v0[1]); o.y = cvt_pk_bf16(v0[2], v0[3]); o.z = cvt_pk_bf16(v1[0], v1[1]); o.w = cvt_pk_bf16(v1[2], v1[3]);
                        *(u32x4*)(PART + (size_t)ent * D + cb + bj * 128) = o; } } }
    }
};

__device__ __forceinline__ void transpose_item(const float* W, int ldw, int scol, bf16* dst_rows, int Kd, int k0, LAS float* scr, int lane) {
#pragma unroll 8
    for (int i = 0; i < 32; ++i) { const int kk = 2 * i + (lane >> 5); scr[kk * 33 + (lane & 31)] = W[(size_t)(k0 + kk) * ldw + scol]; }
    LDS_WAIT(); asm volatile("" ::: "memory");
    const int c = lane & 7;
#pragma unroll
    for (int j = 0; j < 4; ++j) { const int n = (lane >> 3) + 8 * j; const LAS float* s = scr + (8 * c) * 33 + n;
        v4u o; o.x = pk2(s[0 * 33], s[1 * 33]); o.y = pk2(s[2 * 33], s[3 * 33]); o.z = pk2(s[4 * 33], s[5 * 33]); o.w = pk2(s[6 * 33], s[7 * 33]);
        *(GAS v4u*)(dst_rows + (size_t)n * Kd + k0 + 8 * c) = o; }
    LDS_WAIT(); asm volatile("" ::: "memory");
}
__device__ __forceinline__ int plain32(int q) { return 8 * ((q >> 2) & 3) + 4 * (q >> 4) + (q & 3); }
__device__ __forceinline__ int win_col(int P) {
    const int pn = P >> 8, p = P & 255, bj = p >> 7, wc = (p >> 5) & 3, n = (p >> 4) & 1, fq = (p >> 2) & 3, j = p & 3;
    if (pn < 4) { const int part = pn >> 1, th = pn & 1, head = 4 * th + 2 * bj + (wc >> 1), d = 32 * n + 16 * (wc & 1) + 4 * fq + j; return part * 512 + head * 64 + d; }
    const int lc = 128 * bj + 32 * wc + 8 * fq + 4 * n + j;
    if (pn < 6) return 1024 + (pn - 4) * 256 + lc;
    if (pn < 10) { const int hh = pn - 6, kk = 32 * wc + 8 * fq + 4 * n + j; return (bj ? 2048 : 1536) + hh * 128 + kk; }
    if (pn < 12) return 2560 + (pn - 10) * 256 + lc;
    return 3072 + (pn - 12) * 256 + lc;
}

struct Ctx { LAS unsigned char* lds; unsigned char* ws; int vcu, G; };
#define PHASE_IDS const int tid_ = threadIdx.x, lane_ = tid_ & 63, wave_ = __builtin_amdgcn_readfirstlane(tid_ >> 6)

__device__ __forceinline__ void phase0(const Args& a, const Ctx& X) {
    PHASE_IDS;
    const float* c = a.in[1]; const float* w_ada = a.in[3]; const float* b_ada = a.in[4];
    LAS float* cs = (LAS float*)X.lds;
    LAS float* part = (LAS float*)(X.lds + 32768);
    float* mod = (float*)(X.ws + WS_MOD);
    if (X.vcu < 192) {
        for (int i = tid_; i < 8192; i += 512) cs[i] = silu_(c[i]);
        __syncthreads();
        for (int item = X.vcu; item < 192; item += X.G) {
            const int n0 = 32 * item, krow = lane_ >> 3, c4 = lane_ & 7; f32x4 acc[8];
#pragma unroll
            for (int b = 0; b < 8; ++b) acc[b] = (f32x4){0.f, 0.f, 0.f, 0.f};
#pragma unroll 4
            for (int it = 0; it < 16; ++it) { const int k = 128 * wave_ + 8 * it + krow; const f32x4 wv = *(const f32x4*)(w_ada + (size_t)k * NMOD + n0 + 4 * c4);
#pragma unroll
                for (int b = 0; b < 8; ++b) acc[b] += wv * cs[b * 1024 + k]; }
#pragma unroll
            for (int b = 0; b < 8; ++b)
#pragma unroll
                for (int j = 0; j < 4; ++j) { float v = acc[b][j]; v += __shfl_xor(v, 8); v += __shfl_xor(v, 16); v += __shfl_xor(v, 32); acc[b][j] = v; }
            if (lane_ < 8) {
#pragma unroll
                for (int b = 0; b < 8; ++b) *(LAS f32x4*)(part + (wave_ * 8 + b) * 32 + 4 * c4) = acc[b]; }
            __syncthreads();
            if (tid_ < 256) { const int b = tid_ >> 5, col = tid_ & 31; float s = b_ada[n0 + col];
#pragma unroll
                for (int w = 0; w < 8; ++w) s += part[(w * 8 + b) * 32 + col];
                mod[b * NMOD + n0 + col] = s; }
            __syncthreads();
        }
    }
    LAS float* scr = (LAS float*)(X.lds + 65536 + wave_ * 8448);
    const int gw = X.vcu * NWAVES + wave_, NGW = X.G * NWAVES;
    constexpr int I_IN = (NPROJ / 32) * 16, I_OUT = (D / 32) * 16;
    for (int it = gw; it < I_IN + I_OUT; it += NGW) {
        if (it < I_IN) { const int G32 = it >> 4, kb = it & 15; transpose_item(a.in[6], NPROJ, win_col(32 * G32 + (lane_ & 31)), (bf16*)(X.ws + WS_WIN) + (size_t)(32 * G32) * D, D, 64 * kb, scr, lane_); }
        else { const int r = it - I_IN, G32 = r >> 4, kb = r & 15; transpose_item(a.in[14], D, 32 * G32 + (lane_ & 31), (bf16*)(X.ws + WS_WOUT) + (size_t)(32 * G32) * D, D, 64 * kb, scr, lane_); }
    }
}
__device__ __forceinline__ void phase1(const Args& a, const Ctx& X) {
    PHASE_IDS;
    const float* x = a.in[0]; const float* nw = a.in[5]; const float* mod = (const float*)(X.ws + WS_MOD); bf16* H1 = (bf16*)(X.ws + WS_RA);
    const int gw = X.vcu * NWAVES + wave_, NGW = X.G * NWAVES;
    for (int m = gw; m < M; m += NGW) { const int b = m >> 11; const f32x4* xr = (const f32x4*)(x + (size_t)m * D) + lane_; f32x4 v[4]; float ss = 0.f;
#pragma unroll
        for (int j = 0; j < 4; ++j) { v[j] = xr[64 * j]; ss += (v[j].x * v[j].x + v[j].y * v[j].y) + (v[j].z * v[j].z + v[j].w * v[j].w); }
        const float rstd = 1.f / sqrtf(wave_sum(ss) * (1.f / D) + RMS_EPS);
#pragma unroll
        for (int j = 0; j < 4; ++j) { const int k = 256 * j + 4 * lane_; const f32x4 w = *(const f32x4*)(nw + k), sh = *(const f32x4*)(mod + b * NMOD + k), sc = *(const f32x4*)(mod + b * NMOD + D + k);
            const f32x4 h = v[j] * rstd * w * (sc + 1.f) + sh; u32x2v o; o.x = cvt_pk_bf16(h.x, h.y); o.y = cvt_pk_bf16(h.z, h.w); *(u32x2v*)(H1 + (size_t)m * D + k) = o; }
    }
}
__device__ __forceinline__ bf16x8 frag16(const LAS bf16* A, int ld, int r0, int k0, int lane) { return *(const LAS bf16x8*)(A + (r0 + (lane & 15)) * ld + k0 + 8 * (lane >> 4)); }
#define MFMA16(a, b, c) __builtin_amdgcn_mfma_f32_16x16x32_bf16(a, b, c, 0, 0, 0)
__device__ __forceinline__ void stage_T(const bf16* src, LAS bf16* dst, int wave, int lane) {
#pragma unroll
    for (int cc = 0; cc < 2; ++cc) { const int c = wave + 8 * cc; const v4u q = *(const v4u*)(src + (size_t)lane * 512 + 8 * c);
        dst[(8 * c + 0) * 72 + lane] = (bf16)(q.x & 0xffffu); dst[(8 * c + 1) * 72 + lane] = (bf16)(q.x >> 16); dst[(8 * c + 2) * 72 + lane] = (bf16)(q.y & 0xffffu); dst[(8 * c + 3) * 72 + lane] = (bf16)(q.y >> 16);
        dst[(8 * c + 4) * 72 + lane] = (bf16)(q.z & 0xffffu); dst[(8 * c + 5) * 72 + lane] = (bf16)(q.z >> 16); dst[(8 * c + 6) * 72 + lane] = (bf16)(q.w & 0xffffu); dst[(8 * c + 7) * 72 + lane] = (bf16)(q.w >> 16); }
}
__device__ __forceinline__ void phase3(const Args& a, const Ctx& X) {
    PHASE_IDS;
    LAS bf16* VT = (LAS bf16*)X.lds; LAS bf16* KT = (LAS bf16*)(X.lds + 18432);
    const bf16* VI = (const bf16*)(X.ws + WS_VI); const bf16* KP = (const bf16*)(X.ws + WS_KP); bf16* UST = (bf16*)(X.ws + WS_UST);
    for (int un = X.vcu; un < 1024; un += X.G) { const int c = un & 31, h = (un >> 5) & 3, b = un >> 7; const size_t row0 = (size_t)b * SEQ + c * 64;
        stage_T(VI + row0 * 512 + h * 128, VT, wave_, lane_); stage_T(KP + row0 * 512 + h * 128, KT, wave_, lane_);
        __syncthreads();
        f32x4 acc[8];
#pragma unroll
        for (int kt = 0; kt < 8; ++kt) acc[kt] = (f32x4){0.f, 0.f, 0.f, 0.f};
#pragma unroll
        for (int ks = 0; ks < 2; ++ks) { const bf16x8 af = frag16(VT, 72, 16 * wave_, 32 * ks, lane_);
#pragma unroll
            for (int kt = 0; kt < 8; ++kt) acc[kt] = MFMA16(af, frag16(KT, 72, 16 * kt, 32 * ks, lane_), acc[kt]); }
        bf16* U = UST + (size_t)un * 16384;
#pragma unroll
        for (int kt = 0; kt < 8; ++kt)
#pragma unroll
            for (int j = 0; j < 4; ++j) U[(16 * wave_ + (lane_ >> 4) * 4 + j) * 128 + 16 * kt + (lane_ & 15)] = (bf16)f2bf(acc[kt][j]);
        __syncthreads();
    }
}
__device__ __forceinline__ void phase4_scan(const Args& a, const Ctx& X, size_t dst_delta = 0) {
    PHASE_IDS;
    bf16* UST = (bf16*)(X.ws + WS_UST); const float* EL = (const float*)(X.ws + WS_EL);
    for (int g = X.vcu * 512 + tid_; g < 32 * 4096; g += X.G * 512) { const int bh = g >> 12, rem = g & 4095, v = rem >> 5, k4 = (rem & 31) * 4, h = bh & 3, b = bh >> 2;
        f32x4 S = (f32x4){0.f, 0.f, 0.f, 0.f};
#pragma unroll 4
        for (int c = 0; c < NCH; ++c) { u32x2v* p = (u32x2v*)(UST + (size_t)(bh * 32 + c) * 16384 + v * 128 + k4); const u32x2v uw = *p; const f32x4 e = *(const f32x4*)(EL + (size_t)((b * 32 + c) * 4 + h) * 128 + k4);
            u32x2v o; o.x = cvt_pk_bf16(S.x, S.y); o.y = cvt_pk_bf16(S.z, S.w); *(u32x2v*)((char*)p + dst_delta) = o;
            S.x = e.x * (S.x + bf_lo(uw.x)); S.y = e.y * (S.y + bf_hi(uw.x)); S.z = e.z * (S.z + bf_lo(uw.y)); S.w = e.w * (S.w + bf_hi(uw.y)); }
    }
}
struct AttnUnitU { int bvh; int qb; };
struct AttnOrder {
  int vcu;
#ifndef ATTN_REP
#define ATTN_REP 1
#endif
  __device__ __forceinline__ bool next(int i_, AttnUnitU& u) const { if (i_ >= 4 * ATTN_REP) return false; const int i = i_ & 3; const int s0 = 2 * (vcu & 1); u.bvh = vcu >> 1; u.qb = (i == 0) ? s0 : (i == 1) ? 7 - s0 : (i == 2) ? s0 + 1 : 6 - s0; return true; }
};
struct AttnT { const attn_body::bf16* Q; const attn_body::bf16* K; const attn_body::bf16* V; attn_body::bf16* O; };
template <class Sched> __device__ __forceinline__ void attn_phase_(char* lds, const AttnT& T, const Sched& S) {
  AttnUnitU u;
  for (int i = 0; S.next(i, u); ++i) { const int vh = u.bvh & 1, qh = (u.bvh >> 1) & 7, b = u.bvh >> 4; attn_body::attn_unit<8>(b, qh * 64, (qh >> 1) * 128 + vh * 64, qh * 128 + vh * 64, u.qb, T.Q, T.K, T.V, T.O, lds); }
}
__device__ __forceinline__ void phase4_attn(const Args& a, const Ctx& X, char* ldsg) {
    const AttnT T{(const attn_body::bf16*)(X.ws + WS_Q), (const attn_body::bf16*)(X.ws + WS_K), (const attn_body::bf16*)(X.ws + WS_V), (attn_body::bf16*)(X.ws + WS_RA)};
    const AttnOrder S{X.vcu};
    attn_phase_<AttnOrder>(ldsg, T, S);
}
__device__ __forceinline__ void phase5_hgrn(const Args& a, const Ctx& X) {
    PHASE_IDS;
    LAS bf16* QS = (LAS bf16*)X.lds; LAS bf16* KS = (LAS bf16*)(X.lds + 17408); LAS bf16* VT = (LAS bf16*)(X.lds + 34816); LAS bf16* STs = (LAS bf16*)(X.lds + 53248);
    LAS bf16* PS = (LAS bf16*)(X.lds + 88064); LAS float* OS = (LAS float*)(X.lds + 97280);
    const bf16* QP = (const bf16*)(X.ws + WS_QP); const bf16* KP = (const bf16*)(X.ws + WS_KP); const bf16* VI = (const bf16*)(X.ws + WS_VI); const bf16* SG = (const bf16*)(X.ws + WS_SG);
    const bf16* UST = (const bf16*)(X.ws + WS_UST); bf16* MIXED = (bf16*)(X.ws + WS_MIXED); const float* gnw = a.in[13];
    for (int un = X.vcu; un < 1024; un += X.G) { const int c = un & 31, h = (un >> 5) & 3, b = un >> 7; const size_t row0 = (size_t)b * SEQ + c * 64;
#pragma unroll
        for (int i = 0; i < 2; ++i) { const int idx = tid_ + 512 * i, row = idx >> 4, ch = idx & 15;
            *(LAS v4u*)(QS + row * 136 + ch * 8) = *(const v4u*)(QP + (row0 + row) * 512 + h * 128 + ch * 8); *(LAS v4u*)(KS + row * 136 + ch * 8) = *(const v4u*)(KP + (row0 + row) * 512 + h * 128 + ch * 8); }
#pragma unroll
        for (int i = 0; i < 4; ++i) { const int idx = tid_ + 512 * i, row = idx >> 4, ch = idx & 15; *(LAS v4u*)(STs + row * 136 + ch * 8) = *(const v4u*)(UST + (size_t)un * 16384 + row * 128 + ch * 8); }
        stage_T(VI + row0 * 512 + h * 128, VT, wave_, lane_);
        __syncthreads();
        { const int tt = wave_ >> 1; f32x4 s2[2];
#pragma unroll
          for (int x = 0; x < 2; ++x) s2[x] = (f32x4){0.f, 0.f, 0.f, 0.f};
#pragma unroll
          for (int ks = 0; ks < 4; ++ks) { const bf16x8 af = frag16(QS, 136, 16 * tt, 32 * ks, lane_);
#pragma unroll
              for (int x = 0; x < 2; ++x) s2[x] = MFMA16(af, frag16(KS, 136, 16 * (2 * (wave_ & 1) + x), 32 * ks, lane_), s2[x]); }
#pragma unroll
          for (int x = 0; x < 2; ++x) { const int st = 2 * (wave_ & 1) + x;
#pragma unroll
              for (int j = 0; j < 4; ++j) { const int t = 16 * tt + (lane_ >> 4) * 4 + j, s = 16 * st + (lane_ & 15); PS[t * 72 + s] = (bf16)f2bf(s <= t ? s2[x][j] : 0.f); } } }
        __syncthreads();
        { f32x4 o[4];
#pragma unroll
          for (int tt = 0; tt < 4; ++tt) o[tt] = (f32x4){0.f, 0.f, 0.f, 0.f};
#pragma unroll
          for (int ks = 0; ks < 2; ++ks) { const bf16x8 bfr = frag16(VT, 72, 16 * wave_, 32 * ks, lane_);
#pragma unroll
              for (int tt = 0; tt < 4; ++tt) o[tt] = MFMA16(frag16(PS, 72, 16 * tt, 32 * ks, lane_), bfr, o[tt]); }
#pragma unroll
          for (int ks = 0; ks < 4; ++ks) { const bf16x8 bfr = frag16(STs, 136, 16 * wave_, 32 * ks, lane_);
#pragma unroll
              for (int tt = 0; tt < 4; ++tt) o[tt] = MFMA16(frag16(QS, 136, 16 * tt, 32 * ks, lane_), bfr, o[tt]); }
#pragma unroll
          for (int tt = 0; tt < 4; ++tt)
#pragma unroll
              for (int j = 0; j < 4; ++j) OS[(16 * tt + (lane_ >> 4) * 4 + j) * 132 + 16 * wave_ + (lane_ & 15)] = o[tt][j]; }
        __syncthreads();
#pragma unroll
        for (int r = 0; r < 8; ++r) { const int t = 8 * wave_ + r; const float o0 = OS[t * 132 + 2 * lane_], o1 = OS[t * 132 + 2 * lane_ + 1];
            const float rstd = 1.f / sqrtf(wave_sum(o0 * o0 + o1 * o1) * (1.f / 128.f) + RMS_EPS); const unsigned sg = *(const unsigned*)(SG + (row0 + t) * 512 + h * 128 + 2 * lane_);
            *(unsigned*)(MIXED + (row0 + t) * 1024 + 512 + h * 128 + 2 * lane_) = cvt_pk_bf16(o0 * rstd * gnw[2 * lane_] * bf_lo(sg), o1 * rstd * gnw[2 * lane_ + 1] * bf_hi(sg)); }
        __syncthreads();
    }
}
__device__ __forceinline__ void phase5_comb(const Args& a, const Ctx& X) {
    PHASE_IDS;
    const bf16* AO = (const bf16*)(X.ws + WS_RA); bf16* MIXED = (bf16*)(X.ws + WS_MIXED); const float* sw = a.in[11];
    const float d1 = wave_sum(a.in[7][lane_] * a.in[8][lane_]), d2 = wave_sum(a.in[9][lane_] * a.in[10][lane_]); const float lam = expf(d1) - expf(d2) + LAMBDA_INIT;
    const int gw = X.vcu * NWAVES + wave_, NGW = X.G * NWAVES, hh = lane_ >> 4, ds = (lane_ & 15) * 8;
    float swv[8];
#pragma unroll
    for (int i = 0; i < 8; ++i) swv[i] = sw[ds + i] * (1.f - LAMBDA_INIT);
    for (int m = gw; m < M; m += NGW) { const v4u p1 = *(const v4u*)(AO + (size_t)m * 1024 + (2 * hh) * 128 + ds), p2 = *(const v4u*)(AO + (size_t)m * 1024 + (2 * hh + 1) * 128 + ds); float v[8];
        v[0] = bf_lo(p1.x) - lam * bf_lo(p2.x); v[1] = bf_hi(p1.x) - lam * bf_hi(p2.x); v[2] = bf_lo(p1.y) - lam * bf_lo(p2.y); v[3] = bf_hi(p1.y) - lam * bf_hi(p2.y);
        v[4] = bf_lo(p1.z) - lam * bf_lo(p2.z); v[5] = bf_hi(p1.z) - lam * bf_hi(p2.z); v[6] = bf_lo(p1.w) - lam * bf_lo(p2.w); v[7] = bf_hi(p1.w) - lam * bf_hi(p2.w);
        float ss = 0.f;
#pragma unroll
        for (int i = 0; i < 8; ++i) ss += v[i] * v[i];
        ss += __shfl_xor(ss, 1); ss += __shfl_xor(ss, 2); ss += __shfl_xor(ss, 4); ss += __shfl_xor(ss, 8);
        const float rstd = 1.f / sqrtf(ss * (1.f / 128.f) + SUBLN_EPS);
        v4u o; o.x = cvt_pk_bf16(v[0] * rstd * swv[0], v[1] * rstd * swv[1]); o.y = cvt_pk_bf16(v[2] * rstd * swv[2], v[3] * rstd * swv[3]);
        o.z = cvt_pk_bf16(v[4] * rstd * swv[4], v[5] * rstd * swv[5]); o.w = cvt_pk_bf16(v[6] * rstd * swv[6], v[7] * rstd * swv[7]);
        *(v4u*)(MIXED + (size_t)m * 1024 + hh * 128 + ds) = o; }
}
__device__ __forceinline__ void phase7_route(const Args& a, const Ctx& X, gu32* ctl, size_t list_delta = 0, int cnt_delta = 0) {
    PHASE_IDS;
    LAS float* WT = (LAS float*)X.lds;
    const float* wgr = a.in[16]; const float* bgr = a.in[17]; const float* wer = a.in[18]; const float* ber = a.in[19]; const float* nw = a.in[15];
    const float* x1 = a.out; const float* mod = (const float*)(X.ws + WS_MOD); bf16* H2 = (bf16*)(X.ws + WS_RA);
    int* elist = (int*)(X.ws + WS_ELIST + list_delta); float* wlist = (float*)(X.ws + WS_WLIST + list_delta);
#pragma unroll 4
    for (int i = 0; i < 16; ++i) { const int idx = tid_ + 512 * i, k = idx & 1023, o4 = idx >> 10; const f32x4 w = *(const f32x4*)(wer + k * 32 + 4 * o4);
        WT[(4 + 4 * o4 + 0) * 1024 + k] = w.x; WT[(4 + 4 * o4 + 1) * 1024 + k] = w.y; WT[(4 + 4 * o4 + 2) * 1024 + k] = w.z; WT[(4 + 4 * o4 + 3) * 1024 + k] = w.w; }
#pragma unroll
    for (int i = 0; i < 2; ++i) { const int k = tid_ + 512 * i; const f32x4 w = *(const f32x4*)(wgr + k * 4); WT[0 * 1024 + k] = w.x; WT[1 * 1024 + k] = w.y; WT[2 * 1024 + k] = w.z; WT[3 * 1024 + k] = w.w; }
    LAS int* rE = (LAS int*)(X.lds + LDSCTL_OFF + 2048); LAS float* rW = (LAS float*)(rE + 128); LAS unsigned* lcnt = (LAS unsigned*)(rE + 256); LAS unsigned* lbase = lcnt + 32;
    if (tid_ < 32) lcnt[tid_] = 0u;
    if (tid_ < 128) rE[tid_] = -1;
    __syncthreads();
    const int gw = X.vcu * NWAVES + wave_, NGW = X.G * NWAVES; int trip = 0;
    for (int m = gw; m < M; m += NGW, ++trip) { const int b = m >> 11; const f32x4* xr = (const f32x4*)(x1 + (size_t)m * D) + lane_; f32x4 h[4]; float ss = 0.f;
#pragma unroll
        for (int j = 0; j < 4; ++j) { h[j] = xr[64 * j]; ss += (h[j].x * h[j].x + h[j].y * h[j].y) + (h[j].z * h[j].z + h[j].w * h[j].w); }
        const float rstd = 1.f / sqrtf(wave_sum(ss) * (1.f / D) + RMS_EPS);
#pragma unroll
        for (int j = 0; j < 4; ++j) { const int k = 256 * j + 4 * lane_; const f32x4 w = *(const f32x4*)(nw + k), sh = *(const f32x4*)(mod + b * NMOD + 3 * D + k), sc = *(const f32x4*)(mod + b * NMOD + 4 * D + k);
            h[j] = h[j] * rstd * w * (sc + 1.f) + sh; u32x2v o; o.x = cvt_pk_bf16(h[j].x, h[j].y); o.y = cvt_pk_bf16(h[j].z, h[j].w); *(u32x2v*)(H2 + (size_t)m * D + k) = o; }
        float gl[4];
#pragma unroll
        for (int g = 0; g < 4; ++g) { float s = 0.f;
#pragma unroll
            for (int j = 0; j < 4; ++j) { const f32x4 w = *(const LAS f32x4*)(WT + g * 1024 + 256 * j + 4 * lane_); s += (h[j].x * w.x + h[j].y * w.y) + (h[j].z * w.z + h[j].w * w.w); }
            gl[g] = wave_sum(s) + bgr[g]; }
        int gs = 0; float gm = gl[0];
#pragma unroll
        for (int g = 1; g < 4; ++g) if (gl[g] > gm) { gm = gl[g]; gs = g; }
        float den = 0.f;
#pragma unroll
        for (int g = 0; g < 4; ++g) den += expf(gl[g] - gm);
        const float pg = 1.f / den;
        float el[8]; const LAS float* WE = WT + (4 + 8 * gs) * 1024;
#pragma unroll
        for (int i = 0; i < 8; ++i) { float s = 0.f;
#pragma unroll
            for (int j = 0; j < 4; ++j) { const f32x4 w = *(const LAS f32x4*)(WE + i * 1024 + 256 * j + 4 * lane_); s += (h[j].x * w.x + h[j].y * w.y) + (h[j].z * w.z + h[j].w * w.w); }
            el[i] = wave_sum(s) + ber[gs * 8 + i]; }
        int i1 = 0; float m1 = el[0];
#pragma unroll
        for (int i = 1; i < 8; ++i) if (el[i] > m1) { m1 = el[i]; i1 = i; }
        int i2 = -1; float m2 = -INFINITY;
#pragma unroll
        for (int i = 0; i < 8; ++i) if (i != i1 && (i2 < 0 || el[i] > m2)) { m2 = el[i]; i2 = i; }
        const float t = expf(m2 - m1), w1 = pg / (1.f + t), w2 = pg * t / (1.f + t);
        if (lane_ == 0 && trip < 8) { const int li = trip * 8 + wave_; rE[2 * li] = gs * 8 + i1; rE[2 * li + 1] = gs * 8 + i2; rW[2 * li] = w1; rW[2 * li + 1] = w2; }
    }
    __syncthreads();
    int e = -1; unsigned loc = 0u;
    if (tid_ < 128) { e = rE[tid_]; if (e >= 0) loc = __hip_atomic_fetch_add(lcnt + e, 1u, __ATOMIC_RELAXED, __HIP_MEMORY_SCOPE_WORKGROUP); }
    __syncthreads();
    if (tid_ < 32) { const unsigned cn = lcnt[tid_]; lbase[tid_] = cn ? __hip_atomic_fetch_add(ctl + CW_CNT + cnt_delta + 64 * tid_, cn, RLX_AGENT) : 0u; }
    __syncthreads();
    if (tid_ < 128 && e >= 0) { const unsigned slot = lbase[e] + loc; const int li = tid_ >> 1, m = X.vcu * NWAVES + (li & 7) + (li >> 3) * NGW;
        if (slot < (unsigned)LCAP) { elist[e * LCAP + slot] = 2 * m + (tid_ & 1); wlist[e * LCAP + slot] = rW[tid_]; } }
}
__device__ __forceinline__ void phase7_conv(const Args& a, const Ctx& X) {
    PHASE_IDS;
    LAS float* scr = (LAS float*)(X.lds + wave_ * 8448);
    const int gw = X.vcu * NWAVES + wave_, NGW = X.G * NWAVES;
    constexpr int I_GU = 32 * 4 * 8 * 16, I_DN = 32 * 32 * 8;
    for (int it = gw; it < I_GU + I_DN; it += NGW) {
        if (it < I_GU) { const int kb = it & 15, g8 = (it >> 4) & 7, sub = (it >> 7) & 3, e = it >> 9, bj = g8 >> 2, wc = g8 & 3;
            const float* W = (bj ? a.in[21] : a.in[20]) + (size_t)e * D * FF; const int scol = 128 * sub + 32 * wc + plain32(lane_ & 31);
            transpose_item(W, FF, scol, (bf16*)(X.ws + WS_WGU) + ((size_t)(e * 4 + sub) * 256 + 32 * g8) * D, D, 64 * kb, scr, lane_); }
        else { const int r = it - I_GU, kb = r & 7, G32 = (r >> 3) & 31, e = r >> 8; const float* W = a.in[22] + (size_t)e * FF * D; const int scol = 32 * G32 + plain32(lane_ & 31);
            transpose_item(W, D, scol, (bf16*)(X.ws + WS_WD) + ((size_t)e * 1024 + 32 * G32) * FF, FF, 64 * kb, scr, lane_); }
    }
}
__device__ __forceinline__ void phase10(const Args& a, const Ctx& X, float* dst = nullptr) {
    PHASE_IDS;
    float* out = a.out; const float* mod = (const float*)(X.ws + WS_MOD); const bf16* PART = (const bf16*)(X.ws + WS_PART); const float* fw = a.in[23];
    const int gw = X.vcu * NWAVES + wave_, NGW = X.G * NWAVES;
    for (int m = gw; m < M; m += NGW) { const int b = m >> 11; f32x4* xr = (f32x4*)(out + (size_t)m * D) + lane_; f32x4* xw = dst ? (f32x4*)(dst + (size_t)m * D) + lane_ : xr; f32x4 y[4]; float ss = 0.f;
#pragma unroll
        for (int j = 0; j < 4; ++j) { const int k = 256 * j + 4 * lane_; const f32x4 g = *(const f32x4*)(mod + b * NMOD + 5 * D + k);
            const u32x2v p0 = *(const u32x2v*)(PART + (size_t)(2 * m) * D + k), p1 = *(const u32x2v*)(PART + (size_t)(2 * m + 1) * D + k);
            f32x4 f; f.x = bf_lo(p0.x) + bf_lo(p1.x); f.y = bf_hi(p0.x) + bf_hi(p1.x); f.z = bf_lo(p0.y) + bf_lo(p1.y); f.w = bf_hi(p0.y) + bf_hi(p1.y);
            y[j] = xr[64 * j] + g * f; ss += (y[j].x * y[j].x + y[j].y * y[j].y) + (y[j].z * y[j].z + y[j].w * y[j].w); }
        const float rstd = 1.f / sqrtf(wave_sum(ss) * (1.f / D) + RMS_EPS);
#pragma unroll
        for (int j = 0; j < 4; ++j) { const int k = 256 * j + 4 * lane_; xw[64 * j] = y[j] * rstd * *(const f32x4*)(fw + k); }
    }
}

__global__ void __launch_bounds__(NWAVES * 64, 2) hymba_fwd(Args args) {
    extern __shared__ __attribute__((aligned(16))) unsigned char lds[];
    Ctx X; X.lds = (LAS unsigned char*)lds; X.ws = args.ws;
    X.G = gridDim.x; { const int bx = blockIdx.x; X.vcu = (X.G % 8 == 0) ? (bx % 8) * (X.G / 8) + bx / 8 : bx; }
    gu32* ctl = (gu32*)(args.ws + WS_CTL);
    for (int u = threadIdx.x; u < (LDS_BYTES - LDSCTL_OFF) / 4; u += NWAVES * 64) ((LAS unsigned*)(X.lds + LDSCTL_OFF))[u] = 0u;
    __syncthreads();
    if (MK_N_LAUNCHES == 1) (void)xcd_barrier_post((unsigned*)(ctl + CW_BAR), (volatile LAS unsigned*)(X.lds + MISC_OFF) + 8);
    const int lo = args.ph_lo, hi = args.ph_hi;
#ifndef PH_MASK
#define PH_MASK 0x7ff
#endif
#define IN(k) ((((PH_MASK) >> (k)) & 1) && lo <= (k) && (k) < hi)
#define SEAM(k) do { if (IN(k) && IN((k) + 1)) { XcdBarrier bar_; bar_.bar = (unsigned*)((gu32*)(args.ws + WS_CTL) + CW_BAR); bar_.x = xb_xcc_id(); bar_.st = (volatile LAS unsigned*)(X.lds + MISC_OFF) + 8; xcd_barrier(bar_); } } while (0)
    LAS int* tab = (LAS int*)(X.lds + SCHED_OFF);
#ifndef DUP_MASK
#define DUP_MASK 0
#endif
#define GBAR() do { XcdBarrier bar_; bar_.bar = (unsigned*)((gu32*)(args.ws + WS_CTL) + CW_BAR); bar_.x = xb_xcc_id(); bar_.st = (volatile LAS unsigned*)(X.lds + MISC_OFF) + 8; xcd_barrier(bar_); } while (0)
#define DUP(k) (((DUP_MASK) >> (k)) & 1)
    if (IN(0)) { phase0(args, X); if (DUP(0)) { GBAR(); phase0(args, X); } } SEAM(0);
    if (IN(1)) { phase1(args, X); if (DUP(1)) { GBAR(); phase1(args, X); } } SEAM(1);
    if (IN(2)) {
        { DenseOrder S; S.init(M, 2560, D, X.G, (int)blockIdx.x, args.ws + WS_RA, args.ws + WS_WIN, 0, 6, 4);
          EpiInProj<3> E{(bf16*)(args.ws + WS_Q), (float*)(args.ws + WS_EL), (const int*)args.in[2], args.in[12]};
          pg8::gemm_phase<EpiInProj<3>, DenseOrder, false, true>(X.lds, D, S, E); }
        { DenseOrder S; S.init(M, 1024, D, X.G, (int)blockIdx.x, args.ws + WS_RA, args.ws + WS_WIN, 6);
          EpiInProj<4> E{(bf16*)(args.ws + WS_Q), (float*)(args.ws + WS_EL), (const int*)args.in[2], args.in[12]};
          pg8::gemm_phase<EpiInProj<4>, DenseOrder, false, true>(X.lds, D, S, E); }
        if (DUP(2)) { GBAR(); { DenseOrder S; S.init(M, 2560, D, X.G, (int)blockIdx.x, args.ws + WS_RA, args.ws + WS_WIN, 0, 6, 4); EpiInProj<3> E{(bf16*)(args.ws + WS_Q), (float*)(args.ws + WS_EL), (const int*)args.in[2], args.in[12]}; pg8::gemm_phase<EpiInProj<3>, DenseOrder, false, true>(X.lds, D, S, E); }
          { DenseOrder S; S.init(M, 1024, D, X.G, (int)blockIdx.x, args.ws + WS_RA, args.ws + WS_WIN, 6); EpiInProj<4> E{(bf16*)(args.ws + WS_Q), (float*)(args.ws + WS_EL), (const int*)args.in[2], args.in[12]}; pg8::gemm_phase<EpiInProj<4>, DenseOrder, false, true>(X.lds, D, S, E); } } } SEAM(2);
    if (IN(3)) { phase3(args, X); if (DUP(3)) { GBAR(); phase3(args, X); } } SEAM(3);
    if (IN(4)) { if (DUP(11)) { phase4_scan(args, X, WS_WD - WS_UST); GBAR(); } phase4_scan(args, X); phase4_attn(args, X, (char*)lds); } SEAM(4);
    if (IN(5)) { phase5_hgrn(args, X); phase5_comb(args, X); if (DUP(5)) { GBAR(); phase5_hgrn(args, X); phase5_comb(args, X); } } SEAM(5);
    if (IN(6)) { DenseOrder S; S.init(M, D, D, X.G, (int)blockIdx.x, args.ws + WS_MIXED, args.ws + WS_WOUT);
        EpiOut E{args.in[0], (const float*)(args.ws + WS_MOD), args.out};
        pg8::gemm_phase<EpiOut, DenseOrder, false, true>(X.lds, D, S, E); if (DUP(6)) { GBAR(); pg8::gemm_phase<EpiOut, DenseOrder, false, true>(X.lds, D, S, E); } } SEAM(6);
    if (IN(7)) { if (DUP(12)) { phase7_route(args, X, ctl, WS_HID - WS_ELIST, 4096); GBAR(); } phase7_route(args, X, ctl); __syncthreads(); phase7_conv(args, X); if (DUP(7)) { GBAR(); phase7_conv(args, X); } } SEAM(7);
    if (IN(8)) { sched_tables(tab, ctl + CW_CNT, (int)threadIdx.x);
        MoeOrder S{tab, X.G, (int)blockIdx.x, 0, (const char*)(args.ws + WS_RA), (const char*)(args.ws + WS_WGU), (const int*)(args.ws + WS_ELIST)};
        EpiGU E{(bf16*)(args.ws + WS_HID), (const float*)(args.ws + WS_WLIST)};
        pg8::gemm_phase<EpiGU, MoeOrder, true, true>(X.lds, D, S, E); } SEAM(8);
    if (IN(9)) { sched_tables(tab, ctl + CW_CNT, (int)threadIdx.x);
        MoeOrder S{tab, X.G, (int)blockIdx.x, 1, (const char*)(args.ws + WS_HID), (const char*)(args.ws + WS_WD), (const int*)(args.ws + WS_ELIST)};
        EpiDN E{(bf16*)(args.ws + WS_PART), (const int*)(args.ws + WS_ELIST)};
        pg8::gemm_phase<EpiDN, MoeOrder, false, true>(X.lds, FF, S, E); } SEAM(9);
    if (IN(10)) { if (DUP(13)) { phase10(args, X, (float*)(args.ws + WS_WGU)); GBAR(); } phase10(args, X); }
#undef IN
#undef SEAM
}

extern "C" void kernel_launch(void* const* d_in, const int* in_sizes, int n_in, void* d_out, int out_size, void* d_ws, size_t ws_size, hipStream_t stream) {
    static int grid = 0;
    if (grid == 0) {
        if (n_in != 24 || in_sizes[0] != M * D || out_size != M * D || ws_size < WS_END) { fprintf(stderr, "kernel_launch: unexpected shapes (n_in %d, in0 %d, out %d, ws %zu); nothing launched\n", n_in, n_in > 0 ? in_sizes[0] : -1, out_size, ws_size); grid = -1; return; }
        int dev = 0, cus = 0, per_cu = 0;
        if (hipGetDevice(&dev) != hipSuccess || hipDeviceGetAttribute(&cus, hipDeviceAttributeMultiprocessorCount, dev) != hipSuccess) { fprintf(stderr, "kernel_launch: device query failed\n"); grid = -1; return; }
        if (hipFuncSetAttribute((const void*)hymba_fwd, hipFuncAttributeMaxDynamicSharedMemorySize, LDS_BYTES) != hipSuccess) { fprintf(stderr, "kernel_launch: hipFuncSetAttribute failed\n"); grid = -1; return; }
        if (hipOccupancyMaxActiveBlocksPerMultiprocessor(&per_cu, (const void*)hymba_fwd, NWAVES * 64, LDS_BYTES) != hipSuccess || per_cu < 1) { fprintf(stderr, "kernel_launch: occupancy query reports %d workgroups per CU\n", per_cu); (void)hipGetLastError(); grid = -1; return; }
        if (cus != 256) { fprintf(stderr, "kernel_launch: built for a 256-CU device, found %d CUs; nothing launched\n", cus); grid = -1; return; }
        grid = cus;
    }
    if (grid < 0) return;
    (void)hipMemsetAsync((char*)d_ws + WS_CTL, 0, CTL_ZERO_BYTES, stream);
    Args a{};
    for (int i = 0; i < 24; ++i) a.in[i] = (const float*)d_in[i];
    a.out = (float*)d_out; a.ws = (unsigned char*)d_ws;
    if (MK_N_LAUNCHES == 1) { a.ph_lo = 0; a.ph_hi = NPH; hipLaunchKernelGGL(hymba_fwd, dim3(grid), dim3(NWAVES * 64), LDS_BYTES, stream, a); }
    else { for (int p = 0; p < NPH; ++p) { a.ph_lo = p; a.ph_hi = p + 1; hipLaunchKernelGGL(hymba_fwd, dim3(grid), dim3(NWAVES * 64), LDS_BYTES, stream, a); } }
}
```

```cpp
#include <hip/hip_runtime.h>
#include <hip/hip_bf16.h>
#include <cstdio>
#include <cstdint>
#include <cmath>
namespace pg8 {
#define PG8_LAS __attribute__((address_space(3)))
typedef unsigned short bf16_t;
typedef short bf16x8 __attribute__((ext_vector_type(8)));
typedef float f32x4 __attribute__((ext_vector_type(4)));
typedef unsigned u32x4 __attribute__((ext_vector_type(4)));
constexpr int BM = 256, BK = 64, HALF = 128, HTB = HALF * BK * 2  , STAGE_BYTES = 8 * HTB, NXCD = 8, WGM = 8;
__host__ __device__ __forceinline__ int lds_byte(int r, int c) { const int st = (r >> 4) * 2 + (c >> 5), rr = r & 15, cc = c & 31, ob = rr * 64 + cc * 2; return st * 1024 + (ob ^ (((ob >> 9) & 1) << 5)); }
__host__ __device__ __forceinline__ void stage_rc(int b, int& R, int& C) { const int st = b / 1024, sb = b % 1024, swz = sb ^ (((sb >> 9) & 1) << 5); R = (st >> 1) * 16 + swz / 64; C = (st & 1) * 32 + (swz % 64) / 2; }
struct Unit { int pm, pn; const char* A; const char* B; const int* gidx; int rows; int e; int base; };
__device__ __forceinline__ unsigned cvt_pk_bf16(float lo, float hi) { unsigned r; asm volatile("v_cvt_pk_bf16_f32 %0, %1, %2" : "=v"(r) : "v"(lo), "v"(hi)); return r; }
template <class Epi, class Sched, bool GATHER, bool ALIGN_EPI>
__device__ __forceinline__ void gemm_phase(PG8_LAS unsigned char* lds, const int K, const Sched& S, const Epi& E) {
    constexpr bool SP2 = true;
    const int tid = threadIdx.x, wid = __builtin_amdgcn_readfirstlane(tid >> 6), lane = tid & 63, wr = wid >> 2, wc = wid & 3, fr = lane & 15, fq = lane >> 4;
    const int nt = K / BK;
    unsigned voffB[2]; int RA[2], CA[2];
#pragma unroll
    for (int i = 0; i < 2; ++i) { int R, C; stage_rc(tid * 16 + i * 8192, R, C); RA[i] = R; CA[i] = C; voffB[i] = (unsigned)(R * K + C) * 2u; }
#define PG8_SETVOFF(dst, u) do { _Pragma("unroll") for (int _h = 0; _h < 2; ++_h) _Pragma("unroll") for (int _i = 0; _i < 2; ++_i) { int _r = _h * HALF + RA[_i]; \
        if constexpr (GATHER) { _r = _r < (u).rows ? _r : (u).rows - 1; _r = (u).gidx[_r] >> 1; } \
        dst[_h][_i] = (unsigned)(_r * K + CA[_i]) * 2u; } } while (0)
    const size_t kstep = (size_t)(BK * 2);
    const size_t hstep = (size_t)HALF * K * 2;
    const unsigned ldsw = (unsigned)wid * 1024u;
    const int aoff = lds_byte(wr * 64 + fr, fq * 8), boff = lds_byte(wc * 32 + fr, fq * 8);
#define PG8_SA(b, h) (((b) * 2 + (h)) * HTB)
#define PG8_SB(b, h) ((4 + (b) * 2 + (h)) * HTB)
#define PG8_STAGE(bufoff, gbase, voff) do { _Pragma("unroll") for (int _i = 0; _i < 2; ++_i) \
        __builtin_amdgcn_global_load_lds((const unsigned*)((const char*)(gbase) + (voff)[_i]), (PG8_LAS unsigned*)(lds + (bufoff) + ldsw + _i * 8192), 16, 0, 0); } while (0)
#define PG8_STAGEA(bufoff, gbase, h) PG8_STAGE(bufoff, gbase, vA[h])
#define PG8_LDA(dst, b, h) do { _Pragma("unroll") for (int m = 0; m < 4; ++m) _Pragma("unroll") for (int k = 0; k < 2; ++k) dst[m][k] = *(const PG8_LAS bf16x8*)(lds + PG8_SA(b, h) + aoff + m * 2048 + k * 1024); } while (0)
#define PG8_LDB(dst, b, h) do { _Pragma("unroll") for (int n = 0; n < 2; ++n) _Pragma("unroll") for (int k = 0; k < 2; ++k) dst[n][k] = *(const PG8_LAS bf16x8*)(lds + PG8_SB(b, h) + boff + n * 2048 + k * 1024); } while (0)
#define PG8_MMA(ai, bj, At, Bt) do { __builtin_amdgcn_s_setprio(1); _Pragma("unroll") for (int m = 0; m < 4; ++m) _Pragma("unroll") for (int n = 0; n < 2; ++n) _Pragma("unroll") for (int k = 0; k < 2; ++k) \
        acc[ai][bj][m][n] = __builtin_amdgcn_mfma_f32_16x16x32_bf16(Bt[n][k], At[m][k], acc[ai][bj][m][n], 0, 0, 0); __builtin_amdgcn_s_setprio(0); } while (0)
#define PG8_WAIT_V(n) asm volatile("s_waitcnt vmcnt(" #n ")" ::: "memory")
#define PG8_WAIT_L(n) asm volatile("s_waitcnt lgkmcnt(" #n ")" ::: "memory")
#define PG8_BAR __builtin_amdgcn_s_barrier()
#define PG8_SCHED __builtin_amdgcn_sched_barrier(0)
    Unit cur, nxt; int ui = 0;
    if (!S.next(0, cur)) return;
    f32x4 acc[2][2][4][2];
#pragma unroll
    for (int a = 0; a < 2; ++a)
#pragma unroll
        for (int b = 0; b < 2; ++b)
#pragma unroll
            for (int m = 0; m < 4; ++m)
#pragma unroll
                for (int n = 0; n < 2; ++n) acc[a][b][m][n] = (f32x4){0.f, 0.f, 0.f, 0.f};
    bf16x8 At[4][2], B0[2][2], B1[2][2];
    const char* cA = cur.A; const char* cB = cur.B;
    unsigned vA[2][2], vN[2][2];
    PG8_SETVOFF(vA, cur);
    if constexpr (SP2) {
        PG8_STAGE(PG8_SB(0, 0), cB, voffB); PG8_STAGE(PG8_SB(0, 1), cB + hstep, voffB); PG8_STAGEA(PG8_SA(0, 0), cA, 0); PG8_STAGEA(PG8_SA(0, 1), cA, 1);
        if (wr == 1) PG8_BAR;
        PG8_WAIT_V(2); PG8_BAR;
        PG8_STAGE(PG8_SB(1, 0), cB + kstep, voffB); PG8_STAGEA(PG8_SA(1, 0), cA + kstep, 0); PG8_STAGE(PG8_SB(1, 1), cB + hstep + kstep, voffB);
        PG8_WAIT_V(6); PG8_BAR;
    }
    for (;;) {
        const bool has_next = S.next(ui + 1, nxt);
        const char* nA = has_next ? nxt.A : cA; const char* nB = has_next ? nxt.B : cB;
        for (int t = 0; t < nt; t += 2) {
            const bool last = (t == nt - 2);
            const char* a1 = cA + (size_t)(t + 1) * kstep;
            const char* a2 = last ? nA : cA + (size_t)(t + 2) * kstep; const char* b2 = last ? nB : cB + (size_t)(t + 2) * kstep;
            const char* a3 = a2 + kstep; const char* b3 = b2 + kstep;
            if (last) { if (has_next) { PG8_SETVOFF(vN, nxt); } else { _Pragma("unroll") for (int _h = 0; _h < 2; ++_h) _Pragma("unroll") for (int _i = 0; _i < 2; ++_i) vN[_h][_i] = vA[_h][_i]; } }
            if constexpr (SP2) {
            PG8_LDB(B0, 0, 0); PG8_LDB(B1, 0, 1); PG8_SCHED; PG8_LDA(At, 0, 0); PG8_STAGEA(PG8_SA(1, 1), a1, 1);
            if (last) { _Pragma("unroll") for (int _h = 0; _h < 2; ++_h) _Pragma("unroll") for (int _i = 0; _i < 2; ++_i) vA[_h][_i] = vN[_h][_i]; }
            PG8_WAIT_V(8); PG8_WAIT_L(0); PG8_BAR; PG8_MMA(0, 0, At, B0); PG8_MMA(0, 1, At, B1); PG8_BAR; PG8_SCHED;
            PG8_LDA(At, 0, 1); PG8_STAGE(PG8_SB(0, 0), b2, voffB); PG8_STAGE(PG8_SB(0, 1), b2 + hstep, voffB); PG8_STAGEA(PG8_SA(0, 0), a2, 0);
            PG8_WAIT_V(8); PG8_WAIT_L(0); PG8_BAR; PG8_MMA(1, 0, At, B0); PG8_MMA(1, 1, At, B1); PG8_BAR; PG8_SCHED;
            PG8_LDB(B0, 1, 0); PG8_LDB(B1, 1, 1); PG8_SCHED; PG8_LDA(At, 1, 0); PG8_STAGEA(PG8_SA(0, 1), a2, 1);
            PG8_WAIT_V(8); PG8_WAIT_L(0); PG8_BAR; PG8_MMA(0, 0, At, B0); PG8_MMA(0, 1, At, B1); PG8_BAR; PG8_SCHED;
            PG8_LDA(At, 1, 1); PG8_STAGE(PG8_SB(1, 0), b3, voffB); PG8_STAGE(PG8_SB(1, 1), b3 + hstep, voffB); PG8_STAGEA(PG8_SA(1, 0), a3, 0);
            PG8_WAIT_V(8); PG8_WAIT_L(0); PG8_BAR; PG8_MMA(1, 0, At, B0); PG8_MMA(1, 1, At, B1); PG8_BAR; PG8_SCHED;
            }
        }
        if constexpr (ALIGN_EPI) { if (wr == 0) PG8_BAR; }
        E(acc, cur, wr, wc, fr, fq);
        if (!has_next) break;
#pragma unroll
        for (int a = 0; a < 2; ++a)
#pragma unroll
            for (int b = 0; b < 2; ++b)
#pragma unroll
                for (int m = 0; m < 4; ++m)
#pragma unroll
                    for (int n = 0; n < 2; ++n) acc[a][b][m][n] = (f32x4){0.f, 0.f, 0.f, 0.f};
        cur = nxt; cA = nA; cB = nB; ++ui;
        if constexpr (ALIGN_EPI) { if (wr == 1) PG8_BAR; }
    }
    PG8_WAIT_V(0);
    if constexpr (!ALIGN_EPI) { if (wr == 0) PG8_BAR; }
    PG8_BAR;
#undef PG8_SA
#undef PG8_SB
#undef PG8_STAGE
#undef PG8_STAGEA
#undef PG8_SETVOFF
#undef PG8_LDA
#undef PG8_LDB
#undef PG8_MMA
#undef PG8_WAIT_V
#undef PG8_WAIT_L
#undef PG8_BAR
#undef PG8_SCHED
}
}
#include <hip/hip_bf16.h>
#include <cmath>
namespace attn_body {
using bf16=__hip_bfloat16;
using bf16x8=__attribute__((ext_vector_type(8)))short;
using s16x4=__attribute__((ext_vector_type(4)))short;
using f32x16=__attribute__((ext_vector_type(16)))float;
using u32x4=__attribute__((ext_vector_type(4)))unsigned;
constexpr int SEQ=2048,D=64,QKP=512,VP=512,OP=1024;
constexpr int NW=8,QBLK=32,QB=QBLK*NW,KVBLK=64,NQB=SEQ/QB;
constexpr int ATTN_UNIT_ROWS=QB;
__device__ __forceinline__ int crow(int r,int hi){return (r&3)+8*(r>>2)+4*hi;}
#define SBAR() __builtin_amdgcn_sched_barrier(0)
__device__ __forceinline__ void cmask(f32x16&p0,f32x16&p1,int jb,int qrel,int hi){
  const float NEG=-INFINITY; int kb=64*jb+4*hi;
  #pragma unroll
  for(int r=0;r<16;++r){int kv=kb+(r&3)+8*(r>>2); if(kv>qrel)p0[r]=NEG; if(kv+32>qrel)p1[r]=NEG;}
}

constexpr int NSLOT=3, SLOTB=8192;
constexpr int LDS_K=0, LDS_V=NSLOT*SLOTB, LDS_WS=2*NSLOT*SLOTB, LDS_OST=LDS_WS+NW*64*4, LDS_BYTES=LDS_OST+NW*4096;
constexpr float C2=0.125f*1.4426950408889634f;
__device__ __forceinline__ void glds16(const void*gsrc,unsigned lds_dst){unsigned keep;
  asm volatile("s_mov_b32 %0, m0\n\ts_mov_b32 m0, %2\n\ts_nop 0\n\tglobal_load_lds_dwordx4 %1, off\n\ts_mov_b32 m0, %0":"=&s"(keep):"v"(gsrc),"s"(lds_dst):"memory");}
__device__ __forceinline__ float max3f(float a,float b,float c){float r;asm("v_max3_f32 %0, %1, %2, %3":"=v"(r):"v"(a),"v"(b),"v"(c));return r;}
__device__ __forceinline__ float max2f(float a,float b){float r;asm("v_max_f32_e32 %0, %1, %2":"=v"(r):"v"(a),"v"(b));return r;}
__device__ __forceinline__ float fadd_s(float a,float b){float r;asm("v_add_f32_e32 %0, %1, %2":"=v"(r):"v"(a),"v"(b));return r;}
__device__ __forceinline__ float fsub_s(float a,float b){float r;asm("v_sub_f32_e32 %0, %1, %2":"=v"(r):"v"(a),"v"(b));return r;}
typedef float f32x2_t __attribute__((ext_vector_type(2))); typedef __bf16 bf16x2_t __attribute__((ext_vector_type(2)));
__device__ __forceinline__ unsigned cvtpk_s(float lo,float hi){f32x2_t v={lo,hi};bf16x2_t b=__builtin_convertvector(v,bf16x2_t);return __builtin_bit_cast(unsigned,b);}
#define WAIT_BAR(N) asm volatile("s_waitcnt vmcnt(" #N ") lgkmcnt(0)\n\ts_barrier":::"memory")

__device__ __forceinline__ void qkt(f32x16&p0,f32x16&p1,const char*Kslot,const bf16x8*qr,const f32x16&negm,int r32,int hi){
  const char*kb=Kslot+hi*1024+r32*16;
  #pragma unroll
  for(int d0=0;d0<4;++d0){
    const bf16x8 b0=*reinterpret_cast<const bf16x8*>(kb+d0*2048);
    const bf16x8 b1=*reinterpret_cast<const bf16x8*>(kb+d0*2048+512);
    if(d0==0){p0=__builtin_amdgcn_mfma_f32_32x32x16_bf16(b0,qr[0],negm,0,0,0);p1=__builtin_amdgcn_mfma_f32_32x32x16_bf16(b1,qr[0],negm,0,0,0);}
    else{p0=__builtin_amdgcn_mfma_f32_32x32x16_bf16(b0,qr[d0],p0,0,0,0);p1=__builtin_amdgcn_mfma_f32_32x32x16_bf16(b1,qr[d0],p1,0,0,0);}}
}
typedef __attribute__((address_space(3))) const char* lds_cptr;
typedef short v4i16_t __attribute__((ext_vector_type(4)));
__device__ __forceinline__ void kload8(bf16x8*kf,lds_cptr kp){
  kf[0]=*(const __attribute__((address_space(3))) bf16x8*)(kp);      kf[1]=*(const __attribute__((address_space(3))) bf16x8*)(kp+512);
  kf[2]=*(const __attribute__((address_space(3))) bf16x8*)(kp+2048); kf[3]=*(const __attribute__((address_space(3))) bf16x8*)(kp+2560);
  kf[4]=*(const __attribute__((address_space(3))) bf16x8*)(kp+4096); kf[5]=*(const __attribute__((address_space(3))) bf16x8*)(kp+4608);
  kf[6]=*(const __attribute__((address_space(3))) bf16x8*)(kp+6144); kf[7]=*(const __attribute__((address_space(3))) bf16x8*)(kp+6656);
}
__device__ __forceinline__ void kload2(bf16x8*kf,lds_cptr kp,int j){ kf[2*j]=*(const __attribute__((address_space(3))) bf16x8*)(kp+j*2048); kf[2*j+1]=*(const __attribute__((address_space(3))) bf16x8*)(kp+j*2048+512); }
__device__ __forceinline__ s16x4 vtr(lds_cptr p){ return __builtin_bit_cast(s16x4,__builtin_amdgcn_ds_read_tr16_b64_v4i16((__attribute__((address_space(3))) v4i16_t*)p)); }
__device__ __forceinline__ float rowmax(const f32x16&p0,const f32x16&p1){
  float a=max3f(p0[0],p0[1],p1[0]),b=max3f(p0[2],p0[3],p1[1]);a=max3f(a,p1[2],p1[3]);
  #pragma unroll
  for(int r=4;r<16;r+=4){a=max3f(a,p0[r],p0[r+1]);b=max3f(b,p0[r+2],p0[r+3]);a=max3f(a,p1[r],p1[r+1]);b=max3f(b,p1[r+2],p1[r+3]);}
  const float m=max2f(a,b);
  auto rr=__builtin_amdgcn_permlane32_swap(__float_as_uint(m),__float_as_uint(m),false,false);
  return max2f(__uint_as_float(rr[0]),__uint_as_float(rr[1]));
}
__device__ __forceinline__ void pv(f32x16*o,int vb,bf16x8 pa0,bf16x8 pa1,bf16x8 pa2,bf16x8 pa3){
  #pragma unroll
  for(int d0=0;d0<2;++d0){s16x4 lo[4],hi[4];
    #pragma unroll
    for(int ks=0;ks<4;++ks){
      asm volatile("ds_read_b64_tr_b16 %0,%1 offset:%c2":"=&v"(lo[ks]):"v"(vb),"i"(d0*4096+ks*1024):"memory");
      asm volatile("ds_read_b64_tr_b16 %0,%1 offset:%c2":"=&v"(hi[ks]):"v"(vb),"i"(d0*4096+ks*1024+512):"memory");}
    asm volatile("s_waitcnt lgkmcnt(0)":::"memory");SBAR();
    #define PK(k) (bf16x8){lo[k][0],lo[k][1],lo[k][2],lo[k][3],hi[k][0],hi[k][1],hi[k][2],hi[k][3]}
    o[d0]=__builtin_amdgcn_mfma_f32_32x32x16_bf16(pa0,PK(0),o[d0],0,0,0);
    o[d0]=__builtin_amdgcn_mfma_f32_32x32x16_bf16(pa1,PK(1),o[d0],0,0,0);
    o[d0]=__builtin_amdgcn_mfma_f32_32x32x16_bf16(pa2,PK(2),o[d0],0,0,0);
    o[d0]=__builtin_amdgcn_mfma_f32_32x32x16_bf16(pa3,PK(3),o[d0],0,0,0);
    #undef PK
  }
}

#ifndef ATTN_STORE16
#define ATTN_STORE16(p,v) (*(u32x4*)(p)=(v))
#endif
template<int THRL> __device__ __forceinline__ void attn_unit(int b,int qcol,int vcol,int ocol,int qb,const bf16*Q,const bf16*__restrict__ K,const bf16*__restrict__ V,bf16*O,char*shm){
  const int tid=threadIdx.x,lane=tid&63,r32=lane&31,hi=lane>>5; const int wid=__builtin_amdgcn_readfirstlane(tid>>6);
  const long rowbase=(long)b*SEQ; const int q0=qb*QB;
  const bf16*Qw=Q+(rowbase+q0+wid*QBLK)*QKP+qcol;
  const bf16*Kh=K+rowbase*QKP+qcol,*Vh=V+rowbase*VP+vcol;
  const unsigned lds0=(unsigned)(uintptr_t)shm;
  float*wsf=(float*)(shm+LDS_WS)+wid*64;
  const bf16*ksrc=Kh+(long)lane*QKP+wid*8;
  const bf16*vsrc=Vh+(long)(16*(wid&3)+(lane>>2))*VP+(wid>>2)*32+(lane&3)*8;
  const unsigned kdst=lds0+LDS_K+wid*1024, vdst=lds0+LDS_V+wid*1024;
  #define DMA_K(t,slot) glds16(ksrc+(long)(t)*KVBLK*QKP,(unsigned)__builtin_amdgcn_readfirstlane(kdst+(slot)))
  #define DMA_V(t,slot) glds16(vsrc+(long)(t)*KVBLK*VP,(unsigned)__builtin_amdgcn_readfirstlane(vdst+(slot)))
  const int vb0=(int)(lds0+LDS_V)+((lane>>4)&1)*32+(lane&3)*8+(4*hi+((lane&15)>>2))*64;
  const char*Kbase=shm+LDS_K; bf16x8 kf[8];
  const lds_cptr shm3=(lds_cptr)shm; const lds_cptr kp0=shm3+LDS_K+hi*1024+r32*16; const lds_cptr vp0=shm3+LDS_V+((lane>>4)&1)*32+(lane&3)*8+(4*hi+((lane&15)>>2))*64;
  const int NT=(q0+QB)/KVBLK;
  DMA_K(0,0);DMA_V(0,0);DMA_K(1,SLOTB);
  bf16x8 qr[4];
  #pragma unroll
  for(int d0=0;d0<4;++d0)qr[d0]=*reinterpret_cast<const bf16x8*>(&Qw[(long)r32*QKP+d0*16+hi*8]);
  float mhat=0.f,l_reg=0.f;f32x16 o[2];o[0]=f32x16{};o[1]=f32x16{};f32x16 negm=f32x16{};asm volatile("":"+v"(negm));
  const int qrel=wid*QBLK+r32;
  #define CMASK(P0,P1,t) do{int jb_=(t)-(NT-4); if(jb_>=0)cmask(P0,P1,jb_,qrel,hi);}while(0)
  bool resc=false;
  #define START(P0,P1) do{ const float rm=rowmax(P0,P1); resc=false; \
    { const float dl=rm; mhat=fadd_s(mhat,dl); \
      _Pragma("unroll") for(int r=0;r<16;++r){P0[r]=fsub_s(P0[r],dl);P1[r]=fsub_s(P1[r],dl);} \
      _Pragma("unroll") for(int r=0;r<16;++r)negm[r]=-mhat; asm volatile("":"+v"(negm)); } \
    _Pragma("unroll") for(int r=0;r<16;++r)P0[r]=__builtin_amdgcn_exp2f(P0[r]); }while(0)
  #define RESC() do{ if(resc){ asm volatile("s_waitcnt lgkmcnt(0)":::"memory"); \
      _Pragma("unroll") for(int d_=0;d_<2;++d_) _Pragma("unroll") for(int r=0;r<16;++r)o[d_][r]*=wsf[crow(r,hi)]; } }while(0)
  f32x16 pA0,pA1,pB0,pB1;
  int sl_prev=0,sl_cur=0,sl_next=SLOTB;
  #define ROT() do{sl_prev=sl_cur;sl_cur=sl_next;sl_next=(sl_next==(NSLOT-1)*SLOTB)?0:sl_next+SLOTB;}while(0)
  DMA_K(2,2*SLOTB);
  WAIT_BAR(3);
  qkt(pA0,pA1,Kbase,qr,negm,r32,hi);asm volatile("s_nop 15\n\ts_nop 7":"+v"(pA0),"+v"(pA1));CMASK(pA0,pA1,0);
  START(pA0,pA1);
  _Pragma("unroll") for(int r=0;r<16;++r)pA1[r]=__builtin_amdgcn_exp2f(pA1[r]);
  WAIT_BAR(0);
  DMA_K(3,0);DMA_V(1,SLOTB);
  ROT();
  kload8(kf,kp0+sl_cur);
  WAIT_BAR(2);
  s16x4 vlo[8],vhi[8]; u32x4 pw0,pw1,pw2,pw3;
  #define PKW(P,B) cvtpk_s(P[B],P[B+1])
  #define PAF(k) __builtin_bit_cast(bf16x8,pw##k)
  #define VFR(i) (bf16x8){vlo[i][0],vlo[i][1],vlo[i][2],vlo[i][3],vhi[i][0],vhi[i][1],vhi[i][2],vhi[i][3]}
  #define PIN(x) asm volatile("":"+v"(x))
  #define MX3(a,b,c) __builtin_fmaxf(__builtin_fmaxf((a),(b)),(c))
  #define GAPA(MF,A0,A1,A2,A3,W0,W1,PW) do{ MF; sacc+=A0; sacc+=A1; sacc+=A2; sacc+=A3; PIN(sacc); W0; W1; PIN(PW); SBAR(); }while(0)
  #define EX(v) __builtin_amdgcn_exp2f(v)
  #define GAPB(MF,X,B) do{ MF; X[B]=EX(X[B]); X[B+1]=EX(X[B+1]); X[B+2]=EX(X[B+2]); X[B+3]=EX(X[B+3]); PIN(X); SBAR(); }while(0)
  #define VRD(i) do{ vlo[i]=vtr(vp_+(((i)>>2)*4096+((i)&3)*1024)); vhi[i]=vtr(vp_+(((i)>>2)*4096+((i)&3)*1024+512)); }while(0)
  #define KRD(G,j) do{ if(G){ kload2(kf,kp0+sl_next,j); SBAR(); } }while(0)
  #define STEP(C0,C1,P0,P1,t,GK,GV,GL) do{ SBAR(); \
    const lds_cptr vp_=vp0+sl_prev; \
    VRD(0); SBAR(); float sacc=(P0[0]+P0[1]); \
    GAPA(C0=__builtin_amdgcn_mfma_f32_32x32x16_bf16(kf[0],qr[0],negm,0,0,0), P0[2],P0[3],P0[4],P0[5],     pw0[0]=PKW(P0,0), pw0[1]=PKW(P0,2), pw0); \
    VRD(4); SBAR(); GAPA(C1=__builtin_amdgcn_mfma_f32_32x32x16_bf16(kf[1],qr[0],negm,0,0,0), P0[6],P0[7],P0[8],P0[9],     pw0[2]=PKW(P0,4), pw0[3]=PKW(P0,6), pw0); \
    VRD(1); SBAR(); GAPA(C0=__builtin_amdgcn_mfma_f32_32x32x16_bf16(kf[2],qr[1],C0,0,0,0),   P0[10],P0[11],P0[12],P0[13], pw1[0]=PKW(P0,8), pw1[1]=PKW(P0,10), pw1); \
    VRD(5); SBAR(); GAPA(C1=__builtin_amdgcn_mfma_f32_32x32x16_bf16(kf[3],qr[1],C1,0,0,0),   P0[14],P0[15],P1[0],P1[1],   pw1[2]=PKW(P0,12),pw1[3]=PKW(P0,14), pw1); \
    VRD(2); SBAR(); GAPA(C0=__builtin_amdgcn_mfma_f32_32x32x16_bf16(kf[4],qr[2],C0,0,0,0),   P1[2],P1[3],P1[4],P1[5],     pw2[0]=PKW(P1,0), pw2[1]=PKW(P1,2), pw2); \
    VRD(6); SBAR(); GAPA(C1=__builtin_amdgcn_mfma_f32_32x32x16_bf16(kf[5],qr[2],C1,0,0,0),   P1[6],P1[7],P1[8],P1[9],     pw2[2]=PKW(P1,4), pw2[3]=PKW(P1,6), pw2); \
    VRD(3); SBAR(); GAPA(C0=__builtin_amdgcn_mfma_f32_32x32x16_bf16(kf[6],qr[3],C0,0,0,0),   P1[10],P1[11],P1[12],P1[13], pw3[0]=PKW(P1,8), pw3[1]=PKW(P1,10), pw3); \
    VRD(7); SBAR(); GAPA(C1=__builtin_amdgcn_mfma_f32_32x32x16_bf16(kf[7],qr[3],C1,0,0,0),   P1[14],P1[15],0.f,0.f,       pw3[2]=PKW(P1,12),pw3[3]=PKW(P1,14), pw3); \
    l_reg+=sacc; \
    if(GK){DMA_K((t)+3,sl_cur);} if(GV){DMA_V((t)+1,sl_next);} \
    CMASK(C0,C1,t); \
    { float a=MX3(C0[0],C0[1],C1[0]),b=MX3(C0[2],C0[3],C1[1]); a=MX3(a,C1[2],C1[3]); \
      _Pragma("unroll") for(int r=4;r<16;r+=4){a=MX3(a,C0[r],C0[r+1]);b=MX3(b,C0[r+2],C0[r+3]);a=MX3(a,C1[r],C1[r+1]);b=MX3(b,C1[r+2],C1[r+3]);} \
      float rm=__builtin_fmaxf(a,b); { auto rr=__builtin_amdgcn_permlane32_swap(__float_as_uint(rm),__float_as_uint(rm),false,false); rm=__builtin_fmaxf(__uint_as_float(rr[0]),__uint_as_float(rr[1])); } \
      resc=false; \
      if(__builtin_expect(__any(rm>(float)THRL),0)){ const float dl=__builtin_fmaxf(rm,0.f); mhat+=dl; \
        _Pragma("unroll") for(int r=0;r<16;++r){C0[r]-=dl;C1[r]-=dl;} \
        _Pragma("unroll") for(int r=0;r<16;++r)negm[r]=-mhat; asm volatile("":"+v"(negm)); \
        const float f=__builtin_amdgcn_exp2f(-dl); l_reg*=f; if(hi==0)wsf[r32]=f; resc=true; } } \
    SBAR(); \
    GAPB(o[0]=__builtin_amdgcn_mfma_f32_32x32x16_bf16(PAF(0),VFR(0),o[0],0,0,0), C0,0); \
    GAPB(o[1]=__builtin_amdgcn_mfma_f32_32x32x16_bf16(PAF(0),VFR(4),o[1],0,0,0), C0,4); \
    KRD(GL,0); GAPB(o[0]=__builtin_amdgcn_mfma_f32_32x32x16_bf16(PAF(1),VFR(1),o[0],0,0,0), C0,8); \
    KRD(GL,1); GAPB(o[1]=__builtin_amdgcn_mfma_f32_32x32x16_bf16(PAF(1),VFR(5),o[1],0,0,0), C0,12); \
    KRD(GL,2); GAPB(o[0]=__builtin_amdgcn_mfma_f32_32x32x16_bf16(PAF(2),VFR(2),o[0],0,0,0), C1,0); \
    KRD(GL,3); GAPB(o[1]=__builtin_amdgcn_mfma_f32_32x32x16_bf16(PAF(2),VFR(6),o[1],0,0,0), C1,4); \
    GAPB(o[0]=__builtin_amdgcn_mfma_f32_32x32x16_bf16(PAF(3),VFR(3),o[0],0,0,0), C1,8); \
    GAPB(o[1]=__builtin_amdgcn_mfma_f32_32x32x16_bf16(PAF(3),VFR(7),o[1],0,0,0), C1,12); \
    }while(0)
  int t=1;
  #undef CMASK
  #define CMASK(P0,P1,t) do{}while(0)
  for(;t+5<NT;t+=2){
    STEP(pB0,pB1,pA0,pA1,t,true,true,true);     WAIT_BAR(2); RESC(); ROT();
    STEP(pA0,pA1,pB0,pB1,t+1,true,true,true);   WAIT_BAR(2); RESC(); ROT();
  }
  #undef CMASK
  #define CMASK(P0,P1,t) do{int jb_=(t)-(NT-4); if(jb_>=0)cmask(P0,P1,jb_,qrel,hi);}while(0)
  #define ENDW(tt) do{ if((tt)+3<NT){WAIT_BAR(2);} else if((tt)+2<NT){WAIT_BAR(1);} else {WAIT_BAR(0);} }while(0)
  for(;t+1<NT;t+=2){
    STEP(pB0,pB1,pA0,pA1,t,(t+3<NT),(t+1<NT),(t+1<NT));       ENDW(t);   RESC(); ROT();
    STEP(pA0,pA1,pB0,pB1,t+1,(t+4<NT),(t+2<NT),(t+2<NT));     ENDW(t+1); RESC(); ROT();
  }
  STEP(pB0,pB1,pA0,pA1,NT-1,false,false,false); RESC();
  { float sacc=pB0[0]+pB0[1]; _Pragma("unroll") for(int r=2;r<16;++r)sacc+=pB0[r]; _Pragma("unroll") for(int r=0;r<16;++r)sacc+=pB1[r]; l_reg+=sacc;
    pw0=(u32x4){PKW(pB0,0),PKW(pB0,2),PKW(pB0,4),PKW(pB0,6)};pw1=(u32x4){PKW(pB0,8),PKW(pB0,10),PKW(pB0,12),PKW(pB0,14)};pw2=(u32x4){PKW(pB1,0),PKW(pB1,2),PKW(pB1,4),PKW(pB1,6)};pw3=(u32x4){PKW(pB1,8),PKW(pB1,10),PKW(pB1,12),PKW(pB1,14)};
    SBAR(); pv(o,vb0+sl_cur,PAF(0),PAF(1),PAF(2),PAF(3)); }
  #undef PKW
  #undef PAF
  #undef VFR
  #undef PIN
  #undef MX3
  #undef GAPA
  #undef GAPB
  #undef EX
  #undef VRD
  #undef KRD
  #undef STEP
  #undef ENDW
  {auto rr=__builtin_amdgcn_permlane32_swap(__float_as_uint(l_reg),__float_as_uint(l_reg),false,false);l_reg=__uint_as_float(rr[0])+__uint_as_float(rr[1]);}
  if(hi==0)wsf[32+r32]=l_reg;asm volatile("s_waitcnt lgkmcnt(0)":::"memory");
  float rli[16];
  #pragma unroll
  for(int r=0;r<16;++r)rli[r]=__builtin_amdgcn_rcpf(wsf[32+crow(r,hi)]);
  bf16*Ow=O+(rowbase+q0+wid*QBLK)*OP+ocol;
  { bf16*stg=(bf16*)(shm+LDS_OST)+wid*2048;
    #pragma unroll
    for(int r=0;r<16;++r){const int orow=crow(r,hi);
      #pragma unroll
      for(int d0=0;d0<2;++d0)stg[orow*64+d0*32+r32]=__float2bfloat16(o[d0][r]*rli[r]);}
    asm volatile("s_waitcnt lgkmcnt(0)":::"memory");
    #pragma unroll
    for(int i=0;i<4;++i){const int row=i*8+(lane>>3),ch=lane&7; const u32x4 v=*(const u32x4*)(stg+row*64+ch*8); ATTN_STORE16(Ow+(long)row*OP+ch*8,v);} }
  asm volatile("s_waitcnt lgkmcnt(0)\n\ts_barrier":::"memory");
  #undef DMA_K
  #undef DMA_V
  #undef CMASK
  #undef START
  #undef RESC
  #undef ROT
}
constexpr int ATTN_LDS_BYTES=LDS_BYTES;
#undef SBAR
#undef WAIT_BAR
}

#define GAS __attribute__((address_space(1)))
#define LAS __attribute__((address_space(3)))
typedef unsigned short bf16;
typedef unsigned v4u __attribute__((ext_vector_type(4)));
typedef float f32x4 __attribute__((ext_vector_type(4)));
typedef short bf16x8 __attribute__((ext_vector_type(8)));
typedef GAS unsigned gu32;
typedef GAS unsigned long long gu64;
#define RLX_AGENT __ATOMIC_RELAXED, __HIP_MEMORY_SCOPE_AGENT
#define LDS_WAIT() asm volatile("s_waitcnt lgkmcnt(0)" ::: "memory")
#define VM_WAIT() asm volatile("s_waitcnt vmcnt(0)" ::: "memory")
__device__ __forceinline__ unsigned long long rt() { return __builtin_amdgcn_s_memrealtime(); }
__device__ __forceinline__ unsigned f2bf(float f) { unsigned u = __builtin_bit_cast(unsigned, f); return (u + 0x7fffu + ((u >> 16) & 1u)) >> 16; }
__device__ __forceinline__ unsigned pk2(float lo, float hi) { return f2bf(lo) | (f2bf(hi) << 16); }

#define XB_TMO      128
#define XB_XCNT(j)  (256  + 64 * (j))
#define XB_XSUB(j)  (1280 + 64 * (j))
#define XB_XGEN(j)  (2304 + 64 * (j))
#define XB_TOP      3328
#define XB_TOPGEN   3392
#define XCD_BAR_WORDS 3456
#define XB_SPIN_CAP (1u << 18)

__device__ __forceinline__ unsigned xb_ld(unsigned* p)              { return __hip_atomic_load(p, __ATOMIC_RELAXED, __HIP_MEMORY_SCOPE_AGENT); }
__device__ __forceinline__ unsigned xb_add(unsigned* p, unsigned v) { return __hip_atomic_fetch_add(p, v, __ATOMIC_RELAXED, __HIP_MEMORY_SCOPE_AGENT); }
__device__ __forceinline__ unsigned xb_xcc_id() { return (unsigned)__builtin_amdgcn_s_getreg((3 << 11) | 20) & 0xFu; }
#define XB_SPIN(cond, bar) do { unsigned _sp = 0; while (cond) { __builtin_amdgcn_s_sleep(1); \
    if ((++_sp & 255u) == 0u) { if (xb_ld(&(bar)[XB_TMO])) break; if (_sp > XB_SPIN_CAP) { atomicAdd(&(bar)[XB_TMO], 1u); break; } } } } while (0)

struct XcdBarrier {
    unsigned* bar; unsigned x;
    volatile LAS unsigned* st;
};

__device__ __forceinline__ XcdBarrier xcd_barrier_post(unsigned* bar, volatile LAS unsigned* st) {
    XcdBarrier b; b.bar = bar; b.x = xb_xcc_id(); b.st = st;
    if (threadIdx.x == 0) (void)xb_add(&bar[XB_XCNT(b.x)], 1u);
    return b;
}
__device__ __forceinline__ void xcd_barrier_complete(unsigned* bar, unsigned x, unsigned& nloc, unsigned& nx) {
    const unsigned G = gridDim.x * gridDim.y * gridDim.z;
    unsigned sum, cnt, mine, sp = 0u;
    for (;;) {
        sum = 0u; cnt = 0u; mine = 0u;
#pragma unroll
        for (unsigned j = 0; j < 16; ++j) { const unsigned c = xb_ld(&bar[XB_XCNT(j)]); sum += c; cnt += (c > 0u) ? 1u : 0u; mine = (j == x) ? c : mine; }
        if (sum == G) break;
        __builtin_amdgcn_s_sleep(1);
        if ((++sp & 255u) == 0u) { if (xb_ld(&bar[XB_TMO])) break; if (sp > XB_SPIN_CAP) { atomicAdd(&bar[XB_TMO], 1u); break; } }
    }
    nloc = mine > 0u ? mine : 1u; nx = cnt > 0u ? cnt : 1u;
}

__device__ __forceinline__ void xcd_barrier(const XcdBarrier& b) {
    asm volatile("s_waitcnt vmcnt(0)" ::: "memory");
    __syncthreads();
    if (threadIdx.x == 0) {
        unsigned* bar = b.bar;
        __builtin_amdgcn_s_waitcnt(0);
        unsigned nloc = b.st[0], nx = b.st[1];
        if (nloc == 0u) { xcd_barrier_complete(bar, b.x, nloc, nx); b.st[0] = nloc; b.st[1] = nx; }
        const unsigned old = xb_add(&bar[XB_XSUB(b.x)], 1u);
        const unsigned gen = old / nloc;
        if (old + 1u == (gen + 1u) * nloc) {
            __builtin_amdgcn_fence(__ATOMIC_RELEASE, "agent");
            asm volatile("s_waitcnt vmcnt(0)" ::: "memory");
            const unsigned og = xb_add(&bar[XB_TOP], 1u);
            const unsigned tg = og / nx;
            if (og + 1u == (tg + 1u) * nx) xb_add(&bar[XB_TOPGEN], 1u);
            else XB_SPIN(xb_ld(&bar[XB_TOPGEN]) == tg, bar);
            __builtin_amdgcn_fence(__ATOMIC_ACQUIRE, "agent");
            xb_add(&bar[XB_XGEN(b.x)], 1u);
            asm volatile("s_waitcnt vmcnt(0)" ::: "memory");
        } else {
            XB_SPIN(xb_ld(&bar[XB_XGEN(b.x)]) == gen, bar);
            __builtin_amdgcn_fence(__ATOMIC_ACQUIRE, "agent");
            asm volatile("s_waitcnt vmcnt(0)" ::: "memory");
        }
    }
    __syncthreads();
}

constexpr int NWAVES = 8;
constexpr int D = 1024, NB = 8, SEQ = 2048, M = NB * SEQ, NPROJ = 3584, NE = 32, FF = 512, NCH = SEQ / 64, NMOD = 6 * D;
constexpr int LCAP = 16384;
constexpr float RMS_EPS = 1e-6f, SUBLN_EPS = 1e-5f, LAMBDA_INIT = 0.2f;
#ifndef MK_N_LAUNCHES
#define MK_N_LAUNCHES 1
#endif
constexpr int NPH = 11;
constexpr size_t MiB = 1u << 20;
constexpr size_t WS_CTL = 0, CTL_ZERO_BYTES = 1 * MiB;
constexpr size_t WS_MOD = 1 * MiB;
constexpr size_t WS_EL = 1 * MiB + 512 * 1024;
constexpr size_t WS_ELIST = 2 * MiB, WS_WLIST = 4 * MiB;
constexpr size_t WS_WIN = 6 * MiB;
constexpr size_t WS_WOUT = 13 * MiB;
constexpr size_t WS_WGU = 16 * MiB;
constexpr size_t WS_UST = 16 * MiB;
constexpr size_t WS_WD = 80 * MiB;
constexpr size_t WS_MIXED = 80 * MiB;
constexpr size_t WS_RA = 112 * MiB;
constexpr size_t WS_Q = 144 * MiB, WS_K = 160 * MiB, WS_V = 176 * MiB, WS_QP = 192 * MiB, WS_KP = 208 * MiB, WS_VI = 224 * MiB, WS_SG = 240 * MiB;
constexpr size_t WS_PART = 144 * MiB;
constexpr size_t WS_HID = 208 * MiB;
constexpr size_t WS_END = 256 * MiB;
constexpr int CW_BAR = 4096;
constexpr int CW_CNT = 8192;
constexpr int RING_BYTES = 131072;
constexpr int LDSCTL_OFF = 147456;
constexpr int MISC_OFF = LDSCTL_OFF + 320;
constexpr int SCHED_OFF = LDSCTL_OFF + 1024;
constexpr int LDS_BYTES = 163840;

typedef unsigned u32x2v __attribute__((ext_vector_type(2)));
__device__ __forceinline__ float dpp_row_shr(float v, int n) {
    const int iv = __builtin_bit_cast(int, v); int r;
    switch (n) { case 1: r = __builtin_amdgcn_update_dpp(0, iv, 0x111, 0xf, 0xf, true); break; case 2: r = __builtin_amdgcn_update_dpp(0, iv, 0x112, 0xf, 0xf, true); break;
                 case 4: r = __builtin_amdgcn_update_dpp(0, iv, 0x114, 0xf, 0xf, true); break; default: r = __builtin_amdgcn_update_dpp(0, iv, 0x118, 0xf, 0xf, true); break; }
    return __builtin_bit_cast(float, r);
}
__device__ __forceinline__ float wave_sum(float v) {
    v += dpp_row_shr(v, 1); v += dpp_row_shr(v, 2); v += dpp_row_shr(v, 4); v += dpp_row_shr(v, 8);
    v += __builtin_bit_cast(float, __builtin_amdgcn_update_dpp(0, __builtin_bit_cast(int, v), 0x142, 0xa, 0xf, false));
    v += __builtin_bit_cast(float, __builtin_amdgcn_update_dpp(0, __builtin_bit_cast(int, v), 0x143, 0xc, 0xf, false));
    return __builtin_bit_cast(float, __builtin_amdgcn_readlane(__builtin_bit_cast(int, v), 63));
}
__device__ __forceinline__ float bf_lo(unsigned w) { return __uint_as_float(w << 16); }
__device__ __forceinline__ float bf_hi(unsigned w) { return __uint_as_float(w & 0xffff0000u); }
__device__ __forceinline__ float sigmoidf_(float x) { return 1.f / (1.f + __expf(-x)); }

struct Args { const float* in[24]; float* out; unsigned char* ws; int ph_lo, ph_hi; };

struct DenseOrder {
    int nM, nN, nwg, G, c; const char* Abase; const char* Bbase; size_t tstep; int pn_off, pn_cut, pn_shift;
    __device__ __forceinline__ void init(int M_, int N_, int K_, int G_, int c_, const void* A_, const void* B_, int off_ = 0, int cut_ = 1 << 30, int shift_ = 0) { nM = M_ / 256; nN = N_ / 256; nwg = nM * nN; G = G_; c = c_; Abase = (const char*)A_; Bbase = (const char*)B_; tstep = (size_t)256 * K_ * 2; pn_off = off_; pn_cut = cut_; pn_shift = shift_; }
    __device__ __forceinline__ bool next(int i, pg8::Unit& u) const {
        const long L = (long)i * G + c; if (L >= nwg) return false;
        int wgid = (int)L; { const int q = nwg / 8, r = nwg % 8, xcd = wgid % 8, off = wgid / 8; wgid = (xcd < r ? xcd * (q + 1) : r * (q + 1) + (xcd - r) * q) + off; }
        const int nig = 8 * nN, gid = wgid / nig, fm = gid * 8, gsz = (nM - fm) < 8 ? (nM - fm) : 8;
        u.pm = fm + ((wgid % nig) % gsz); { const int idx = (wgid % nig) / gsz; u.pn = idx + pn_off + (idx >= pn_cut ? pn_shift : 0); }
        u.A = Abase + (size_t)u.pm * tstep; u.B = Bbase + (size_t)u.pn * tstep; u.gidx = nullptr; u.rows = 256; u.e = 0; u.base = 0; return true;
    }
};
struct MoeOrder {
    const LAS int* tab; int G, c; int down; const char* Abase; const char* Bbase; const int* elist;
    __device__ __forceinline__ bool next(int i, pg8::Unit& u) const {
#ifndef MOE_REP
#define MOE_REP 1
#endif
        int L = i * G + c; const int T = tab[32];
        if (L >= T * 4 * MOE_REP) return false;
        if (MOE_REP > 1 && L >= T * 4) L -= T * 4;
        const int tile = L >> 2, sub = L & 3; int e = 0;
#pragma unroll 1
        for (int j = 1; j < 32; ++j) e = (tab[j] <= tile) ? j : e;
        const int rt = tile - tab[e], cnt = tab[66 + e], rb = tab[33 + e] + 256 * rt;
        u.pm = rt; u.pn = sub; u.e = e; u.base = rb; u.rows = (cnt - 256 * rt) < 256 ? (cnt - 256 * rt) : 256; u.gidx = elist + e * LCAP + 256 * rt;
        if (down) { u.A = Abase + (size_t)rb * (FF * 2); u.B = Bbase + ((size_t)e * 1024 + 256 * sub) * (FF * 2); }
        else      { u.A = Abase;                          u.B = Bbase + ((size_t)(e * 4 + sub) * 256) * (D * 2); }
        return true;
    }
};
__device__ __forceinline__ void sched_tables(LAS int* tab, gu32* cntw, int tid) {
    if (tid == 0) { int ts = 0, rb = 0;
        for (int e = 0; e < 32; ++e) { int cn = (int)__hip_atomic_load(cntw + 64 * e, RLX_AGENT); cn = cn > LCAP ? LCAP : cn; tab[e] = ts; tab[33 + e] = rb; tab[66 + e] = cn; ts += (cn + 255) >> 8; rb += cn; }
        tab[32] = ts; tab[65] = rb; }
    __syncthreads();
}

using pg8::u32x4; using pg8::cvt_pk_bf16;
__device__ __forceinline__ float silu_(float v) { return v / (1.f + __expf(-v)); }
constexpr float QSCALE = 0.125f * 1.4426950408889634f;
template <int EMASK> struct EpiInProj {
    bf16* R1; float* EL; const int* pos; const float* lbl;
    static constexpr size_t RSTR = (size_t)M * 512;
    __device__ __forceinline__ void operator()(f32x4 (&acc)[2][2][4][2], const pg8::Unit& u, int wr, int wc, int fr, int fq) const {
        asm volatile("" : "+v"(fr), "+v"(fq));
        const int pn = u.pn, rowb = u.pm * 256 + wr * 64 + fr;
        if ((EMASK & 1) && pn < 4) {
            const int part = pn >> 1, th = pn & 1; bf16* dst = R1 + (size_t)part * RSTR; const float qs = part ? 1.f : QSCALE;
            const int i0 = 16 * (wc & 1) + 4 * fq, dm0 = 32 * (wc & 1) + 8 * fq;
            float invf[4];
#pragma unroll
            for (int j = 0; j < 4; ++j) invf[j] = exp2f(-(float)(i0 + j) * 0.41524101186092029f);
#pragma unroll
            for (int ai = 0; ai < 2; ++ai)
#pragma unroll
                for (int m = 0; m < 4; ++m) { const int row = rowb + ai * 128 + m * 16; const float p = (float)pos[row]; float cs[4], sn[4];
#pragma unroll
                    for (int j = 0; j < 4; ++j) { float rev = p * invf[j] * 0.15915494309189535f; rev -= floorf(rev); sn[j] = __builtin_amdgcn_sinf(rev); cs[j] = __builtin_amdgcn_cosf(rev); }
#pragma unroll
                    for (int bj = 0; bj < 2; ++bj) { const int head = 4 * th + 2 * bj + (wc >> 1); const f32x4 x1 = acc[ai][bj][m][0], x2 = acc[ai][bj][m][1]; float o1[4], o2[4];
#pragma unroll
                        for (int j = 0; j < 4; ++j) { o1[j] = (x1[j] * cs[j] - x2[j] * sn[j]) * qs; o2[j] = (x2[j] * cs[j] + x1[j] * sn[j]) * qs; }
                        u32x4 w; w.x = cvt_pk_bf16(o1[0], o1[1]); w.y = cvt_pk_bf16(o1[2], o1[3]); w.z = cvt_pk_bf16(o2[0], o2[1]); w.w = cvt_pk_bf16(o2[2], o2[3]);
                        *(u32x4*)(dst + (size_t)row * 512 + head * 64 + dm0) = w; } }
        } else if ((EMASK & 2) && (pn < 6 || pn >= 10)) {
            bf16* dst = R1 + (size_t)(pn < 6 ? 2 : (pn < 12 ? 5 : 6)) * RSTR; const int cb = ((pn < 6 ? pn - 4 : (pn < 12 ? pn - 10 : pn - 12)) * 256) + wc * 32 + 8 * fq; const bool act = pn >= 12;
#pragma unroll
            for (int ai = 0; ai < 2; ++ai)
#pragma unroll
                for (int m = 0; m < 4; ++m) { const int row = rowb + ai * 128 + m * 16;
#pragma unroll
                    for (int bj = 0; bj < 2; ++bj) { f32x4 v0 = acc[ai][bj][m][0], v1 = acc[ai][bj][m][1];
                        if (act) {
#pragma unroll
                            for (int j = 0; j < 4; ++j) { v0[j] = silu_(v0[j]); v1[j] = silu_(v1[j]); } }
                        u32x4 w; w.x = cvt_pk_bf16(v0[0], v0[1]); w.y = cvt_pk_bf16(v0[2], v0[3]); w.z = cvt_pk_bf16(v1[0], v1[1]); w.w = cvt_pk_bf16(v1[2], v1[3]);
                        *(u32x4*)(dst + (size_t)row * 512 + cb + bj * 128) = w; } }
        } else if (EMASK & 4) {
            const int hh = pn - 6, k0 = wc * 32 + 8 * fq; float lb[2][4];
#pragma unroll
            for (int n = 0; n < 2; ++n)
#pragma unroll
                for (int j = 0; j < 4; ++j) { const int k = hh * 128 + k0 + 4 * n + j; lb[n][j] = 1.f / (1.f + __expf(lbl[512 + k] - lbl[k])); }
#pragma unroll
            for (int ai = 0; ai < 2; ++ai) {
#pragma unroll
                for (int m = 0; m < 4; ++m)
#pragma unroll
                    for (int n = 0; n < 2; ++n)
#pragma unroll
                        for (int j = 0; j < 4; ++j) { const float f = acc[ai][1][m][n][j]; const float t = __expf(fminf(-f, 80.f)); acc[ai][1][m][n][j] = (1.f - lb[n][j]) * (t / (1.f + t)); }
                const int chunk = u.pm * 4 + ai * 2 + wr;
#pragma unroll
                for (int n = 0; n < 2; ++n)
#pragma unroll
                    for (int j = 0; j < 4; ++j) { float carry = 0.f;
#pragma unroll
                        for (int m = 0; m < 4; ++m) { const float kin = acc[ai][1][m][n][j]; float x = __logf(1.f - kin);
#pragma unroll
                            for (int d = 1; d < 16; d <<= 1) { const float y = __shfl_up(x, d, 16); if (fr >= d) x += y; }
                            x += carry; carry = __shfl(x, 15, 16);
                            acc[ai][0][m][n][j] = silu_(acc[ai][0][m][n][j]) * __expf(x); acc[ai][1][m][n][j] = kin * __expf(-x); }
                        if (fr == 0) EL[(size_t)(chunk * 4 + hh) * 128 + k0 + 4 * n + j] = __expf(carry); }
#pragma unroll
                for (int m = 0; m < 4; ++m) { const int row = rowb + ai * 128 + m * 16; const f32x4 q0 = acc[ai][0][m][0], q1 = acc[ai][0][m][1], k0v = acc[ai][1][m][0], k1v = acc[ai][1][m][1];
                    u32x4 w; w.x = cvt_pk_bf16(q0[0], q0[1]); w.y = cvt_pk_bf16(q0[2], q0[3]); w.z = cvt_pk_bf16(q1[0], q1[1]); w.w = cvt_pk_bf16(q1[2], q1[3]);
                    *(u32x4*)(R1 + 3 * RSTR + (size_t)row * 512 + hh * 128 + k0) = w;
                    w.x = cvt_pk_bf16(k0v[0], k0v[1]); w.y = cvt_pk_bf16(k0v[2], k0v[3]); w.z = cvt_pk_bf16(k1v[0], k1v[1]); w.w = cvt_pk_bf16(k1v[2], k1v[3]);
                    *(u32x4*)(R1 + 4 * RSTR + (size_t)row * 512 + hh * 128 + k0) = w; } }
        }
    }
};
struct EpiOut {
    const float* x; const float* mod; float* out;
    __device__ __forceinline__ void operator()(f32x4 (&acc)[2][2][4][2], const pg8::Unit& u, int wr, int wc, int fr, int fq) const {
        const int rowb = u.pm * 256 + wr * 64 + fr, b = u.pm >> 3;
#pragma unroll
        for (int bj = 0; bj < 2; ++bj)
#pragma unroll
            for (int n = 0; n < 2; ++n) { const int col = u.pn * 256 + bj * 128 + wc * 32 + n * 16 + 4 * fq; const f32x4 g = *(const f32x4*)(mod + b * NMOD + 2 * D + col);
#pragma unroll
                for (int ai = 0; ai < 2; ++ai)
#pragma unroll
                    for (int m = 0; m < 4; ++m) { const size_t off = (size_t)(rowb + ai * 128 + m * 16) * D + col; *(f32x4*)(out + off) = *(const f32x4*)(x + off) + g * acc[ai][bj][m][n]; } }
    }
};
struct EpiGU {
    bf16* HID; const float* wlist;
    __device__ __forceinline__ void operator()(f32x4 (&acc)[2][2][4][2], const pg8::Unit& u, int wr, int wc, int fr, int fq) const {
        const int sb = wr * 64 + fr, cb = u.pn * 128 + wc * 32 + 8 * fq;
#pragma unroll
        for (int ai = 0; ai < 2; ++ai)
#pragma unroll
            for (int m = 0; m < 4; ++m) { const int s = sb + ai * 128 + m * 16;
                if (s < u.rows) { const float w = wlist[u.e * LCAP + u.pm * 256 + s]; const f32x4 g0 = acc[ai][0][m][0], g1 = acc[ai][0][m][1], u0 = acc[ai][1][m][0], u1 = acc[ai][1][m][1]; float h0[4], h1[4];
#pragma unroll
                    for (int j = 0; j < 4; ++j) { h0[j] = silu_(g0[j]) * u0[j] * w; h1[j] = silu_(g1[j]) * u1[j] * w; }
                    u32x4 o; o.x = cvt_pk_bf16(h0[0], h0[1]); o.y = cvt_pk_bf16(h0[2], h0[3]); o.z = cvt_pk_bf16(h1[0], h1[1]); o.w = cvt_pk_bf16(h1[2], h1[3]);
                    *(u32x4*)(HID + (size_t)(u.base + s) * FF + cb) = o; } }
    }
};
struct EpiDN {
    bf16* PART; const int* elist;
    __device__ __forceinline__ void operator()(f32x4 (&acc)[2][2][4][2], const pg8::Unit& u, int wr, int wc, int fr, int fq) const {
        const int sb = wr * 64 + fr, cb = u.pn * 256 + wc * 32 + 8 * fq;
#pragma unroll
        for (int ai = 0; ai < 2; ++ai)
#pragma unroll
            for (int m = 0; m < 4; ++m) { const int s = sb + ai * 128 + m * 16;
                if (s < u.rows) { const int ent = elist[u.e * LCAP + u.pm * 256 + s];
#pragma unroll
                    for (int bj = 0; bj < 2; ++bj) { const f32x4 v0 = acc[ai][bj][m][0], v1 = acc[ai][bj][m][1];
                        u32x4 o; o.x = cvt_pk_bf16(v0[0], v0[1]); o.y = cvt_pk_bf16(v0[2], v0[3]); o.z = cvt_pk_bf16(v1[0], v1[1]); o.w = cvt_pk_bf16(v1[2], v1[3]);
                        *(u32x4*)(PART + (size_t)ent * D + cb + bj * 128) = o; } } }
    }
};

__device__ __forceinline__ void transpose_item(const float* W, int ldw, int scol, bf16* dst_rows, int Kd, int k0, LAS float* scr, int lane) {
#pragma unroll 8
    for (int i = 0; i < 32; ++i) { const int kk = 2 * i + (lane >> 5); scr[kk * 33 + (lane & 31)] = W[(size_t)(k0 + kk) * ldw + scol]; }
    LDS_WAIT(); asm volatile("" ::: "memory");
    const int c = lane & 7;
#pragma unroll
    for (int j = 0; j < 4; ++j) { const int n = (lane >> 3) + 8 * j; const LAS float* s = scr + (8 * c) * 33 + n;
        v4u o; o.x = pk2(s[0 * 33], s[1 * 33]); o.y = pk2(s[2 * 33], s[3 * 33]); o.z = pk2(s[4 * 33], s[5 * 33]); o.w = pk2(s[6 * 33], s[7 * 33]);
        *(GAS v4u*)(dst_rows + (size_t)n * Kd + k0 + 8 * c) = o; }
    LDS_WAIT(); asm volatile("" ::: "memory");
}
__device__ __forceinline__ int plain32(int q) { return 8 * ((q >> 2) & 3) + 4 * (q >> 4) + (q & 3); }
__device__ __forceinline__ int win_col(int P) {
    const int pn = P >> 8, p = P & 255, bj = p >> 7, wc = (p >> 5) & 3, n = (p >> 4) & 1, fq = (p >> 2) & 3, j = p & 3;
    if (pn < 4) { const int part = pn >> 1, th = pn & 1, head = 4 * th + 2 * bj + (wc >> 1), d = 32 * n + 16 * (wc & 1) + 4 * fq + j; return part * 512 + head * 64 + d; }
    const int lc = 128 * bj + 32 * wc + 8 * fq + 4 * n + j;
    if (pn < 6) return 1024 + (pn - 4) * 256 + lc;
    if (pn < 10) { const int hh = pn - 6, kk = 32 * wc + 8 * fq + 4 * n + j; return (bj ? 2048 : 1536) + hh * 128 + kk; }
    if (pn < 12) return 2560 + (pn - 10) * 256 + lc;
    return 3072 + (pn - 12) * 256 + lc;
}

struct Ctx { LAS unsigned char* lds; unsigned char* ws; int vcu, G; };
#define PHASE_IDS const int tid_ = threadIdx.x, lane_ = tid_ & 63, wave_ = __builtin_amdgcn_readfirstlane(tid_ >> 6)

__device__ __forceinline__ void phase0(const Args& a, const Ctx& X) {
    PHASE_IDS;
    const float* c = a.in[1]; const float* w_ada = a.in[3]; const float* b_ada = a.in[4];
    LAS float* cs = (LAS float*)X.lds;
    LAS float* part = (LAS float*)(X.lds + 32768);
    float* mod = (float*)(X.ws + WS_MOD);
    if (X.vcu < 192) {
        for (int i = tid_; i < 8192; i += 512) cs[i] = silu_(c[i]);
        __syncthreads();
        for (int item = X.vcu; item < 192; item += X.G) {
            const int n0 = 32 * item, krow = lane_ >> 3, c4 = lane_ & 7; f32x4 acc[8];
#pragma unroll
            for (int b = 0; b < 8; ++b) acc[b] = (f32x4){0.f, 0.f, 0.f, 0.f};
#pragma unroll 4
            for (int it = 0; it < 16; ++it) { const int k = 128 * wave_ + 8 * it + krow; const f32x4 wv = *(const f32x4*)(w_ada + (size_t)k * NMOD + n0 + 4 * c4);
#pragma unroll
                for (int b = 0; b < 8; ++b) acc[b] += wv * cs[b * 1024 + k]; }
#pragma unroll
            for (int b = 0; b < 8; ++b)
#pragma unroll
                for (int j = 0; j < 4; ++j) { float v = acc[b][j]; v += __shfl_xor(v, 8); v += __shfl_xor(v, 16); v += __shfl_xor(v, 32); acc[b][j] = v; }
            if (lane_ < 8) {
#pragma unroll
                for (int b = 0; b < 8; ++b) *(LAS f32x4*)(part + (wave_ * 8 + b) * 32 + 4 * c4) = acc[b]; }
            __syncthreads();
            if (tid_ < 256) { const int b = tid_ >> 5, col = tid_ & 31; float s = b_ada[n0 + col];
#pragma unroll
                for (int w = 0; w < 8; ++w) s += part[(w * 8 + b) * 32 + col];
                mod[b * NMOD + n0 + col] = s; }
            __syncthreads();
        }
    }
    LAS float* scr = (LAS float*)(X.lds + 65536 + wave_ * 8448);
    const int gw = X.vcu * NWAVES + wave_, NGW = X.G * NWAVES;
    constexpr int I_IN = (NPROJ / 32) * 16, I_OUT = (D / 32) * 16;
    for (int it = gw; it < I_IN + I_OUT; it += NGW) {
        if (it < I_IN) { const int G32 = it >> 4, kb = it & 15; transpose_item(a.in[6], NPROJ, win_col(32 * G32 + (lane_ & 31)), (bf16*)(X.ws + WS_WIN) + (size_t)(32 * G32) * D, D, 64 * kb, scr, lane_); }
        else { const int r = it - I_IN, G32 = r >> 4, kb = r & 15; transpose_item(a.in[14], D, 32 * G32 + (lane_ & 31), (bf16*)(X.ws + WS_WOUT) + (size_t)(32 * G32) * D, D, 64 * kb, scr, lane_); }
    }
}
__device__ __forceinline__ void phase1(const Args& a, const Ctx& X) {
    PHASE_IDS;
    const float* x = a.in[0]; const float* nw = a.in[5]; const float* mod = (const float*)(X.ws + WS_MOD); bf16* H1 = (bf16*)(X.ws + WS_RA);
    const int gw = X.vcu * NWAVES + wave_, NGW = X.G * NWAVES;
    for (int m = gw; m < M; m += NGW) { const int b = m >> 11; const f32x4* xr = (const f32x4*)(x + (size_t)m * D) + lane_; f32x4 v[4]; float ss = 0.f;
#pragma unroll
        for (int j = 0; j < 4; ++j) { v[j] = xr[64 * j]; ss += (v[j].x * v[j].x + v[j].y * v[j].y) + (v[j].z * v[j].z + v[j].w * v[j].w); }
        const float rstd = 1.f / sqrtf(wave_sum(ss) * (1.f / D) + RMS_EPS);
#pragma unroll
        for (int j = 0; j < 4; ++j) { const int k = 256 * j + 4 * lane_; const f32x4 w = *(const f32x4*)(nw + k), sh = *(const f32x4*)(mod + b * NMOD + k), sc = *(const f32x4*)(mod + b * NMOD + D + k);
            const f32x4 h = v[j] * rstd * w * (sc + 1.f) + sh; u32x2v o; o.x = cvt_pk_bf16(h.x, h.y); o.y = cvt_pk_bf16(h.z, h.w); *(u32x2v*)(H1 + (size_t)m * D + k) = o; }
    }
}
__device__ __forceinline__ bf16x8 frag16(const LAS bf16* A, int ld, int r0, int k0, int lane) { return *(const LAS bf16x8*)(A + (r0 + (lane & 15)) * ld + k0 + 8 * (lane >> 4)); }
#define MFMA16(a, b, c) __builtin_amdgcn_mfma_f32_16x16x32_bf16(a, b, c, 0, 0, 0)
__device__ __forceinline__ void stage_T(const bf16* src, LAS bf16* dst, int wave, int lane) {
#pragma unroll
    for (int cc = 0; cc < 2; ++cc) { const int c = wave + 8 * cc; const v4u q = *(const v4u*)(src + (size_t)lane * 512 + 8 * c);
        dst[(8 * c + 0) * 72 + lane] = (bf16)(q.x & 0xffffu); dst[(8 * c + 1) * 72 + lane] = (bf16)(q.x >> 16); dst[(8 * c + 2) * 72 + lane] = (bf16)(q.y & 0xffffu); dst[(8 * c + 3) * 72 + lane] = (bf16)(q.y >> 16);
        dst[(8 * c + 4) * 72 + lane] = (bf16)(q.z & 0xffffu); dst[(8 * c + 5) * 72 + lane] = (bf16)(q.z >> 16); dst[(8 * c + 6) * 72 + lane] = (bf16)(q.w & 0xffffu); dst[(8 * c + 7) * 72 + lane] = (bf16)(q.w >> 16); }
}
__device__ __forceinline__ void phase3(const Args& a, const Ctx& X) {
    PHASE_IDS;
    LAS bf16* VT = (LAS bf16*)X.lds; LAS bf16* KT = (LAS bf16*)(X.lds + 18432);
    const bf16* VI = (const bf16*)(X.ws + WS_VI); const bf16* KP = (const bf16*)(X.ws + WS_KP); bf16* UST = (bf16*)(X.ws + WS_UST);
    for (int un = X.vcu; un < 1024; un += X.G) { const int c = un & 31, h = (un >> 5) & 3, b = un >> 7; const size_t row0 = (size_t)b * SEQ + c * 64;
        stage_T(VI + row0 * 512 + h * 128, VT, wave_, lane_); stage_T(KP + row0 * 512 + h * 128, KT, wave_, lane_);
        __syncthreads();
        f32x4 acc[8];
#pragma unroll
        for (int kt = 0; kt < 8; ++kt) acc[kt] = (f32x4){0.f, 0.f, 0.f, 0.f};
#pragma unroll
        for (int ks = 0; ks < 2; ++ks) { const bf16x8 af = frag16(VT, 72, 16 * wave_, 32 * ks, lane_);
#pragma unroll
            for (int kt = 0; kt < 8; ++kt) acc[kt] = MFMA16(af, frag16(KT, 72, 16 * kt, 32 * ks, lane_), acc[kt]); }
        bf16* U = UST + (size_t)un * 16384;
#pragma unroll
        for (int kt = 0; kt < 8; ++kt)
#pragma unroll
            for (int j = 0; j < 4; ++j) U[(16 * wave_ + (lane_ >> 4) * 4 + j) * 128 + 16 * kt + (lane_ & 15)] = (bf16)f2bf(acc[kt][j]);
        __syncthreads();
    }
}
__device__ __forceinline__ void phase4_scan(const Args& a, const Ctx& X, size_t dst_delta = 0) {
    PHASE_IDS;
    bf16* UST = (bf16*)(X.ws + WS_UST); const float* EL = (const float*)(X.ws + WS_EL);
    for (int g = X.vcu * 512 + tid_; g < 32 * 4096; g += X.G * 512) { const int bh = g >> 12, rem = g & 4095, v = rem >> 5, k4 = (rem & 31) * 4, h = bh & 3, b = bh >> 2;
        f32x4 S = (f32x4){0.f, 0.f, 0.f, 0.f};
#pragma unroll 4
        for (int c = 0; c < NCH; ++c) { u32x2v* p = (u32x2v*)(UST + (size_t)(bh * 32 + c) * 16384 + v * 128 + k4); const u32x2v uw = *p; const f32x4 e = *(const f32x4*)(EL + (size_t)((b * 32 + c) * 4 + h) * 128 + k4);
            u32x2v o; o.x = cvt_pk_bf16(S.x, S.y); o.y = cvt_pk_bf16(S.z, S.w); *(u32x2v*)((char*)p + dst_delta) = o;
            S.x = e.x * (S.x + bf_lo(uw.x)); S.y = e.y * (S.y + bf_hi(uw.x)); S.z = e.z * (S.z + bf_lo(uw.y)); S.w = e.w * (S.w + bf_hi(uw.y)); }
    }
}
struct AttnUnitU { int bvh; int qb; };
struct AttnOrder {
  int vcu;
#ifndef ATTN_REP
#define ATTN_REP 1
#endif
  __device__ __forceinline__ bool next(int i_, AttnUnitU& u) const { if (i_ >= 4 * ATTN_REP) return false; const int i = i_ & 3; const int s0 = 2 * (vcu & 1); u.bvh = vcu >> 1; u.qb = (i == 0) ? s0 : (i == 1) ? 7 - s0 : (i == 2) ? s0 + 1 : 6 - s0; return true; }
};
struct AttnT { const attn_body::bf16* Q; const attn_body::bf16* K; const attn_body::bf16* V; attn_body::bf16* O; };
template <class Sched> __device__ __forceinline__ void attn_phase_(char* lds, const AttnT& T, const Sched& S) {
  AttnUnitU u;
  for (int i = 0; S.next(i, u); ++i) { const int vh = u.bvh & 1, qh = (u.bvh >> 1) & 7, b = u.bvh >> 4; attn_body::attn_unit<8>(b, qh * 64, (qh >> 1) * 128 + vh * 64, qh * 128 + vh * 64, u.qb, T.Q, T.K, T.V, T.O, lds); }
}
__device__ __forceinline__ void phase4_attn(const Args& a, const Ctx& X, char* ldsg) {
    const AttnT T{(const attn_body::bf16*)(X.ws + WS_Q), (const attn_body::bf16*)(X.ws + WS_K), (const attn_body::bf16*)(X.ws + WS_V), (attn_body::bf16*)(X.ws + WS_RA)};
    const AttnOrder S{X.vcu};
    attn_phase_<AttnOrder>(ldsg, T, S);
}
__device__ __forceinline__ void phase5_hgrn(const Args& a, const Ctx& X) {
    PHASE_IDS;
    LAS bf16* QS = (LAS bf16*)X.lds; LAS bf16* KS = (LAS bf16*)(X.lds + 17408); LAS bf16* VT = (LAS bf16*)(X.lds + 34816); LAS bf16* STs = (LAS bf16*)(X.lds + 53248);
    LAS bf16* PS = (LAS bf16*)(X.lds + 88064); LAS float* OS = (LAS float*)(X.lds + 97280);
    const bf16* QP = (const bf16*)(X.ws + WS_QP); const bf16* KP = (const bf16*)(X.ws + WS_KP); const bf16* VI = (const bf16*)(X.ws + WS_VI); const bf16* SG = (const bf16*)(X.ws + WS_SG);
    const bf16* UST = (const bf16*)(X.ws + WS_UST); bf16* MIXED = (bf16*)(X.ws + WS_MIXED); const float* gnw = a.in[13];
    for (int un = X.vcu; un < 1024; un += X.G) { const int c = un & 31, h = (un >> 5) & 3, b = un >> 7; const size_t row0 = (size_t)b * SEQ + c * 64;
#pragma unroll
        for (int i = 0; i < 2; ++i) { const int idx = tid_ + 512 * i, row = idx >> 4, ch = idx & 15;
            *(LAS v4u*)(QS + row * 136 + ch * 8) = *(const v4u*)(QP + (row0 + row) * 512 + h * 128 + ch * 8); *(LAS v4u*)(KS + row * 136 + ch * 8) = *(const v4u*)(KP + (row0 + row) * 512 + h * 128 + ch * 8); }
#pragma unroll
        for (int i = 0; i < 4; ++i) { const int idx = tid_ + 512 * i, row = idx >> 4, ch = idx & 15; *(LAS v4u*)(STs + row * 136 + ch * 8) = *(const v4u*)(UST + (size_t)un * 16384 + row * 128 + ch * 8); }
        stage_T(VI + row0 * 512 + h * 128, VT, wave_, lane_);
        __syncthreads();
        { const int tt = wave_ >> 1; f32x4 s2[2];
#pragma unroll
          for (int x = 0; x < 2; ++x) s2[x] = (f32x4){0.f, 0.f, 0.f, 0.f};
#pragma unroll
          for (int ks = 0; ks < 4; ++ks) { const bf16x8 af = frag16(QS, 136, 16 * tt, 32 * ks, lane_);
#pragma unroll
              for (int x = 0; x < 2; ++x) s2[x] = MFMA16(af, frag16(KS, 136, 16 * (2 * (wave_ & 1) + x), 32 * ks, lane_), s2[x]); }
#pragma unroll
          for (int x = 0; x < 2; ++x) { const int st = 2 * (wave_ & 1) + x;
#pragma unroll
              for (int j = 0; j < 4; ++j) { const int t = 16 * tt + (lane_ >> 4) * 4 + j, s = 16 * st + (lane_ & 15); PS[t * 72 + s] = (bf16)f2bf(s <= t ? s2[x][j] : 0.f); } } }
        __syncthreads();
        { f32x4 o[4];
#pragma unroll
          for (int tt = 0; tt < 4; ++tt) o[tt] = (f32x4){0.f, 0.f, 0.f, 0.f};
#pragma unroll
          for (int ks = 0; ks < 2; ++ks) { const bf16x8 bfr = frag16(VT, 72, 16 * wave_, 32 * ks, lane_);
#pragma unroll
              for (int tt = 0; tt < 4; ++tt) o[tt] = MFMA16(frag16(PS, 72, 16 * tt, 32 * ks, lane_), bfr, o[tt]); }
#pragma unroll
          for (int ks = 0; ks < 4; ++ks) { const bf16x8 bfr = frag16(STs, 136, 16 * wave_, 32 * ks, lane_);
#pragma unroll
              for (int tt = 0; tt < 4; ++tt) o[tt] = MFMA16(frag16(QS, 136, 16 * tt, 32 * ks, lane_), bfr, o[tt]); }
#pragma unroll
          for (int tt = 0; tt < 4; ++tt)
#pragma unroll
              for (int j = 0; j < 4; ++j) OS[(16 * tt + (lane_ >> 4) * 4 + j) * 132 + 16 * wave_ + (lane_ & 15)] = o[tt][j]; }
        __syncthreads();
#pragma unroll
        for (int r = 0; r < 8; ++r) { const int t = 8 * wave_ + r; const float o0 = OS[t * 132 + 2 * lane_], o1 = OS[t * 132 + 2 * lane_ + 1];
            const float rstd = 1.f / sqrtf(wave_sum(o0 * o0 + o1 * o1) * (1.f / 128.f) + RMS_EPS); const unsigned sg = *(const unsigned*)(SG + (row0 + t) * 512 + h * 128 + 2 * lane_);
            *(unsigned*)(MIXED + (row0 + t) * 1024 + 512 + h * 128 + 2 * lane_) = cvt_pk_bf16(o0 * rstd * gnw[2 * lane_] * bf_lo(sg), o1 * rstd * gnw[2 * lane_ + 1] * bf_hi(sg)); }
        __syncthreads();
    }
}
__device__ __forceinline__ void phase5_comb(const Args& a, const Ctx& X) {
    PHASE_IDS;
    const bf16* AO = (const bf16*)(X.ws + WS_RA); bf16* MIXED = (bf16*)(X.ws + WS_MIXED); const float* sw = a.in[11];
    const float d1 = wave_sum(a.in[7][lane_] * a.in[8][lane_]), d2 = wave_sum(a.in[9][lane_] * a.in[10][lane_]); const float lam = expf(d1) - expf(d2) + LAMBDA_INIT;
    const int gw = X.vcu * NWAVES + wave_, NGW = X.G * NWAVES, hh = lane_ >> 4, ds = (lane_ & 15) * 8;
    float swv[8];
#pragma unroll
    for (int i = 0; i < 8; ++i) swv[i] = sw[ds + i] * (1.f - LAMBDA_INIT);
    for (int m = gw; m < M; m += NGW) { const v4u p1 = *(const v4u*)(AO + (size_t)m * 1024 + (2 * hh) * 128 + ds), p2 = *(const v4u*)(AO + (size_t)m * 1024 + (2 * hh + 1) * 128 + ds); float v[8];
        v[0] = bf_lo(p1.x) - lam * bf_lo(p2.x); v[1] = bf_hi(p1.x) - lam * bf_hi(p2.x); v[2] = bf_lo(p1.y) - lam * bf_lo(p2.y); v[3] = bf_hi(p1.y) - lam * bf_hi(p2.y);
        v[4] = bf_lo(p1.z) - lam * bf_lo(p2.z); v[5] = bf_hi(p1.z) - lam * bf_hi(p2.z); v[6] = bf_lo(p1.w) - lam * bf_lo(p2.w); v[7] = bf_hi(p1.w) - lam * bf_hi(p2.w);
        float ss = 0.f;
#pragma unroll
        for (int i = 0; i < 8; ++i) ss += v[i] * v[i];
        ss += __shfl_xor(ss, 1); ss += __shfl_xor(ss, 2); ss += __shfl_xor(ss, 4); ss += __shfl_xor(ss, 8);
        const float rstd = 1.f / sqrtf(ss * (1.f / 128.f) + SUBLN_EPS);
        v4u o; o.x = cvt_pk_bf16(v[0] * rstd * swv[0], v[1] * rstd * swv[1]); o.y = cvt_pk_bf16(v[2] * rstd * swv[2], v[3] * rstd * swv[3]);
        o.z = cvt_pk_bf16(v[4] * rstd * swv[4], v[5] * rstd * swv[5]); o.w = cvt_pk_bf16(v[6] * rstd * swv[6], v[7] * rstd * swv[7]);
        *(v4u*)(MIXED + (size_t)m * 1024 + hh * 128 + ds) = o; }
}
__device__ __forceinline__ void phase7_route(const Args& a, const Ctx& X, gu32* ctl, size_t list_delta = 0, int cnt_delta = 0) {
    PHASE_IDS;
    LAS float* WT = (LAS float*)X.lds;
    const float* wgr = a.in[16]; const float* bgr = a.in[17]; const float* wer = a.in[18]; const float* ber = a.in[19]; const float* nw = a.in[15];
    const float* x1 = a.out; const float* mod = (const float*)(X.ws + WS_MOD); bf16* H2 = (bf16*)(X.ws + WS_RA);
    int* elist = (int*)(X.ws + WS_ELIST + list_delta); float* wlist = (float*)(X.ws + WS_WLIST + list_delta);
#pragma unroll 4
    for (int i = 0; i < 16; ++i) { const int idx = tid_ + 512 * i, k = idx & 1023, o4 = idx >> 10; const f32x4 w = *(const f32x4*)(wer + k * 32 + 4 * o4);
        WT[(4 + 4 * o4 + 0) * 1024 + k] = w.x; WT[(4 + 4 * o4 + 1) * 1024 + k] = w.y; WT[(4 + 4 * o4 + 2) * 1024 + k] = w.z; WT[(4 + 4 * o4 + 3) * 1024 + k] = w.w; }
#pragma unroll
    for (int i = 0; i < 2; ++i) { const int k = tid_ + 512 * i; const f32x4 w = *(const f32x4*)(wgr + k * 4); WT[0 * 1024 + k] = w.x; WT[1 * 1024 + k] = w.y; WT[2 * 1024 + k] = w.z; WT[3 * 1024 + k] = w.w; }
    LAS int* rE = (LAS int*)(X.lds + LDSCTL_OFF + 2048); LAS float* rW = (LAS float*)(rE + 128); LAS unsigned* lcnt = (LAS unsigned*)(rE + 256); LAS unsigned* lbase = lcnt + 32;
    if (tid_ < 32) lcnt[tid_] = 0u;
    if (tid_ < 128) rE[tid_] = -1;
    __syncthreads();
    const int gw = X.vcu * NWAVES + wave_, NGW = X.G * NWAVES; int trip = 0;
    f32x4 xn[4];
    if (gw < M) {
#pragma unroll
        for (int j = 0; j < 4; ++j) xn[j] = ((const f32x4*)(x1 + (size_t)gw * D) + lane_)[64 * j]; }
    for (int m = gw; m < M; m += NGW, ++trip) { const int b = m >> 11; f32x4 h[4]; float ss = 0.f;
#pragma unroll
        for (int j = 0; j < 4; ++j) { h[j] = xn[j]; ss += (h[j].x * h[j].x + h[j].y * h[j].y) + (h[j].z * h[j].z + h[j].w * h[j].w); }
        if (m + NGW < M) {
#pragma unroll
            for (int j = 0; j < 4; ++j) xn[j] = ((const f32x4*)(x1 + (size_t)(m + NGW) * D) + lane_)[64 * j]; }
        const float rstd = 1.f / sqrtf(wave_sum(ss) * (1.f / D) + RMS_EPS);
#pragma unroll
        for (int j = 0; j < 4; ++j) { const int k = 256 * j + 4 * lane_; const f32x4 w = *(const f32x4*)(nw + k), sh = *(const f32x4*)(mod + b * NMOD + 3 * D + k), sc = *(const f32x4*)(mod + b * NMOD + 4 * D + k);
            h[j] = h[j] * rstd * w * (sc + 1.f) + sh; u32x2v o; o.x = cvt_pk_bf16(h[j].x, h[j].y); o.y = cvt_pk_bf16(h[j].z, h[j].w); *(u32x2v*)(H2 + (size_t)m * D + k) = o; }
        float gl[4];
#pragma unroll
        for (int g = 0; g < 4; ++g) { float s = 0.f;
#pragma unroll
            for (int j = 0; j < 4; ++j) { const f32x4 w = *(const LAS f32x4*)(WT + g * 1024 + 256 * j + 4 * lane_); s += (h[j].x * w.x + h[j].y * w.y) + (h[j].z * w.z + h[j].w * w.w); }
            gl[g] = wave_sum(s) + bgr[g]; }
        int gs = 0; float gm = gl[0];
#pragma unroll
        for (int g = 1; g < 4; ++g) if (gl[g] > gm) { gm = gl[g]; gs = g; }
        float den = 0.f;
#pragma unroll
        for (int g = 0; g < 4; ++g) den += expf(gl[g] - gm);
        const float pg = 1.f / den;
        float el[8]; const LAS float* WE = WT + (4 + 8 * gs) * 1024;
#pragma unroll
        for (int i = 0; i < 8; ++i) { float s = 0.f;
#pragma unroll
            for (int j = 0; j < 4; ++j) { const f32x4 w = *(const LAS f32x4*)(WE + i * 1024 + 256 * j + 4 * lane_); s += (h[j].x * w.x + h[j].y * w.y) + (h[j].z * w.z + h[j].w * w.w); }
            el[i] = wave_sum(s) + ber[gs * 8 + i]; }
        int i1 = 0; float m1 = el[0];
#pragma unroll
        for (int i = 1; i < 8; ++i) if (el[i] > m1) { m1 = el[i]; i1 = i; }
        int i2 = -1; float m2 = -INFINITY;
#pragma unroll
        for (int i = 0; i < 8; ++i) if (i != i1 && (i2 < 0 || el[i] > m2)) { m2 = el[i]; i2 = i; }
        const float t = expf(m2 - m1), w1 = pg / (1.f + t), w2 = pg * t / (1.f + t);
        if (lane_ == 0 && trip < 8) { const int li = trip * 8 + wave_; rE[2 * li] = gs * 8 + i1; rE[2 * li + 1] = gs * 8 + i2; rW[2 * li] = w1; rW[2 * li + 1] = w2; }
    }
    __syncthreads();
    int e = -1; unsigned loc = 0u;
    if (tid_ < 128) { e = rE[tid_]; if (e >= 0) loc = __hip_atomic_fetch_add(lcnt + e, 1u, __ATOMIC_RELAXED, __HIP_MEMORY_SCOPE_WORKGROUP); }
    __syncthreads();
    if (tid_ < 32) { const unsigned cn = lcnt[tid_]; lbase[tid_] = cn ? __hip_atomic_fetch_add(ctl + CW_CNT + cnt_delta + 64 * tid_, cn, RLX_AGENT) : 0u; }
    __syncthreads();
    if (tid_ < 128 && e >= 0) { const unsigned slot = lbase[e] + loc; const int li = tid_ >> 1, m = X.vcu * NWAVES + (li & 7) + (li >> 3) * NGW;
        if (slot < (unsigned)LCAP) { elist[e * LCAP + slot] = 2 * m + (tid_ & 1); wlist[e * LCAP + slot] = rW[tid_]; } }
}
__device__ __forceinline__ void phase7_conv(const Args& a, const Ctx& X) {
    PHASE_IDS;
    LAS float* scr = (LAS float*)(X.lds + wave_ * 8448);
    const int gw = X.vcu * NWAVES + wave_, NGW = X.G * NWAVES;
    constexpr int I_GU = 32 * 4 * 8 * 16, I_DN = 32 * 32 * 8;
    for (int it = gw; it < I_GU + I_DN; it += NGW) {
        if (it < I_GU) { const int kb = it & 15, g8 = (it >> 4) & 7, sub = (it >> 7) & 3, e = it >> 9, bj = g8 >> 2, wc = g8 & 3;
            const float* W = (bj ? a.in[21] : a.in[20]) + (size_t)e * D * FF; const int scol = 128 * sub + 32 * wc + plain32(lane_ & 31);
            transpose_item(W, FF, scol, (bf16*)(X.ws + WS_WGU) + ((size_t)(e * 4 + sub) * 256 + 32 * g8) * D, D, 64 * kb, scr, lane_); }
        else { const int r = it - I_GU, kb = r & 7, G32 = (r >> 3) & 31, e = r >> 8; const float* W = a.in[22] + (size_t)e * FF * D; const int scol = 32 * G32 + plain32(lane_ & 31);
            transpose_item(W, D, scol, (bf16*)(X.ws + WS_WD) + ((size_t)e * 1024 + 32 * G32) * FF, FF, 64 * kb, scr, lane_); }
    }
}
__device__ __forceinline__ void phase10(const Args& a, const Ctx& X, float* dst = nullptr) {
    PHASE_IDS;
    float* out = a.out; const float* mod = (const float*)(X.ws + WS_MOD); const bf16* PART = (const bf16*)(X.ws + WS_PART); const float* fw = a.in[23];
    const int gw = X.vcu * NWAVES + wave_, NGW = X.G * NWAVES;
    for (int m = gw; m < M; m += NGW) { const int b = m >> 11; f32x4* xr = (f32x4*)(out + (size_t)m * D) + lane_; f32x4* xw = dst ? (f32x4*)(dst + (size_t)m * D) + lane_ : xr; f32x4 y[4]; float ss = 0.f;
#pragma unroll
        for (int j = 0; j < 4; ++j) { const int k = 256 * j + 4 * lane_; const f32x4 g = *(const f32x4*)(mod + b * NMOD + 5 * D + k);
            const u32x2v p0 = *(const u32x2v*)(PART + (size_t)(2 * m) * D + k), p1 = *(const u32x2v*)(PART + (size_t)(2 * m + 1) * D + k);
            f32x4 f; f.x = bf_lo(p0.x) + bf_lo(p1.x); f.y = bf_hi(p0.x) + bf_hi(p1.x); f.z = bf_lo(p0.y) + bf_lo(p1.y); f.w = bf_hi(p0.y) + bf_hi(p1.y);
            y[j] = xr[64 * j] + g * f; ss += (y[j].x * y[j].x + y[j].y * y[j].y) + (y[j].z * y[j].z + y[j].w * y[j].w); }
        const float rstd = 1.f / sqrtf(wave_sum(ss) * (1.f / D) + RMS_EPS);
#pragma unroll
        for (int j = 0; j < 4; ++j) { const int k = 256 * j + 4 * lane_; xw[64 * j] = y[j] * rstd * *(const f32x4*)(fw + k); }
    }
}

__global__ void __launch_bounds__(NWAVES * 64, 2) hymba_fwd(Args args) {
    extern __shared__ __attribute__((aligned(16))) unsigned char lds[];
    Ctx X; X.lds = (LAS unsigned char*)lds; X.ws = args.ws;
    X.G = gridDim.x; { const int bx = blockIdx.x; X.vcu = (X.G % 8 == 0) ? (bx % 8) * (X.G / 8) + bx / 8 : bx; }
    gu32* ctl = (gu32*)(args.ws + WS_CTL);
    for (int u = threadIdx.x; u < (LDS_BYTES - LDSCTL_OFF) / 4; u += NWAVES * 64) ((LAS unsigned*)(X.lds + LDSCTL_OFF))[u] = 0u;
    __syncthreads();
    if (MK_N_LAUNCHES == 1) (void)xcd_barrier_post((unsigned*)(ctl + CW_BAR), (volatile LAS unsigned*)(X.lds + MISC_OFF) + 8);
    const int lo = args.ph_lo, hi = args.ph_hi;
#ifndef PH_MASK
#define PH_MASK 0x7ff
#endif
#define IN(k) ((((PH_MASK) >> (k)) & 1) && lo <= (k) && (k) < hi)
#define SEAM(k) do { if (IN(k) && IN((k) + 1)) { XcdBarrier bar_; bar_.bar = (unsigned*)((gu32*)(args.ws + WS_CTL) + CW_BAR); bar_.x = xb_xcc_id(); bar_.st = (volatile LAS unsigned*)(X.lds + MISC_OFF) + 8; xcd_barrier(bar_); } } while (0)
    LAS int* tab = (LAS int*)(X.lds + SCHED_OFF);
#ifndef DUP_MASK
#define DUP_MASK 0
#endif
#define GBAR() do { XcdBarrier bar_; bar_.bar = (unsigned*)((gu32*)(args.ws + WS_CTL) + CW_BAR); bar_.x = xb_xcc_id(); bar_.st = (volatile LAS unsigned*)(X.lds + MISC_OFF) + 8; xcd_barrier(bar_); } while (0)
#define DUP(k) (((DUP_MASK) >> (k)) & 1)
    if (IN(0)) { phase0(args, X); if (DUP(0)) { GBAR(); phase0(args, X); } } SEAM(0);
    if (IN(1)) { phase1(args, X); if (DUP(1)) { GBAR(); phase1(args, X); } } SEAM(1);
    if (IN(2)) {
        { DenseOrder S; S.init(M, 2560, D, X.G, (int)blockIdx.x, args.ws + WS_RA, args.ws + WS_WIN, 0, 6, 4);
          EpiInProj<3> E{(bf16*)(args.ws + WS_Q), (float*)(args.ws + WS_EL), (const int*)args.in[2], args.in[12]};
          pg8::gemm_phase<EpiInProj<3>, DenseOrder, false, true>(X.lds, D, S, E); }
        { DenseOrder S; S.init(M, 1024, D, X.G, (int)blockIdx.x, args.ws + WS_RA, args.ws + WS_WIN, 6);
          EpiInProj<4> E{(bf16*)(args.ws + WS_Q), (float*)(args.ws + WS_EL), (const int*)args.in[2], args.in[12]};
          pg8::gemm_phase<EpiInProj<4>, DenseOrder, false, true>(X.lds, D, S, E); }
        if (DUP(2)) { GBAR(); { DenseOrder S; S.init(M, 2560, D, X.G, (int)blockIdx.x, args.ws + WS_RA, args.ws + WS_WIN, 0, 6, 4); EpiInProj<3> E{(bf16*)(args.ws + WS_Q), (float*)(args.ws + WS_EL), (const int*)args.in[2], args.in[12]}; pg8::gemm_phase<EpiInProj<3>, DenseOrder, false, true>(X.lds, D, S, E); }
          { DenseOrder S; S.init(M, 1024, D, X.G, (int)blockIdx.x, args.ws + WS_RA, args.ws + WS_WIN, 6); EpiInProj<4> E{(bf16*)(args.ws + WS_Q), (float*)(args.ws + WS_EL), (const int*)args.in[2], args.in[12]}; pg8::gemm_phase<EpiInProj<4>, DenseOrder, false, true>(X.lds, D, S, E); } } } SEAM(2);
    if (IN(3)) { phase3(args, X); if (DUP(3)) { GBAR(); phase3(args, X); } } SEAM(3);
    if (IN(4)) { if (DUP(11)) { phase4_scan(args, X, WS_WD - WS_UST); GBAR(); } phase4_scan(args, X); phase4_attn(args, X, (char*)lds); } SEAM(4);
    if (IN(5)) { phase5_hgrn(args, X); phase5_comb(args, X); if (DUP(5)) { GBAR(); phase5_hgrn(args, X); phase5_comb(args, X); } } SEAM(5);
    if (IN(6)) { DenseOrder S; S.init(M, D, D, X.G, (int)blockIdx.x, args.ws + WS_MIXED, args.ws + WS_WOUT);
        EpiOut E{args.in[0], (const float*)(args.ws + WS_MOD), args.out};
        pg8::gemm_phase<EpiOut, DenseOrder, false, true>(X.lds, D, S, E); if (DUP(6)) { GBAR(); pg8::gemm_phase<EpiOut, DenseOrder, false, true>(X.lds, D, S, E); } } SEAM(6);
    if (IN(7)) { if (DUP(12)) { phase7_route(args, X, ctl, WS_HID - WS_ELIST, 4096); GBAR(); } phase7_route(args, X, ctl); __syncthreads(); phase7_conv(args, X); if (DUP(7)) { GBAR(); phase7_conv(args, X); } } SEAM(7);
    if (IN(8)) { sched_tables(tab, ctl + CW_CNT, (int)threadIdx.x);
        MoeOrder S{tab, X.G, (int)blockIdx.x, 0, (const char*)(args.ws + WS_RA), (const char*)(args.ws + WS_WGU), (const int*)(args.ws + WS_ELIST)};
        EpiGU E{(bf16*)(args.ws + WS_HID), (const float*)(args.ws + WS_WLIST)};
        pg8::gemm_phase<EpiGU, MoeOrder, true, true>(X.lds, D, S, E); } SEAM(8);
    if (IN(9)) { sched_tables(tab, ctl + CW_CNT, (int)threadIdx.x);
        MoeOrder S{tab, X.G, (int)blockIdx.x, 1, (const char*)(args.ws + WS_HID), (const char*)(args.ws + WS_WD), (const int*)(args.ws + WS_ELIST)};
        EpiDN E{(bf16*)(args.ws + WS_PART), (const int*)(args.ws + WS_ELIST)};
        pg8::gemm_phase<EpiDN, MoeOrder, false, true>(X.lds, FF, S, E); } SEAM(9);
    if (IN(10)) { if (DUP(13)) { phase10(args, X, (float*)(args.ws + WS_WGU)); GBAR(); } phase10(args, X); }
#undef IN
#undef SEAM
}

extern "C" void kernel_launch(void* const* d_in, const int* in_sizes, int n_in, void* d_out, int out_size, void* d_ws, size_t ws_size, hipStream_t stream) {
    static int grid = 0;
    if (grid == 0) {
        if (n_in != 24 || in_sizes[0] != M * D || out_size != M * D || ws_size < WS_END) { fprintf(stderr, "kernel_launch: unexpected shapes (n_in %d, in0 %d, out %d, ws %zu); nothing launched\n", n_in, n_in > 0 ? in_sizes[0] : -1, out_size, ws_size); grid = -1; return; }
        int dev = 0, cus = 0, per_cu = 0;
        if (hipGetDevice(&dev) != hipSuccess || hipDeviceGetAttribute(&cus, hipDeviceAttributeMultiprocessorCount, dev) != hipSuccess) { fprintf(stderr, "kernel_launch: device query failed\n"); grid = -1; return; }
        if (hipFuncSetAttribute((const void*)hymba_fwd, hipFuncAttributeMaxDynamicSharedMemorySize, LDS_BYTES) != hipSuccess) { fprintf(stderr, "kernel_launch: hipFuncSetAttribute failed\n"); grid = -1; return; }
        if (hipOccupancyMaxActiveBlocksPerMultiprocessor(&per_cu, (const void*)hymba_fwd, NWAVES * 64, LDS_BYTES) != hipSuccess || per_cu < 1) { fprintf(stderr, "kernel_launch: occupancy query reports %d workgroups per CU\n", per_cu); (void)hipGetLastError(); grid = -1; return; }
        if (cus != 256) { fprintf(stderr, "kernel_launch: built for a 256-CU device, found %d CUs; nothing launched\n", cus); grid = -1; return; }
        grid = cus;
    }
    if (grid < 0) return;
    (void)hipMemsetAsync((char*)d_ws + WS_CTL, 0, CTL_ZERO_BYTES, stream);
    Args a{};
    for (int i = 0; i < 24; ++i) a.in[i] = (const float*)d_in[i];
    a.out = (float*)d_out; a.ws = (unsigned char*)d_ws;
    if (MK_N_LAUNCHES == 1) { a.ph_lo = 0; a.ph_hi = NPH; hipLaunchKernelGGL(hymba_fwd, dim3(grid), dim3(NWAVES * 64), LDS_BYTES, stream, a); }
    else { for (int p = 0; p < NPH; ++p) { a.ph_lo = p; a.ph_hi = p + 1; hipLaunchKernelGGL(hymba_fwd, dim3(grid), dim3(NWAVES * 64), LDS_BYTES, stream, a); } }
}
```

```cpp
#include <hip/hip_runtime.h>
#include <hip/hip_bf16.h>
#include <cstdio>
#include <cstdint>
#include <cmath>
namespace pg8 {
#define PG8_LAS __attribute__((address_space(3)))
typedef unsigned short bf16_t;
typedef short bf16x8 __attribute__((ext_vector_type(8)));
typedef float f32x4 __attribute__((ext_vector_type(4)));
typedef unsigned u32x4 __attribute__((ext_vector_type(4)));
constexpr int BM = 256, BK = 64, HALF = 128, HTB = HALF * BK * 2  , STAGE_BYTES = 8 * HTB, NXCD = 8, WGM = 8;
__host__ __device__ __forceinline__ int lds_byte(int r, int c) { const int st = (r >> 4) * 2 + (c >> 5), rr = r & 15, cc = c & 31, ob = rr * 64 + cc * 2; return st * 1024 + (ob ^ (((ob >> 9) & 1) << 5)); }
__host__ __device__ __forceinline__ void stage_rc(int b, int& R, int& C) { const int st = b / 1024, sb = b % 1024, swz = sb ^ (((sb >> 9) & 1) << 5); R = (st >> 1) * 16 + swz / 64; C = (st & 1) * 32 + (swz % 64) / 2; }
struct Unit { int pm, pn; const char* A; const char* B; const int* gidx; int rows; int e; int base; };
__device__ __forceinline__ unsigned cvt_pk_bf16(float lo, float hi) { unsigned r; asm volatile("v_cvt_pk_bf16_f32 %0, %1, %2" : "=v"(r) : "v"(lo), "v"(hi)); return r; }
template <class Epi, class Sched, bool GATHER, bool ALIGN_EPI>
__device__ __forceinline__ void gemm_phase(PG8_LAS unsigned char* lds, const int K, const Sched& S, const Epi& E) {
    constexpr bool SP2 = true;
    const int tid = threadIdx.x, wid = __builtin_amdgcn_readfirstlane(tid >> 6), lane = tid & 63, wr = wid >> 2, wc = wid & 3, fr = lane & 15, fq = lane >> 4;
    const int nt = K / BK;
    unsigned voffB[2]; int RA[2], CA[2];
#pragma unroll
    for (int i = 0; i < 2; ++i) { int R, C; stage_rc(tid * 16 + i * 8192, R, C); RA[i] = R; CA[i] = C; voffB[i] = (unsigned)(R * K + C) * 2u; }
#define PG8_SETVOFF(dst, u) do { _Pragma("unroll") for (int _h = 0; _h < 2; ++_h) _Pragma("unroll") for (int _i = 0; _i < 2; ++_i) { int _r = _h * HALF + RA[_i]; \
        if constexpr (GATHER) { _r = _r < (u).rows ? _r : (u).rows - 1; _r = (u).gidx[_r] >> 1; } \
        dst[_h][_i] = (unsigned)(_r * K + CA[_i]) * 2u; } } while (0)
    const size_t kstep = (size_t)(BK * 2);
    const size_t hstep = (size_t)HALF * K * 2;
    const unsigned ldsw = (unsigned)wid * 1024u;
    const int aoff = lds_byte(wr * 64 + fr, fq * 8), boff = lds_byte(wc * 32 + fr, fq * 8);
#define PG8_SA(b, h) (((b) * 2 + (h)) * HTB)
#define PG8_SB(b, h) ((4 + (b) * 2 + (h)) * HTB)
#define PG8_STAGE(bufoff, gbase, voff) do { _Pragma("unroll") for (int _i = 0; _i < 2; ++_i) \
        __builtin_amdgcn_global_load_lds((const unsigned*)((const char*)(gbase) + (voff)[_i]), (PG8_LAS unsigned*)(lds + (bufoff) + ldsw + _i * 8192), 16, 0, 0); } while (0)
#define PG8_STAGEA(bufoff, gbase, h) PG8_STAGE(bufoff, gbase, vA[h])
#define PG8_LDA(dst, b, h) do { _Pragma("unroll") for (int m = 0; m < 4; ++m) _Pragma("unroll") for (int k = 0; k < 2; ++k) dst[m][k] = *(const PG8_LAS bf16x8*)(lds + PG8_SA(b, h) + aoff + m * 2048 + k * 1024); } while (0)
#define PG8_LDB(dst, b, h) do { _Pragma("unroll") for (int n = 0; n < 2; ++n) _Pragma("unroll") for (int k = 0; k < 2; ++k) dst[n][k] = *(const PG8_LAS bf16x8*)(lds + PG8_SB(b, h) + boff + n * 2048 + k * 1024); } while (0)
#define PG8_MMA(ai, bj, At, Bt) do { __builtin_amdgcn_s_setprio(1); _Pragma("unroll") for (int m = 0; m < 4; ++m) _Pragma("unroll") for (int n = 0; n < 2; ++n) _Pragma("unroll") for (int k = 0; k < 2; ++k) \
        acc[ai][bj][m][n] = __builtin_amdgcn_mfma_f32_16x16x32_bf16(Bt[n][k], At[m][k], acc[ai][bj][m][n], 0, 0, 0); __builtin_amdgcn_s_setprio(0); } while (0)
#define PG8_WAIT_V(n) asm volatile("s_waitcnt vmcnt(" #n ")" ::: "memory")
#define PG8_WAIT_L(n) asm volatile("s_waitcnt lgkmcnt(" #n ")" ::: "memory")
#define PG8_BAR __builtin_amdgcn_s_barrier()
#define PG8_SCHED __builtin_amdgcn_sched_barrier(0)
    Unit cur, nxt; int ui = 0;
    if (!S.next(0, cur)) return;
    f32x4 acc[2][2][4][2];
#pragma unroll
    for (int a = 0; a < 2; ++a)
#pragma unroll
        for (int b = 0; b < 2; ++b)
#pragma unroll
            for (int m = 0; m < 4; ++m)
#pragma unroll
                for (int n = 0; n < 2; ++n) acc[a][b][m][n] = (f32x4){0.f, 0.f, 0.f, 0.f};
    bf16x8 At[4][2], B0[2][2], B1[2][2];
    const char* cA = cur.A; const char* cB = cur.B;
    unsigned vA[2][2], vN[2][2];
    PG8_SETVOFF(vA, cur);
    if constexpr (SP2) {
        PG8_STAGE(PG8_SB(0, 0), cB, voffB); PG8_STAGE(PG8_SB(0, 1), cB + hstep, voffB); PG8_STAGEA(PG8_SA(0, 0), cA, 0); PG8_STAGEA(PG8_SA(0, 1), cA, 1);
        if (wr == 1) PG8_BAR;
        PG8_WAIT_V(2); PG8_BAR;
        PG8_STAGE(PG8_SB(1, 0), cB + kstep, voffB); PG8_STAGEA(PG8_SA(1, 0), cA + kstep, 0); PG8_STAGE(PG8_SB(1, 1), cB + hstep + kstep, voffB);
        PG8_WAIT_V(6); PG8_BAR;
    }
    for (;;) {
        const bool has_next = S.next(ui + 1, nxt);
        const char* nA = has_next ? nxt.A : cA; const char* nB = has_next ? nxt.B : cB;
        for (int t = 0; t < nt; t += 2) {
            const bool last = (t == nt - 2);
            const char* a1 = cA + (size_t)(t + 1) * kstep;
            const char* a2 = last ? nA : cA + (size_t)(t + 2) * kstep; const char* b2 = last ? nB : cB + (size_t)(t + 2) * kstep;
            const char* a3 = a2 + kstep; const char* b3 = b2 + kstep;
            if (last) { if (has_next) { PG8_SETVOFF(vN, nxt); } else { _Pragma("unroll") for (int _h = 0; _h < 2; ++_h) _Pragma("unroll") for (int _i = 0; _i < 2; ++_i) vN[_h][_i] = vA[_h][_i]; } }
            if constexpr (SP2) {
            PG8_LDB(B0, 0, 0); PG8_LDB(B1, 0, 1); PG8_SCHED; PG8_LDA(At, 0, 0); PG8_STAGEA(PG8_SA(1, 1), a1, 1);
            if (last) { _Pragma("unroll") for (int _h = 0; _h < 2; ++_h) _Pragma("unroll") for (int _i = 0; _i < 2; ++_i) vA[_h][_i] = vN[_h][_i]; }
            PG8_WAIT_V(8); PG8_WAIT_L(0); PG8_BAR; PG8_MMA(0, 0, At, B0); PG8_MMA(0, 1, At, B1); PG8_BAR; PG8_SCHED;
            PG8_LDA(At, 0, 1); PG8_STAGE(PG8_SB(0, 0), b2, voffB); PG8_STAGE(PG8_SB(0, 1), b2 + hstep, voffB); PG8_STAGEA(PG8_SA(0, 0), a2, 0);
            PG8_WAIT_V(8); PG8_WAIT_L(0); PG8_BAR; PG8_MMA(1, 0, At, B0); PG8_MMA(1, 1, At, B1); PG8_BAR; PG8_SCHED;
            PG8_LDB(B0, 1, 0); PG8_LDB(B1, 1, 1); PG8_SCHED; PG8_LDA(At, 1, 0); PG8_STAGEA(PG8_SA(0, 1), a2, 1);
            PG8_WAIT_V(8); PG8_WAIT_L(0); PG8_BAR; PG8_MMA(0, 0, At, B0); PG8_MMA(0, 1, At, B1); PG8_BAR; PG8_SCHED;
            PG8_LDA(At, 1, 1); PG8_STAGE(PG8_SB(1, 0), b3, voffB); PG8_STAGE(PG8_SB(1, 1), b3 + hstep, voffB); PG8_STAGEA(PG8_SA(1, 0), a3, 0);
            PG8_WAIT_V(8); PG8_WAIT_L(0); PG8_BAR; PG8_MMA(1, 0, At, B0); PG8_MMA(1, 1, At, B1); PG8_BAR; PG8_SCHED;
            }
        }
        if constexpr (ALIGN_EPI) { if (wr == 0) PG8_BAR; }
        E(acc, cur, wr, wc, fr, fq);
        if (!has_next) break;
#pragma unroll
        for (int a = 0; a < 2; ++a)
#pragma unroll
            for (int b = 0; b < 2; ++b)
#pragma unroll
                for (int m = 0; m < 4; ++m)
#pragma unroll
                    for (int n = 0; n < 2; ++n) acc[a][b][m][n] = (f32x4){0.f, 0.f, 0.f, 0.f};
        cur = nxt; cA = nA; cB = nB; ++ui;
        if constexpr (ALIGN_EPI) { if (wr == 1) PG8_BAR; }
    }
    PG8_WAIT_V(0);
    if constexpr (!ALIGN_EPI) { if (wr == 0) PG8_BAR; }
    PG8_BAR;
#undef PG8_SA
#undef PG8_SB
#undef PG8_STAGE
#undef PG8_STAGEA
#undef PG8_SETVOFF
#undef PG8_LDA
#undef PG8_LDB
#undef PG8_MMA
#undef PG8_WAIT_V
#undef PG8_WAIT_L
#undef PG8_BAR
#undef PG8_SCHED
}
}
#include <hip/hip_bf16.h>
#include <cmath>
namespace attn_body {
using bf16=__hip_bfloat16;
using bf16x8=__attribute__((ext_vector_type(8)))short;
using s16x4=__attribute__((ext_vector_type(4)))short;
using f32x16=__attribute__((ext_vector_type(16)))float;
using u32x4=__attribute__((ext_vector_type(4)))unsigned;
constexpr int SEQ=2048,D=64,QKP=512,VP=512,OP=1024;
constexpr int NW=8,QBLK=32,QB=QBLK*NW,KVBLK=64,NQB=SEQ/QB;
constexpr int ATTN_UNIT_ROWS=QB;
__device__ __forceinline__ int crow(int r,int hi){return (r&3)+8*(r>>2)+4*hi;}
#define SBAR() __builtin_amdgcn_sched_barrier(0)
__device__ __forceinline__ void cmask(f32x16&p0,f32x16&p1,int jb,int qrel,int hi){
  const float NEG=-INFINITY; int kb=64*jb+4*hi;
  #pragma unroll
  for(int r=0;r<16;++r){int kv=kb+(r&3)+8*(r>>2); if(kv>qrel)p0[r]=NEG; if(kv+32>qrel)p1[r]=NEG;}
}

constexpr int NSLOT=3, SLOTB=8192;
constexpr int LDS_K=0, LDS_V=NSLOT*SLOTB, LDS_WS=2*NSLOT*SLOTB, LDS_OST=LDS_WS+NW*64*4, LDS_BYTES=LDS_OST+NW*4096;
constexpr float C2=0.125f*1.4426950408889634f;
__device__ __forceinline__ void glds16(const void*gsrc,unsigned lds_dst){unsigned keep;
  asm volatile("s_mov_b32 %0, m0\n\ts_mov_b32 m0, %2\n\ts_nop 0\n\tglobal_load_lds_dwordx4 %1, off\n\ts_mov_b32 m0, %0":"=&s"(keep):"v"(gsrc),"s"(lds_dst):"memory");}
__device__ __forceinline__ float max3f(float a,float b,float c){float r;asm("v_max3_f32 %0, %1, %2, %3":"=v"(r):"v"(a),"v"(b),"v"(c));return r;}
__device__ __forceinline__ float max2f(float a,float b){float r;asm("v_max_f32_e32 %0, %1, %2":"=v"(r):"v"(a),"v"(b));return r;}
__device__ __forceinline__ float fadd_s(float a,float b){float r;asm("v_add_f32_e32 %0, %1, %2":"=v"(r):"v"(a),"v"(b));return r;}
__device__ __forceinline__ float fsub_s(float a,float b){float r;asm("v_sub_f32_e32 %0, %1, %2":"=v"(r):"v"(a),"v"(b));return r;}
typedef float f32x2_t __attribute__((ext_vector_type(2))); typedef __bf16 bf16x2_t __attribute__((ext_vector_type(2)));
__device__ __forceinline__ unsigned cvtpk_s(float lo,float hi){f32x2_t v={lo,hi};bf16x2_t b=__builtin_convertvector(v,bf16x2_t);return __builtin_bit_cast(unsigned,b);}
#define WAIT_BAR(N) asm volatile("s_waitcnt vmcnt(" #N ") lgkmcnt(0)\n\ts_barrier":::"memory")

__device__ __forceinline__ void qkt(f32x16&p0,f32x16&p1,const char*Kslot,const bf16x8*qr,const f32x16&negm,int r32,int hi){
  const char*kb=Kslot+hi*1024+r32*16;
  #pragma unroll
  for(int d0=0;d0<4;++d0){
    const bf16x8 b0=*reinterpret_cast<const bf16x8*>(kb+d0*2048);
    const bf16x8 b1=*reinterpret_cast<const bf16x8*>(kb+d0*2048+512);
    if(d0==0){p0=__builtin_amdgcn_mfma_f32_32x32x16_bf16(b0,qr[0],negm,0,0,0);p1=__builtin_amdgcn_mfma_f32_32x32x16_bf16(b1,qr[0],negm,0,0,0);}
    else{p0=__builtin_amdgcn_mfma_f32_32x32x16_bf16(b0,qr[d0],p0,0,0,0);p1=__builtin_amdgcn_mfma_f32_32x32x16_bf16(b1,qr[d0],p1,0,0,0);}}
}
typedef __attribute__((address_space(3))) const char* lds_cptr;
typedef short v4i16_t __attribute__((ext_vector_type(4)));
__device__ __forceinline__ void kload8(bf16x8*kf,lds_cptr kp){
  kf[0]=*(const __attribute__((address_space(3))) bf16x8*)(kp);      kf[1]=*(const __attribute__((address_space(3))) bf16x8*)(kp+512);
  kf[2]=*(const __attribute__((address_space(3))) bf16x8*)(kp+2048); kf[3]=*(const __attribute__((address_space(3))) bf16x8*)(kp+2560);
  kf[4]=*(const __attribute__((address_space(3))) bf16x8*)(kp+4096); kf[5]=*(const __attribute__((address_space(3))) bf16x8*)(kp+4608);
  kf[6]=*(const __attribute__((address_space(3))) bf16x8*)(kp+6144); kf[7]=*(const __attribute__((address_space(3))) bf16x8*)(kp+6656);
}
__device__ __forceinline__ void kload2(bf16x8*kf,lds_cptr kp,int j){ kf[2*j]=*(const __attribute__((address_space(3))) bf16x8*)(kp+j*2048); kf[2*j+1]=*(const __attribute__((address_space(3))) bf16x8*)(kp+j*2048+512); }
__device__ __forceinline__ s16x4 vtr(lds_cptr p){ return __builtin_bit_cast(s16x4,__builtin_amdgcn_ds_read_tr16_b64_v4i16((__attribute__((address_space(3))) v4i16_t*)p)); }
__device__ __forceinline__ float rowmax(const f32x16&p0,const f32x16&p1){
  float a=max3f(p0[0],p0[1],p1[0]),b=max3f(p0[2],p0[3],p1[1]);a=max3f(a,p1[2],p1[3]);
  #pragma unroll
  for(int r=4;r<16;r+=4){a=max3f(a,p0[r],p0[r+1]);b=max3f(b,p0[r+2],p0[r+3]);a=max3f(a,p1[r],p1[r+1]);b=max3f(b,p1[r+2],p1[r+3]);}
  const float m=max2f(a,b);
  auto rr=__builtin_amdgcn_permlane32_swap(__float_as_uint(m),__float_as_uint(m),false,false);
  return max2f(__uint_as_float(rr[0]),__uint_as_float(rr[1]));
}
__device__ __forceinline__ void pv(f32x16*o,int vb,bf16x8 pa0,bf16x8 pa1,bf16x8 pa2,bf16x8 pa3){
  #pragma unroll
  for(int d0=0;d0<2;++d0){s16x4 lo[4],hi[4];
    #pragma unroll
    for(int ks=0;ks<4;++ks){
      asm volatile("ds_read_b64_tr_b16 %0,%1 offset:%c2":"=&v"(lo[ks]):"v"(vb),"i"(d0*4096+ks*1024):"memory");
      asm volatile("ds_read_b64_tr_b16 %0,%1 offset:%c2":"=&v"(hi[ks]):"v"(vb),"i"(d0*4096+ks*1024+512):"memory");}
    asm volatile("s_waitcnt lgkmcnt(0)":::"memory");SBAR();
    #define PK(k) (bf16x8){lo[k][0],lo[k][1],lo[k][2],lo[k][3],hi[k][0],hi[k][1],hi[k][2],hi[k][3]}
    o[d0]=__builtin_amdgcn_mfma_f32_32x32x16_bf16(pa0,PK(0),o[d0],0,0,0);
    o[d0]=__builtin_amdgcn_mfma_f32_32x32x16_bf16(pa1,PK(1),o[d0],0,0,0);
    o[d0]=__builtin_amdgcn_mfma_f32_32x32x16_bf16(pa2,PK(2),o[d0],0,0,0);
    o[d0]=__builtin_amdgcn_mfma_f32_32x32x16_bf16(pa3,PK(3),o[d0],0,0,0);
    #undef PK
  }
}

#ifndef ATTN_STORE16
#define ATTN_STORE16(p,v) (*(u32x4*)(p)=(v))
#endif
template<int THRL> __device__ __forceinline__ void attn_unit(int b,int qcol,int vcol,int ocol,int qb,const bf16*Q,const bf16*__restrict__ K,const bf16*__restrict__ V,bf16*O,char*shm){
  const int tid=threadIdx.x,lane=tid&63,r32=lane&31,hi=lane>>5; const int wid=__builtin_amdgcn_readfirstlane(tid>>6);
  const long rowbase=(long)b*SEQ; const int q0=qb*QB;
  const bf16*Qw=Q+(rowbase+q0+wid*QBLK)*QKP+qcol;
  const bf16*Kh=K+rowbase*QKP+qcol,*Vh=V+rowbase*VP+vcol;
  const unsigned lds0=(unsigned)(uintptr_t)shm;
  float*wsf=(float*)(shm+LDS_WS)+wid*64;
  const bf16*ksrc=Kh+(long)lane*QKP+wid*8;
  const bf16*vsrc=Vh+(long)(16*(wid&3)+(lane>>2))*VP+(wid>>2)*32+(lane&3)*8;
  const unsigned kdst=lds0+LDS_K+wid*1024, vdst=lds0+LDS_V+wid*1024;
  #define DMA_K(t,slot) glds16(ksrc+(long)(t)*KVBLK*QKP,(unsigned)__builtin_amdgcn_readfirstlane(kdst+(slot)))
  #define DMA_V(t,slot) glds16(vsrc+(long)(t)*KVBLK*VP,(unsigned)__builtin_amdgcn_readfirstlane(vdst+(slot)))
  const int vb0=(int)(lds0+LDS_V)+((lane>>4)&1)*32+(lane&3)*8+(4*hi+((lane&15)>>2))*64;
  const char*Kbase=shm+LDS_K; bf16x8 kf[8];
  const lds_cptr shm3=(lds_cptr)shm; const lds_cptr kp0=shm3+LDS_K+hi*1024+r32*16; const lds_cptr vp0=shm3+LDS_V+((lane>>4)&1)*32+(lane&3)*8+(4*hi+((lane&15)>>2))*64;
  const int NT=(q0+QB)/KVBLK;
  DMA_K(0,0);DMA_V(0,0);DMA_K(1,SLOTB);
  bf16x8 qr[4];
  #pragma unroll
  for(int d0=0;d0<4;++d0)qr[d0]=*reinterpret_cast<const bf16x8*>(&Qw[(long)r32*QKP+d0*16+hi*8]);
  float mhat=0.f,l_reg=0.f;f32x16 o[2];o[0]=f32x16{};o[1]=f32x16{};f32x16 negm=f32x16{};asm volatile("":"+v"(negm));
  const int qrel=wid*QBLK+r32;
  #define CMASK(P0,P1,t) do{int jb_=(t)-(NT-4); if(jb_>=0)cmask(P0,P1,jb_,qrel,hi);}while(0)
  bool resc=false;
  #define START(P0,P1) do{ const float rm=rowmax(P0,P1); resc=false; \
    { const float dl=rm; mhat=fadd_s(mhat,dl); \
      _Pragma("unroll") for(int r=0;r<16;++r){P0[r]=fsub_s(P0[r],dl);P1[r]=fsub_s(P1[r],dl);} \
      _Pragma("unroll") for(int r=0;r<16;++r)negm[r]=-mhat; asm volatile("":"+v"(negm)); } \
    _Pragma("unroll") for(int r=0;r<16;++r)P0[r]=__builtin_amdgcn_exp2f(P0[r]); }while(0)
  #define RESC() do{ if(resc){ asm volatile("s_waitcnt lgkmcnt(0)":::"memory"); \
      _Pragma("unroll") for(int d_=0;d_<2;++d_) _Pragma("unroll") for(int r=0;r<16;++r)o[d_][r]*=wsf[crow(r,hi)]; } }while(0)
  f32x16 pA0,pA1,pB0,pB1;
  int sl_prev=0,sl_cur=0,sl_next=SLOTB;
  #define ROT() do{sl_prev=sl_cur;sl_cur=sl_next;sl_next=(sl_next==(NSLOT-1)*SLOTB)?0:sl_next+SLOTB;}while(0)
  DMA_K(2,2*SLOTB);
  WAIT_BAR(3);
  qkt(pA0,pA1,Kbase,qr,negm,r32,hi);asm volatile("s_nop 15\n\ts_nop 7":"+v"(pA0),"+v"(pA1));CMASK(pA0,pA1,0);
  START(pA0,pA1);
  _Pragma("unroll") for(int r=0;r<16;++r)pA1[r]=__builtin_amdgcn_exp2f(pA1[r]);
  WAIT_BAR(0);
  DMA_K(3,0);DMA_V(1,SLOTB);
  ROT();
  kload8(kf,kp0+sl_cur);
  WAIT_BAR(2);
  s16x4 vlo[8],vhi[8]; u32x4 pw0,pw1,pw2,pw3;
  #define PKW(P,B) cvtpk_s(P[B],P[B+1])
  #define PAF(k) __builtin_bit_cast(bf16x8,pw##k)
  #define VFR(i) (bf16x8){vlo[i][0],vlo[i][1],vlo[i][2],vlo[i][3],vhi[i][0],vhi[i][1],vhi[i][2],vhi[i][3]}
  #define PIN(x) asm volatile("":"+v"(x))
  #define MX3(a,b,c) __builtin_fmaxf(__builtin_fmaxf((a),(b)),(c))
  #define GAPA(MF,A0,A1,A2,A3,W0,W1,PW) do{ MF; sacc+=A0; sacc+=A1; sacc+=A2; sacc+=A3; PIN(sacc); W0; W1; PIN(PW); SBAR(); }while(0)
  #define EX(v) __builtin_amdgcn_exp2f(v)
  #define GAPB(MF,X,B) do{ MF; X[B]=EX(X[B]); X[B+1]=EX(X[B+1]); X[B+2]=EX(X[B+2]); X[B+3]=EX(X[B+3]); PIN(X); SBAR(); }while(0)
  #define VRD(i) do{ vlo[i]=vtr(vp_+(((i)>>2)*4096+((i)&3)*1024)); vhi[i]=vtr(vp_+(((i)>>2)*4096+((i)&3)*1024+512)); }while(0)
  #define KRD(G,j) do{ if(G){ kload2(kf,kp0+sl_next,j); SBAR(); } }while(0)
  #define STEP(C0,C1,P0,P1,t,GK,GV,GL) do{ SBAR(); \
    const lds_cptr vp_=vp0+sl_prev; \
    VRD(0); SBAR(); float sacc=(P0[0]+P0[1]); \
    GAPA(C0=__builtin_amdgcn_mfma_f32_32x32x16_bf16(kf[0],qr[0],negm,0,0,0), P0[2],P0[3],P0[4],P0[5],     pw0[0]=PKW(P0,0), pw0[1]=PKW(P0,2), pw0); \
    VRD(4); SBAR(); GAPA(C1=__builtin_amdgcn_mfma_f32_32x32x16_bf16(kf[1],qr[0],negm,0,0,0), P0[6],P0[7],P0[8],P0[9],     pw0[2]=PKW(P0,4), pw0[3]=PKW(P0,6), pw0); \
    VRD(1); SBAR(); GAPA(C0=__builtin_amdgcn_mfma_f32_32x32x16_bf16(kf[2],qr[1],C0,0,0,0),   P0[10],P0[11],P0[12],P0[13], pw1[0]=PKW(P0,8), pw1[1]=PKW(P0,10), pw1); \
    VRD(5); SBAR(); GAPA(C1=__builtin_amdgcn_mfma_f32_32x32x16_bf16(kf[3],qr[1],C1,0,0,0),   P0[14],P0[15],P1[0],P1[1],   pw1[2]=PKW(P0,12),pw1[3]=PKW(P0,14), pw1); \
    VRD(2); SBAR(); GAPA(C0=__builtin_amdgcn_mfma_f32_32x32x16_bf16(kf[4],qr[2],C0,0,0,0),   P1[2],P1[3],P1[4],P1[5],     pw2[0]=PKW(P1,0), pw2[1]=PKW(P1,2), pw2); \
    VRD(6); SBAR(); GAPA(C1=__builtin_amdgcn_mfma_f32_32x32x16_bf16(kf[5],qr[2],C1,0,0,0),   P1[6],P1[7],P1[8],P1[9],     pw2[2]=PKW(P1,4), pw2[3]=PKW(P1,6), pw2); \
    VRD(3); SBAR(); GAPA(C0=__builtin_amdgcn_mfma_f32_32x32x16_bf16(kf[6],qr[3],C0,0,0,0),   P1[10],P1[11],P1[12],P1[13], pw3[0]=PKW(P1,8), pw3[1]=PKW(P1,10), pw3); \
    VRD(7); SBAR(); GAPA(C1=__builtin_amdgcn_mfma_f32_32x32x16_bf16(kf[7],qr[3],C1,0,0,0),   P1[14],P1[15],0.f,0.f,       pw3[2]=PKW(P1,12),pw3[3]=PKW(P1,14), pw3); \
    l_reg+=sacc; \
    if(GK){DMA_K((t)+3,sl_cur);} if(GV){DMA_V((t)+1,sl_next);} \
    CMASK(C0,C1,t); \
    { float a=MX3(C0[0],C0[1],C1[0]),b=MX3(C0[2],C0[3],C1[1]); a=MX3(a,C1[2],C1[3]); \
      _Pragma("unroll") for(int r=4;r<16;r+=4){a=MX3(a,C0[r],C0[r+1]);b=MX3(b,C0[r+2],C0[r+3]);a=MX3(a,C1[r],C1[r+1]);b=MX3(b,C1[r+2],C1[r+3]);} \
      float rm=__builtin_fmaxf(a,b); { auto rr=__builtin_amdgcn_permlane32_swap(__float_as_uint(rm),__float_as_uint(rm),false,false); rm=__builtin_fmaxf(__uint_as_float(rr[0]),__uint_as_float(rr[1])); } \
      resc=false; \
      if(__builtin_expect(__any(rm>(float)THRL),0)){ const float dl=__builtin_fmaxf(rm,0.f); mhat+=dl; \
        _Pragma("unroll") for(int r=0;r<16;++r){C0[r]-=dl;C1[r]-=dl;} \
        _Pragma("unroll") for(int r=0;r<16;++r)negm[r]=-mhat; asm volatile("":"+v"(negm)); \
        const float f=__builtin_amdgcn_exp2f(-dl); l_reg*=f; if(hi==0)wsf[r32]=f; resc=true; } } \
    SBAR(); \
    GAPB(o[0]=__builtin_amdgcn_mfma_f32_32x32x16_bf16(PAF(0),VFR(0),o[0],0,0,0), C0,0); \
    GAPB(o[1]=__builtin_amdgcn_mfma_f32_32x32x16_bf16(PAF(0),VFR(4),o[1],0,0,0), C0,4); \
    KRD(GL,0); GAPB(o[0]=__builtin_amdgcn_mfma_f32_32x32x16_bf16(PAF(1),VFR(1),o[0],0,0,0), C0,8); \
    KRD(GL,1); GAPB(o[1]=__builtin_amdgcn_mfma_f32_32x32x16_bf16(PAF(1),VFR(5),o[1],0,0,0), C0,12); \
    KRD(GL,2); GAPB(o[0]=__builtin_amdgcn_mfma_f32_32x32x16_bf16(PAF(2),VFR(2),o[0],0,0,0), C1,0); \
    KRD(GL,3); GAPB(o[1]=__builtin_amdgcn_mfma_f32_32x32x16_bf16(PAF(2),VFR(6),o[1],0,0,0), C1,4); \
    GAPB(o[0]=__builtin_amdgcn_mfma_f32_32x32x16_bf16(PAF(3),VFR(3),o[0],0,0,0), C1,8); \
    GAPB(o[1]=__builtin_amdgcn_mfma_f32_32x32x16_bf16(PAF(3),VFR(7),o[1],0,0,0), C1,12); \
    }while(0)
  int t=1;
  #undef CMASK
  #define CMASK(P0,P1,t) do{}while(0)
  for(;t+5<NT;t+=2){
    STEP(pB0,pB1,pA0,pA1,t,true,true,true);     WAIT_BAR(2); RESC(); ROT();
    STEP(pA0,pA1,pB0,pB1,t+1,true,true,true);   WAIT_BAR(2); RESC(); ROT();
  }
  #undef CMASK
  #define CMASK(P0,P1,t) do{int jb_=(t)-(NT-4); if(jb_>=0)cmask(P0,P1,jb_,qrel,hi);}while(0)
  #define ENDW(tt) do{ if((tt)+3<NT){WAIT_BAR(2);} else if((tt)+2<NT){WAIT_BAR(1);} else {WAIT_BAR(0);} }while(0)
  for(;t+1<NT;t+=2){
    STEP(pB0,pB1,pA0,pA1,t,(t+3<NT),(t+1<NT),(t+1<NT));       ENDW(t);   RESC(); ROT();
    STEP(pA0,pA1,pB0,pB1,t+1,(t+4<NT),(t+2<NT),(t+2<NT));     ENDW(t+1); RESC(); ROT();
  }
  STEP(pB0,pB1,pA0,pA1,NT-1,false,false,false); RESC();
  { float sacc=pB0[0]+pB0[1]; _Pragma("unroll") for(int r=2;r<16;++r)sacc+=pB0[r]; _Pragma("unroll") for(int r=0;r<16;++r)sacc+=pB1[r]; l_reg+=sacc;
    pw0=(u32x4){PKW(pB0,0),PKW(pB0,2),PKW(pB0,4),PKW(pB0,6)};pw1=(u32x4){PKW(pB0,8),PKW(pB0,10),PKW(pB0,12),PKW(pB0,14)};pw2=(u32x4){PKW(pB1,0),PKW(pB1,2),PKW(pB1,4),PKW(pB1,6)};pw3=(u32x4){PKW(pB1,8),PKW(pB1,10),PKW(pB1,12),PKW(pB1,14)};
    SBAR(); pv(o,vb0+sl_cur,PAF(0),PAF(1),PAF(2),PAF(3)); }
  #undef PKW
  #undef PAF
  #undef VFR
  #undef PIN
  #undef MX3
  #undef GAPA
  #undef GAPB
  #undef EX
  #undef VRD
  #undef KRD
  #undef STEP
  #undef ENDW
  {auto rr=__builtin_amdgcn_permlane32_swap(__float_as_uint(l_reg),__float_as_uint(l_reg),false,false);l_reg=__uint_as_float(rr[0])+__uint_as_float(rr[1]);}
  if(hi==0)wsf[32+r32]=l_reg;asm volatile("s_waitcnt lgkmcnt(0)":::"memory");
  float rli[16];
  #pragma unroll
  for(int r=0;r<16;++r)rli[r]=__builtin_amdgcn_rcpf(wsf[32+crow(r,hi)]);
  bf16*Ow=O+(rowbase+q0+wid*QBLK)*OP+ocol;
  { bf16*stg=(bf16*)(shm+LDS_OST)+wid*2048;
    #pragma unroll
    for(int r=0;r<16;++r){const int orow=crow(r,hi);
      #pragma unroll
      for(int d0=0;d0<2;++d0)stg[orow*64+d0*32+r32]=__float2bfloat16(o[d0][r]*rli[r]);}
    asm volatile("s_waitcnt lgkmcnt(0)":::"memory");
    #pragma unroll
    for(int i=0;i<4;++i){const int row=i*8+(lane>>3),ch=lane&7; const u32x4 v=*(const u32x4*)(stg+row*64+ch*8); ATTN_STORE16(Ow+(long)row*OP+ch*8,v);} }
  asm volatile("s_waitcnt lgkmcnt(0)\n\ts_barrier":::"memory");
  #undef DMA_K
  #undef DMA_V
  #undef CMASK
  #undef START
  #undef RESC
  #undef ROT
}
constexpr int ATTN_LDS_BYTES=LDS_BYTES;
#undef SBAR
#undef WAIT_BAR
}

#define GAS __attribute__((address_space(1)))
#define LAS __attribute__((address_space(3)))
typedef unsigned short bf16;
typedef unsigned v4u __attribute__((ext_vector_type(4)));
typedef float f32x4 __attribute__((ext_vector_type(4)));
typedef short bf16x8 __attribute__((ext_vector_type(8)));
typedef GAS unsigned gu32;
typedef GAS unsigned long long gu64;
#define RLX_AGENT __ATOMIC_RELAXED, __HIP_MEMORY_SCOPE_AGENT
#define LDS_WAIT() asm volatile("s_waitcnt lgkmcnt(0)" ::: "memory")
#define VM_WAIT() asm volatile("s_waitcnt vmcnt(0)" ::: "memory")
__device__ __forceinline__ unsigned long long rt() { return __builtin_amdgcn_s_memrealtime(); }
__device__ __forceinline__ unsigned f2bf(float f) { unsigned u = __builtin_bit_cast(unsigned, f); return (u + 0x7fffu + ((u >> 16) & 1u)) >> 16; }
__device__ __forceinline__ unsigned pk2(float lo, float hi) { return f2bf(lo) | (f2bf(hi) << 16); }

#define XB_TMO      128
#define XB_XCNT(j)  (256  + 64 * (j))
#define XB_XSUB(j)  (1280 + 64 * (j))
#define XB_XGEN(j)  (2304 + 64 * (j))
#define XB_TOP      3328
#define XB_TOPGEN   3392
#define XCD_BAR_WORDS 3456
#define XB_SPIN_CAP (1u << 18)

__device__ __forceinline__ unsigned xb_ld(unsigned* p)              { return __hip_atomic_load(p, __ATOMIC_RELAXED, __HIP_MEMORY_SCOPE_AGENT); }
__device__ __forceinline__ unsigned xb_add(unsigned* p, unsigned v) { return __hip_atomic_fetch_add(p, v, __ATOMIC_RELAXED, __HIP_MEMORY_SCOPE_AGENT); }
__device__ __forceinline__ unsigned xb_xcc_id() { return (unsigned)__builtin_amdgcn_s_getreg((3 << 11) | 20) & 0xFu; }
#define XB_SPIN(cond, bar) do { unsigned _sp = 0; while (cond) { __builtin_amdgcn_s_sleep(1); \
    if ((++_sp & 255u) == 0u) { if (xb_ld(&(bar)[XB_TMO])) break; if (_sp > XB_SPIN_CAP) { atomicAdd(&(bar)[XB_TMO], 1u); break; } } } } while (0)

struct XcdBarrier {
    unsigned* bar; unsigned x;
    volatile LAS unsigned* st;
};

__device__ __forceinline__ XcdBarrier xcd_barrier_post(unsigned* bar, volatile LAS unsigned* st) {
    XcdBarrier b; b.bar = bar; b.x = xb_xcc_id(); b.st = st;
    if (threadIdx.x == 0) (void)xb_add(&bar[XB_XCNT(b.x)], 1u);
    return b;
}
__device__ __forceinline__ void xcd_barrier_complete(unsigned* bar, unsigned x, unsigned& nloc, unsigned& nx) {
    const unsigned G = gridDim.x * gridDim.y * gridDim.z;
    unsigned sum, cnt, mine, sp = 0u;
    for (;;) {
        sum = 0u; cnt = 0u; mine = 0u;
#pragma unroll
        for (unsigned j = 0; j < 16; ++j) { const unsigned c = xb_ld(&bar[XB_XCNT(j)]); sum += c; cnt += (c > 0u) ? 1u : 0u; mine = (j == x) ? c : mine; }
        if (sum == G) break;
        __builtin_amdgcn_s_sleep(1);
        if ((++sp & 255u) == 0u) { if (xb_ld(&bar[XB_TMO])) break; if (sp > XB_SPIN_CAP) { atomicAdd(&bar[XB_TMO], 1u); break; } }
    }
    nloc = mine > 0u ? mine : 1u; nx = cnt > 0u ? cnt : 1u;
}

__device__ __forceinline__ void xcd_barrier(const XcdBarrier& b) {
    asm volatile("s_waitcnt vmcnt(0)" ::: "memory");
    __syncthreads();
    if (threadIdx.x == 0) {
        unsigned* bar = b.bar;
        __builtin_amdgcn_s_waitcnt(0);
        unsigned nloc = b.st[0], nx = b.st[1];
        if (nloc == 0u) { xcd_barrier_complete(bar, b.x, nloc, nx); b.st[0] = nloc; b.st[1] = nx; }
        const unsigned old = xb_add(&bar[XB_XSUB(b.x)], 1u);
        const unsigned gen = old / nloc;
        if (old + 1u == (gen + 1u) * nloc) {
            __builtin_amdgcn_fence(__ATOMIC_RELEASE, "agent");
            asm volatile("s_waitcnt vmcnt(0)" ::: "memory");
            const unsigned og = xb_add(&bar[XB_TOP], 1u);
            const unsigned tg = og / nx;
            if (og + 1u == (tg + 1u) * nx) xb_add(&bar[XB_TOPGEN], 1u);
            else XB_SPIN(xb_ld(&bar[XB_TOPGEN]) == tg, bar);
            __builtin_amdgcn_fence(__ATOMIC_ACQUIRE, "agent");
            xb_add(&bar[XB_XGEN(b.x)], 1u);
            asm volatile("s_waitcnt vmcnt(0)" ::: "memory");
        } else {
            XB_SPIN(xb_ld(&bar[XB_XGEN(b.x)]) == gen, bar);
            __builtin_amdgcn_fence(__ATOMIC_ACQUIRE, "agent");
            asm volatile("s_waitcnt vmcnt(0)" ::: "memory");
        }
    }
    __syncthreads();
}

constexpr int NWAVES = 8;
constexpr int D = 1024, NB = 8, SEQ = 2048, M = NB * SEQ, NPROJ = 3584, NE = 32, FF = 512, NCH = SEQ / 64, NMOD = 6 * D;
constexpr int LCAP = 16384;
constexpr float RMS_EPS = 1e-6f, SUBLN_EPS = 1e-5f, LAMBDA_INIT = 0.2f;
#ifndef MK_N_LAUNCHES
#define MK_N_LAUNCHES 1
#endif
constexpr int NPH = 11;
constexpr size_t MiB = 1u << 20;
constexpr size_t WS_CTL = 0, CTL_ZERO_BYTES = 1 * MiB;
constexpr size_t WS_MOD = 1 * MiB;
constexpr size_t WS_RT = 1 * MiB + 256 * 1024;
constexpr size_t WS_EL = 1 * MiB + 512 * 1024;
constexpr size_t WS_ELIST = 2 * MiB, WS_WLIST = 4 * MiB;
constexpr size_t WS_WIN = 6 * MiB;
constexpr size_t WS_WOUT = 13 * MiB;
constexpr size_t WS_WGU = 16 * MiB;
constexpr size_t WS_UST = 16 * MiB;
constexpr size_t WS_WD = 80 * MiB;
constexpr size_t WS_MIXED = 80 * MiB;
constexpr size_t WS_RA = 112 * MiB;
constexpr size_t WS_Q = 144 * MiB, WS_K = 160 * MiB, WS_V = 176 * MiB, WS_QP = 192 * MiB, WS_KP = 208 * MiB, WS_VI = 224 * MiB, WS_SG = 240 * MiB;
constexpr size_t WS_PART = 144 * MiB;
constexpr size_t WS_HID = 208 * MiB;
constexpr size_t WS_END = 256 * MiB;
constexpr int CW_BAR = 4096;
constexpr int CW_CNT = 8192;
constexpr int RING_BYTES = 131072;
constexpr int LDSCTL_OFF = 147456;
constexpr int MISC_OFF = LDSCTL_OFF + 320;
constexpr int SCHED_OFF = LDSCTL_OFF + 1024;
constexpr int LDS_BYTES = 163840;

typedef unsigned u32x2v __attribute__((ext_vector_type(2)));
__device__ __forceinline__ float dpp_row_shr(float v, int n) {
    const int iv = __builtin_bit_cast(int, v); int r;
    switch (n) { case 1: r = __builtin_amdgcn_update_dpp(0, iv, 0x111, 0xf, 0xf, true); break; case 2: r = __builtin_amdgcn_update_dpp(0, iv, 0x112, 0xf, 0xf, true); break;
                 case 4: r = __builtin_amdgcn_update_dpp(0, iv, 0x114, 0xf, 0xf, true); break; default: r = __builtin_amdgcn_update_dpp(0, iv, 0x118, 0xf, 0xf, true); break; }
    return __builtin_bit_cast(float, r);
}
__device__ __forceinline__ float wave_sum(float v) {
    v += dpp_row_shr(v, 1); v += dpp_row_shr(v, 2); v += dpp_row_shr(v, 4); v += dpp_row_shr(v, 8);
    v += __builtin_bit_cast(float, __builtin_amdgcn_update_dpp(0, __builtin_bit_cast(int, v), 0x142, 0xa, 0xf, false));
    v += __builtin_bit_cast(float, __builtin_amdgcn_update_dpp(0, __builtin_bit_cast(int, v), 0x143, 0xc, 0xf, false));
    return __builtin_bit_cast(float, __builtin_amdgcn_readlane(__builtin_bit_cast(int, v), 63));
}
__device__ __forceinline__ float bf_lo(unsigned w) { return __uint_as_float(w << 16); }
__device__ __forceinline__ float bf_hi(unsigned w) { return __uint_as_float(w & 0xffff0000u); }
__device__ __forceinline__ float sigmoidf_(float x) { return 1.f / (1.f + __expf(-x)); }

struct Args { const float* in[24]; float* out; unsigned char* ws; int ph_lo, ph_hi; };

struct DenseOrder {
    int nM, nN, nwg, G, c; const char* Abase; const char* Bbase; size_t tstep; int pn_off, pn_cut, pn_shift;
    __device__ __forceinline__ void init(int M_, int N_, int K_, int G_, int c_, const void* A_, const void* B_, int off_ = 0, int cut_ = 1 << 30, int shift_ = 0) { nM = M_ / 256; nN = N_ / 256; nwg = nM * nN; G = G_; c = c_; Abase = (const char*)A_; Bbase = (const char*)B_; tstep = (size_t)256 * K_ * 2; pn_off = off_; pn_cut = cut_; pn_shift = shift_; }
    __device__ __forceinline__ bool next(int i, pg8::Unit& u) const {
        const long L = (long)i * G + c; if (L >= nwg) return false;
        int wgid = (int)L; { const int q = nwg / 8, r = nwg % 8, xcd = wgid % 8, off = wgid / 8; wgid = (xcd < r ? xcd * (q + 1) : r * (q + 1) + (xcd - r) * q) + off; }
        const int nig = 8 * nN, gid = wgid / nig, fm = gid * 8, gsz = (nM - fm) < 8 ? (nM - fm) : 8;
        u.pm = fm + ((wgid % nig) % gsz); { const int idx = (wgid % nig) / gsz; u.pn = idx + pn_off + (idx >= pn_cut ? pn_shift : 0); }
        u.A = Abase + (size_t)u.pm * tstep; u.B = Bbase + (size_t)u.pn * tstep; u.gidx = nullptr; u.rows = 256; u.e = 0; u.base = 0; return true;
    }
};
struct MoeOrder {
    const LAS int* tab; int G, c; int down; const char* Abase; const char* Bbase; const int* elist;
    __device__ __forceinline__ bool next(int i, pg8::Unit& u) const {
#ifndef MOE_REP
#define MOE_REP 1
#endif
        int L = i * G + c; const int T = tab[32];
        if (L >= T * 4 * MOE_REP) return false;
        if (MOE_REP > 1 && L >= T * 4) L -= T * 4;
        const int tile = L >> 2, sub = L & 3; int e = 0;
#pragma unroll 1
        for (int j = 1; j < 32; ++j) e = (tab[j] <= tile) ? j : e;
        const int rt = tile - tab[e], cnt = tab[66 + e], rb = tab[33 + e] + 256 * rt;
        u.pm = rt; u.pn = sub; u.e = e; u.base = rb; u.rows = (cnt - 256 * rt) < 256 ? (cnt - 256 * rt) : 256; u.gidx = elist + e * LCAP + 256 * rt;
        if (down) { u.A = Abase + (size_t)rb * (FF * 2); u.B = Bbase + ((size_t)e * 1024 + 256 * sub) * (FF * 2); }
        else      { u.A = Abase;                          u.B = Bbase + ((size_t)(e * 4 + sub) * 256) * (D * 2); }
        return true;
    }
};
__device__ __forceinline__ void sched_tables(LAS int* tab, gu32* cntw, int tid) {
    if (tid == 0) { int ts = 0, rb = 0;
        for (int e = 0; e < 32; ++e) { int cn = (int)__hip_atomic_load(cntw + 64 * e, RLX_AGENT); cn = cn > LCAP ? LCAP : cn; tab[e] = ts; tab[33 + e] = rb; tab[66 + e] = cn; ts += (cn + 255) >> 8; rb += cn; }
        tab[32] = ts; tab[65] = rb; }
    __syncthreads();
}

using pg8::u32x4; using pg8::cvt_pk_bf16;
__device__ __forceinline__ float silu_(float v) { return v / (1.f + __expf(-v)); }
constexpr float QSCALE = 0.125f * 1.4426950408889634f;
template <int EMASK> struct EpiInProj {
    bf16* R1; float* EL; const int* pos; const float* lbl;
    static constexpr size_t RSTR = (size_t)M * 512;
    __device__ __forceinline__ void operator()(f32x4 (&acc)[2][2][4][2], const pg8::Unit& u, int wr, int wc, int fr, int fq) const {
        asm volatile("" : "+v"(fr), "+v"(fq));
        const int pn = u.pn, rowb = u.pm * 256 + wr * 64 + fr;
        if ((EMASK & 1) && pn < 4) {
            const int part = pn >> 1, th = pn & 1; bf16* dst = R1 + (size_t)part * RSTR; const float qs = part ? 1.f : QSCALE;
            const int i0 = 16 * (wc & 1) + 4 * fq, dm0 = 32 * (wc & 1) + 8 * fq;
            float invf[4];
#pragma unroll
            for (int j = 0; j < 4; ++j) invf[j] = exp2f(-(float)(i0 + j) * 0.41524101186092029f);
#pragma unroll
            for (int ai = 0; ai < 2; ++ai)
#pragma unroll
                for (int m = 0; m < 4; ++m) { const int row = rowb + ai * 128 + m * 16; const float p = (float)pos[row]; float cs[4], sn[4];
#pragma unroll
                    for (int j = 0; j < 4; ++j) { float rev = p * invf[j] * 0.15915494309189535f; rev -= floorf(rev); sn[j] = __builtin_amdgcn_sinf(rev); cs[j] = __builtin_amdgcn_cosf(rev); }
#pragma unroll
                    for (int bj = 0; bj < 2; ++bj) { const int head = 4 * th + 2 * bj + (wc >> 1); const f32x4 x1 = acc[ai][bj][m][0], x2 = acc[ai][bj][m][1]; float o1[4], o2[4];
#pragma unroll
                        for (int j = 0; j < 4; ++j) { o1[j] = (x1[j] * cs[j] - x2[j] * sn[j]) * qs; o2[j] = (x2[j] * cs[j] + x1[j] * sn[j]) * qs; }
                        u32x4 w; w.x = cvt_pk_bf16(o1[0], o1[1]); w.y = cvt_pk_bf16(o1[2], o1[3]); w.z = cvt_pk_bf16(o2[0], o2[1]); w.w = cvt_pk_bf16(o2[2], o2[3]);
                        *(u32x4*)(dst + (size_t)row * 512 + head * 64 + dm0) = w; } }
        } else if ((EMASK & 2) && (pn < 6 || pn >= 10)) {
            bf16* dst = R1 + (size_t)(pn < 6 ? 2 : (pn < 12 ? 5 : 6)) * RSTR; const int cb = ((pn < 6 ? pn - 4 : (pn < 12 ? pn - 10 : pn - 12)) * 256) + wc * 32 + 8 * fq; const bool act = pn >= 12;
#pragma unroll
            for (int ai = 0; ai < 2; ++ai)
#pragma unroll
                for (int m = 0; m < 4; ++m) { const int row = rowb + ai * 128 + m * 16;
#pragma unroll
                    for (int bj = 0; bj < 2; ++bj) { f32x4 v0 = acc[ai][bj][m][0], v1 = acc[ai][bj][m][1];
                        if (act) {
#pragma unroll
                            for (int j = 0; j < 4; ++j) { v0[j] = silu_(v0[j]); v1[j] = silu_(v1[j]); } }
                        u32x4 w; w.x = cvt_pk_bf16(v0[0], v0[1]); w.y = cvt_pk_bf16(v0[2], v0[3]); w.z = cvt_pk_bf16(v1[0], v1[1]); w.w = cvt_pk_bf16(v1[2], v1[3]);
                        *(u32x4*)(dst + (size_t)row * 512 + cb + bj * 128) = w; } }
        } else if (EMASK & 4) {
            const int hh = pn - 6, k0 = wc * 32 + 8 * fq; float lb[2][4];
#pragma unroll
            for (int n = 0; n < 2; ++n)
#pragma unroll
                for (int j = 0; j < 4; ++j) { const int k = hh * 128 + k0 + 4 * n + j; lb[n][j] = 1.f / (1.f + __expf(lbl[512 + k] - lbl[k])); }
#pragma unroll
            for (int ai = 0; ai < 2; ++ai) {
#pragma unroll
                for (int m = 0; m < 4; ++m)
#pragma unroll
                    for (int n = 0; n < 2; ++n)
#pragma unroll
                        for (int j = 0; j < 4; ++j) { const float f = acc[ai][1][m][n][j]; const float t = __expf(fminf(-f, 80.f)); acc[ai][1][m][n][j] = (1.f - lb[n][j]) * (t / (1.f + t)); }
                const int chunk = u.pm * 4 + ai * 2 + wr;
#pragma unroll
                for (int n = 0; n < 2; ++n)
#pragma unroll
                    for (int j = 0; j < 4; ++j) { float carry = 0.f;
#pragma unroll
                        for (int m = 0; m < 4; ++m) { const float kin = acc[ai][1][m][n][j]; float x = __logf(1.f - kin);
#pragma unroll
                            for (int d = 1; d < 16; d <<= 1) { const float y = __shfl_up(x, d, 16); if (fr >= d) x += y; }
                            x += carry; carry = __shfl(x, 15, 16);
                            acc[ai][0][m][n][j] = silu_(acc[ai][0][m][n][j]) * __expf(x); acc[ai][1][m][n][j] = kin * __expf(-x); }
                        if (fr == 0) EL[(size_t)(chunk * 4 + hh) * 128 + k0 + 4 * n + j] = __expf(carry); }
#pragma unroll
                for (int m = 0; m < 4; ++m) { const int row = rowb + ai * 128 + m * 16; const f32x4 q0 = acc[ai][0][m][0], q1 = acc[ai][0][m][1], k0v = acc[ai][1][m][0], k1v = acc[ai][1][m][1];
                    u32x4 w; w.x = cvt_pk_bf16(q0[0], q0[1]); w.y = cvt_pk_bf16(q0[2], q0[3]); w.z = cvt_pk_bf16(q1[0], q1[1]); w.w = cvt_pk_bf16(q1[2], q1[3]);
                    *(u32x4*)(R1 + 3 * RSTR + (size_t)row * 512 + hh * 128 + k0) = w;
                    w.x = cvt_pk_bf16(k0v[0], k0v[1]); w.y = cvt_pk_bf16(k0v[2], k0v[3]); w.z = cvt_pk_bf16(k1v[0], k1v[1]); w.w = cvt_pk_bf16(k1v[2], k1v[3]);
                    *(u32x4*)(R1 + 4 * RSTR + (size_t)row * 512 + hh * 128 + k0) = w; } }
        }
    }
};
struct EpiOut {
    const float* x; const float* mod; float* out;
    __device__ __forceinline__ void operator()(f32x4 (&acc)[2][2][4][2], const pg8::Unit& u, int wr, int wc, int fr, int fq) const {
        const int rowb = u.pm * 256 + wr * 64 + fr, b = u.pm >> 3;
#pragma unroll
        for (int bj = 0; bj < 2; ++bj)
#pragma unroll
            for (int n = 0; n < 2; ++n) { const int col = u.pn * 256 + bj * 128 + wc * 32 + n * 16 + 4 * fq; const f32x4 g = *(const f32x4*)(mod + b * NMOD + 2 * D + col);
#pragma unroll
                for (int ai = 0; ai < 2; ++ai)
#pragma unroll
                    for (int m = 0; m < 4; ++m) { const size_t off = (size_t)(rowb + ai * 128 + m * 16) * D + col; *(f32x4*)(out + off) = *(const f32x4*)(x + off) + g * acc[ai][bj][m][n]; } }
    }
};
struct EpiGU {
    bf16* HID; const float* wlist;
    __device__ __forceinline__ void operator()(f32x4 (&acc)[2][2][4][2], const pg8::Unit& u, int wr, int wc, int fr, int fq) const {
        const int sb = wr * 64 + fr, cb = u.pn * 128 + wc * 32 + 8 * fq;
#pragma unroll
        for (int ai = 0; ai < 2; ++ai)
#pragma unroll
            for (int m = 0; m < 4; ++m) { const int s = sb + ai * 128 + m * 16;
                if (s < u.rows) { const float w = wlist[u.e * LCAP + u.pm * 256 + s]; const f32x4 g0 = acc[ai][0][m][0], g1 = acc[ai][0][m][1], u0 = acc[ai][1][m][0], u1 = acc[ai][1][m][1]; float h0[4], h1[4];
#pragma unroll
                    for (int j = 0; j < 4; ++j) { h0[j] = silu_(g0[j]) * u0[j] * w; h1[j] = silu_(g1[j]) * u1[j] * w; }
                    u32x4 o; o.x = cvt_pk_bf16(h0[0], h0[1]); o.y = cvt_pk_bf16(h0[2], h0[3]); o.z = cvt_pk_bf16(h1[0], h1[1]); o.w = cvt_pk_bf16(h1[2], h1[3]);
                    *(u32x4*)(HID + (size_t)(u.base + s) * FF + cb) = o; } }
    }
};
struct EpiDN {
    bf16* PART; const int* elist;
    __device__ __forceinline__ void operator()(f32x4 (&acc)[2][2][4][2], const pg8::Unit& u, int wr, int wc, int fr, int fq) const {
        const int sb = wr * 64 + fr, cb = u.pn * 256 + wc * 32 + 8 * fq;
#pragma unroll
        for (int ai = 0; ai < 2; ++ai)
#pragma unroll
            for (int m = 0; m < 4; ++m) { const int s = sb + ai * 128 + m * 16;
                if (s < u.rows) { const int ent = elist[u.e * LCAP + u.pm * 256 + s];
#pragma unroll
                    for (int bj = 0; bj < 2; ++bj) { const f32x4 v0 = acc[ai][bj][m][0], v1 = acc[ai][bj][m][1];
                        u32x4 o; o.x = cvt_pk_bf16(v0[0], v0[1]); o.y = cvt_pk_bf16(v0[2], v0[3]); o.z = cvt_pk_bf16(v1[0], v1[1]); o.w = cvt_pk_bf16(v1[2], v1[3]);
                        *(u32x4*)(PART + (size_t)ent * D + cb + bj * 128) = o; } } }
    }
};

__device__ __forceinline__ void transpose_item(const float* W, int ldw, int scol, bf16* dst_rows, int Kd, int k0, LAS float* scr, int lane) {
#pragma unroll 8
    for (int i = 0; i < 32; ++i) { const int kk = 2 * i + (lane >> 5); scr[kk * 33 + (lane & 31)] = W[(size_t)(k0 + kk) * ldw + scol]; }
    LDS_WAIT(); asm volatile("" ::: "memory");
    const int c = lane & 7;
#pragma unroll
    for (int j = 0; j < 4; ++j) { const int n = (lane >> 3) + 8 * j; const LAS float* s = scr + (8 * c) * 33 + n;
        v4u o; o.x = pk2(s[0 * 33], s[1 * 33]); o.y = pk2(s[2 * 33], s[3 * 33]); o.z = pk2(s[4 * 33], s[5 * 33]); o.w = pk2(s[6 * 33], s[7 * 33]);
        *(GAS v4u*)(dst_rows + (size_t)n * Kd + k0 + 8 * c) = o; }
    LDS_WAIT(); asm volatile("" ::: "memory");
}
__device__ __forceinline__ int plain32(int q) { return 8 * ((q >> 2) & 3) + 4 * (q >> 4) + (q & 3); }
__device__ __forceinline__ int win_col(int P) {
    const int pn = P >> 8, p = P & 255, bj = p >> 7, wc = (p >> 5) & 3, n = (p >> 4) & 1, fq = (p >> 2) & 3, j = p & 3;
    if (pn < 4) { const int part = pn >> 1, th = pn & 1, head = 4 * th + 2 * bj + (wc >> 1), d = 32 * n + 16 * (wc & 1) + 4 * fq + j; return part * 512 + head * 64 + d; }
    const int lc = 128 * bj + 32 * wc + 8 * fq + 4 * n + j;
    if (pn < 6) return 1024 + (pn - 4) * 256 + lc;
    if (pn < 10) { const int hh = pn - 6, kk = 32 * wc + 8 * fq + 4 * n + j; return (bj ? 2048 : 1536) + hh * 128 + kk; }
    if (pn < 12) return 2560 + (pn - 10) * 256 + lc;
    return 3072 + (pn - 12) * 256 + lc;
}

struct Ctx { LAS unsigned char* lds; unsigned char* ws; int vcu, G; };
#define PHASE_IDS const int tid_ = threadIdx.x, lane_ = tid_ & 63, wave_ = __builtin_amdgcn_readfirstlane(tid_ >> 6)

__device__ __forceinline__ void phase0(const Args& a, const Ctx& X) {
    PHASE_IDS;
    const float* c = a.in[1]; const float* w_ada = a.in[3]; const float* b_ada = a.in[4];
    LAS float* cs = (LAS float*)X.lds;
    LAS float* part = (LAS float*)(X.lds + 32768);
    float* mod = (float*)(X.ws + WS_MOD);
    if (X.vcu < 192) {
        for (int i = tid_; i < 8192; i += 512) cs[i] = silu_(c[i]);
        __syncthreads();
        for (int item = X.vcu; item < 192; item += X.G) {
            const int n0 = 32 * item, krow = lane_ >> 3, c4 = lane_ & 7; f32x4 acc[8];
#pragma unroll
            for (int b = 0; b < 8; ++b) acc[b] = (f32x4){0.f, 0.f, 0.f, 0.f};
#pragma unroll 4
            for (int it = 0; it < 16; ++it) { const int k = 128 * wave_ + 8 * it + krow; const f32x4 wv = *(const f32x4*)(w_ada + (size_t)k * NMOD + n0 + 4 * c4);
#pragma unroll
                for (int b = 0; b < 8; ++b) acc[b] += wv * cs[b * 1024 + k]; }
#pragma unroll
            for (int b = 0; b < 8; ++b)
#pragma unroll
                for (int j = 0; j < 4; ++j) { float v = acc[b][j]; v += __shfl_xor(v, 8); v += __shfl_xor(v, 16); v += __shfl_xor(v, 32); acc[b][j] = v; }
            if (lane_ < 8) {
#pragma unroll
                for (int b = 0; b < 8; ++b) *(LAS f32x4*)(part + (wave_ * 8 + b) * 32 + 4 * c4) = acc[b]; }
            __syncthreads();
            if (tid_ < 256) { const int b = tid_ >> 5, col = tid_ & 31; float s = b_ada[n0 + col];
#pragma unroll
                for (int w = 0; w < 8; ++w) s += part[(w * 8 + b) * 32 + col];
                mod[b * NMOD + n0 + col] = s; }
            __syncthreads();
        }
    }
    LAS float* scr = (LAS float*)(X.lds + 65536 + wave_ * 8448);
    const int gw = X.vcu * NWAVES + wave_, NGW = X.G * NWAVES;
    constexpr int I_IN = (NPROJ / 32) * 16, I_OUT = (D / 32) * 16;
    for (int it = gw; it < I_IN + I_OUT; it += NGW) {
        if (it < I_IN) { const int G32 = it >> 4, kb = it & 15; transpose_item(a.in[6], NPROJ, win_col(32 * G32 + (lane_ & 31)), (bf16*)(X.ws + WS_WIN) + (size_t)(32 * G32) * D, D, 64 * kb, scr, lane_); }
        else { const int r = it - I_IN, G32 = r >> 4, kb = r & 15; transpose_item(a.in[14], D, 32 * G32 + (lane_ & 31), (bf16*)(X.ws + WS_WOUT) + (size_t)(32 * G32) * D, D, 64 * kb, scr, lane_); }
    }
    { float* RT = (float*)(X.ws + WS_RT); const float* wgr = a.in[16]; const float* wer = a.in[18];
      for (int idx = X.vcu * 512 + tid_; idx < 36 * 1024; idx += X.G * 512) { const int o = idx >> 10, k = idx & 1023; RT[idx] = (o < 4) ? wgr[k * 4 + o] : wer[k * 32 + (o - 4)]; } }
}
__device__ __forceinline__ void phase1(const Args& a, const Ctx& X) {
    PHASE_IDS;
    const float* x = a.in[0]; const float* nw = a.in[5]; const float* mod = (const float*)(X.ws + WS_MOD); bf16* H1 = (bf16*)(X.ws + WS_RA);
    const int gw = X.vcu * NWAVES + wave_, NGW = X.G * NWAVES;
    for (int m = gw; m < M; m += NGW) { const int b = m >> 11; const f32x4* xr = (const f32x4*)(x + (size_t)m * D) + lane_; f32x4 v[4]; float ss = 0.f;
#pragma unroll
        for (int j = 0; j < 4; ++j) { v[j] = xr[64 * j]; ss += (v[j].x * v[j].x + v[j].y * v[j].y) + (v[j].z * v[j].z + v[j].w * v[j].w); }
        const float rstd = 1.f / sqrtf(wave_sum(ss) * (1.f / D) + RMS_EPS);
#pragma unroll
        for (int j = 0; j < 4; ++j) { const int k = 256 * j + 4 * lane_; const f32x4 w = *(const f32x4*)(nw + k), sh = *(const f32x4*)(mod + b * NMOD + k), sc = *(const f32x4*)(mod + b * NMOD + D + k);
            const f32x4 h = v[j] * rstd * w * (sc + 1.f) + sh; u32x2v o; o.x = cvt_pk_bf16(h.x, h.y); o.y = cvt_pk_bf16(h.z, h.w); *(u32x2v*)(H1 + (size_t)m * D + k) = o; }
    }
}
__device__ __forceinline__ bf16x8 frag16(const LAS bf16* A, int ld, int r0, int k0, int lane) { return *(const LAS bf16x8*)(A + (r0 + (lane & 15)) * ld + k0 + 8 * (lane >> 4)); }
#define MFMA16(a, b, c) __builtin_amdgcn_mfma_f32_16x16x32_bf16(a, b, c, 0, 0, 0)
__device__ __forceinline__ void stage_T(const bf16* src, LAS bf16* dst, int wave, int lane) {
#pragma unroll
    for (int cc = 0; cc < 2; ++cc) { const int c = wave + 8 * cc; const v4u q = *(const v4u*)(src + (size_t)lane * 512 + 8 * c);
        dst[(8 * c + 0) * 72 + lane] = (bf16)(q.x & 0xffffu); dst[(8 * c + 1) * 72 + lane] = (bf16)(q.x >> 16); dst[(8 * c + 2) * 72 + lane] = (bf16)(q.y & 0xffffu); dst[(8 * c + 3) * 72 + lane] = (bf16)(q.y >> 16);
        dst[(8 * c + 4) * 72 + lane] = (bf16)(q.z & 0xffffu); dst[(8 * c + 5) * 72 + lane] = (bf16)(q.z >> 16); dst[(8 * c + 6) * 72 + lane] = (bf16)(q.w & 0xffffu); dst[(8 * c + 7) * 72 + lane] = (bf16)(q.w >> 16); }
}
__device__ __forceinline__ void phase3(const Args& a, const Ctx& X) {
    PHASE_IDS;
    LAS bf16* VT = (LAS bf16*)X.lds; LAS bf16* KT = (LAS bf16*)(X.lds + 18432);
    const bf16* VI = (const bf16*)(X.ws + WS_VI); const bf16* KP = (const bf16*)(X.ws + WS_KP); bf16* UST = (bf16*)(X.ws + WS_UST);
    for (int un = X.vcu; un < 1024; un += X.G) { const int c = un & 31, h = (un >> 5) & 3, b = un >> 7; const size_t row0 = (size_t)b * SEQ + c * 64;
        stage_T(VI + row0 * 512 + h * 128, VT, wave_, lane_); stage_T(KP + row0 * 512 + h * 128, KT, wave_, lane_);
        __syncthreads();
        f32x4 acc[8];
#pragma unroll
        for (int kt = 0; kt < 8; ++kt) acc[kt] = (f32x4){0.f, 0.f, 0.f, 0.f};
#pragma unroll
        for (int ks = 0; ks < 2; ++ks) { const bf16x8 af = frag16(VT, 72, 16 * wave_, 32 * ks, lane_);
#pragma unroll
            for (int kt = 0; kt < 8; ++kt) acc[kt] = MFMA16(af, frag16(KT, 72, 16 * kt, 32 * ks, lane_), acc[kt]); }
        bf16* U = UST + (size_t)un * 16384;
#pragma unroll
        for (int kt = 0; kt < 8; ++kt)
#pragma unroll
            for (int j = 0; j < 4; ++j) U[(16 * wave_ + (lane_ >> 4) * 4 + j) * 128 + 16 * kt + (lane_ & 15)] = (bf16)f2bf(acc[kt][j]);
        __syncthreads();
    }
}
__device__ __forceinline__ void phase4_scan(const Args& a, const Ctx& X, size_t dst_delta = 0) {
    PHASE_IDS;
    bf16* UST = (bf16*)(X.ws + WS_UST); const float* EL = (const float*)(X.ws + WS_EL);
    for (int g = X.vcu * 512 + tid_; g < 32 * 4096; g += X.G * 512) { const int bh = g >> 12, rem = g & 4095, v = rem >> 5, k4 = (rem & 31) * 4, h = bh & 3, b = bh >> 2;
        f32x4 S = (f32x4){0.f, 0.f, 0.f, 0.f};
#pragma unroll 4
        for (int c = 0; c < NCH; ++c) { u32x2v* p = (u32x2v*)(UST + (size_t)(bh * 32 + c) * 16384 + v * 128 + k4); const u32x2v uw = *p; const f32x4 e = *(const f32x4*)(EL + (size_t)((b * 32 + c) * 4 + h) * 128 + k4);
            u32x2v o; o.x = cvt_pk_bf16(S.x, S.y); o.y = cvt_pk_bf16(S.z, S.w); *(u32x2v*)((char*)p + dst_delta) = o;
            S.x = e.x * (S.x + bf_lo(uw.x)); S.y = e.y * (S.y + bf_hi(uw.x)); S.z = e.z * (S.z + bf_lo(uw.y)); S.w = e.w * (S.w + bf_hi(uw.y)); }
    }
}
struct AttnUnitU { int bvh; int qb; };
struct AttnOrder {
  int vcu;
#ifndef ATTN_REP
#define ATTN_REP 1
#endif
  __device__ __forceinline__ bool next(int i_, AttnUnitU& u) const { if (i_ >= 4 * ATTN_REP) return false; const int i = i_ & 3; const int s0 = 2 * (vcu & 1); u.bvh = vcu >> 1; u.qb = (i == 0) ? s0 : (i == 1) ? 7 - s0 : (i == 2) ? s0 + 1 : 6 - s0; return true; }
};
struct AttnT { const attn_body::bf16* Q; const attn_body::bf16* K; const attn_body::bf16* V; attn_body::bf16* O; };
template <class Sched> __device__ __forceinline__ void attn_phase_(char* lds, const AttnT& T, const Sched& S) {
  AttnUnitU u;
  for (int i = 0; S.next(i, u); ++i) { const int vh = u.bvh & 1, qh = (u.bvh >> 1) & 7, b = u.bvh >> 4; attn_body::attn_unit<8>(b, qh * 64, (qh >> 1) * 128 + vh * 64, qh * 128 + vh * 64, u.qb, T.Q, T.K, T.V, T.O, lds); }
}
__device__ __forceinline__ void phase4_attn(const Args& a, const Ctx& X, char* ldsg) {
    const AttnT T{(const attn_body::bf16*)(X.ws + WS_Q), (const attn_body::bf16*)(X.ws + WS_K), (const attn_body::bf16*)(X.ws + WS_V), (attn_body::bf16*)(X.ws + WS_RA)};
    const AttnOrder S{X.vcu};
    attn_phase_<AttnOrder>(ldsg, T, S);
}
__device__ __forceinline__ void phase5_hgrn(const Args& a, const Ctx& X) {
    PHASE_IDS;
    LAS bf16* QS = (LAS bf16*)X.lds; LAS bf16* KS = (LAS bf16*)(X.lds + 17408); LAS bf16* VT = (LAS bf16*)(X.lds + 34816); LAS bf16* STs = (LAS bf16*)(X.lds + 53248);
    LAS bf16* PS = (LAS bf16*)(X.lds + 88064); LAS float* OS = (LAS float*)(X.lds + 97280);
    const bf16* QP = (const bf16*)(X.ws + WS_QP); const bf16* KP = (const bf16*)(X.ws + WS_KP); const bf16* VI = (const bf16*)(X.ws + WS_VI); const bf16* SG = (const bf16*)(X.ws + WS_SG);
    const bf16* UST = (const bf16*)(X.ws + WS_UST); bf16* MIXED = (bf16*)(X.ws + WS_MIXED); const float* gnw = a.in[13];
    for (int un = X.vcu; un < 1024; un += X.G) { const int c = un & 31, h = (un >> 5) & 3, b = un >> 7; const size_t row0 = (size_t)b * SEQ + c * 64;
#pragma unroll
        for (int i = 0; i < 2; ++i) { const int idx = tid_ + 512 * i, row = idx >> 4, ch = idx & 15;
            *(LAS v4u*)(QS + row * 136 + ch * 8) = *(const v4u*)(QP + (row0 + row) * 512 + h * 128 + ch * 8); *(LAS v4u*)(KS + row * 136 + ch * 8) = *(const v4u*)(KP + (row0 + row) * 512 + h * 128 + ch * 8); }
#pragma unroll
        for (int i = 0; i < 4; ++i) { const int idx = tid_ + 512 * i, row = idx >> 4, ch = idx & 15; *(LAS v4u*)(STs + row * 136 + ch * 8) = *(const v4u*)(UST + (size_t)un * 16384 + row * 128 + ch * 8); }
        stage_T(VI + row0 * 512 + h * 128, VT, wave_, lane_);
        __syncthreads();
        { const int tt = wave_ >> 1; f32x4 s2[2];
#pragma unroll
          for (int x = 0; x < 2; ++x) s2[x] = (f32x4){0.f, 0.f, 0.f, 0.f};
#pragma unroll
          for (int ks = 0; ks < 4; ++ks) { const bf16x8 af = frag16(QS, 136, 16 * tt, 32 * ks, lane_);
#pragma unroll
              for (int x = 0; x < 2; ++x) s2[x] = MFMA16(af, frag16(KS, 136, 16 * (2 * (wave_ & 1) + x), 32 * ks, lane_), s2[x]); }
#pragma unroll
          for (int x = 0; x < 2; ++x) { const int st = 2 * (wave_ & 1) + x;
#pragma unroll
              for (int j = 0; j < 4; ++j) { const int t = 16 * tt + (lane_ >> 4) * 4 + j, s = 16 * st + (lane_ & 15); PS[t * 72 + s] = (bf16)f2bf(s <= t ? s2[x][j] : 0.f); } } }
        __syncthreads();
        { f32x4 o[4];
#pragma unroll
          for (int tt = 0; tt < 4; ++tt) o[tt] = (f32x4){0.f, 0.f, 0.f, 0.f};
#pragma unroll
          for (int ks = 0; ks < 2; ++ks) { const bf16x8 bfr = frag16(VT, 72, 16 * wave_, 32 * ks, lane_);
#pragma unroll
              for (int tt = 0; tt < 4; ++tt) o[tt] = MFMA16(frag16(PS, 72, 16 * tt, 32 * ks, lane_), bfr, o[tt]); }
#pragma unroll
          for (int ks = 0; ks < 4; ++ks) { const bf16x8 bfr = frag16(STs, 136, 16 * wave_, 32 * ks, lane_);
#pragma unroll
              for (int tt = 0; tt < 4; ++tt) o[tt] = MFMA16(frag16(QS, 136, 16 * tt, 32 * ks, lane_), bfr, o[tt]); }
#pragma unroll
          for (int tt = 0; tt < 4; ++tt)
#pragma unroll
              for (int j = 0; j < 4; ++j) OS[(16 * tt + (lane_ >> 4) * 4 + j) * 132 + 16 * wave_ + (lane_ & 15)] = o[tt][j]; }
        __syncthreads();
#pragma unroll
        for (int r = 0; r < 8; ++r) { const int t = 8 * wave_ + r; const float o0 = OS[t * 132 + 2 * lane_], o1 = OS[t * 132 + 2 * lane_ + 1];
            const float rstd = 1.f / sqrtf(wave_sum(o0 * o0 + o1 * o1) * (1.f / 128.f) + RMS_EPS); const unsigned sg = *(const unsigned*)(SG + (row0 + t) * 512 + h * 128 + 2 * lane_);
            *(unsigned*)(MIXED + (row0 + t) * 1024 + 512 + h * 128 + 2 * lane_) = cvt_pk_bf16(o0 * rstd * gnw[2 * lane_] * bf_lo(sg), o1 * rstd * gnw[2 * lane_ + 1] * bf_hi(sg)); }
        __syncthreads();
    }
}
__device__ __forceinline__ void phase5_comb(const Args& a, const Ctx& X) {
    PHASE_IDS;
    const bf16* AO = (const bf16*)(X.ws + WS_RA); bf16* MIXED = (bf16*)(X.ws + WS_MIXED); const float* sw = a.in[11];
    const float d1 = wave_sum(a.in[7][lane_] * a.in[8][lane_]), d2 = wave_sum(a.in[9][lane_] * a.in[10][lane_]); const float lam = expf(d1) - expf(d2) + LAMBDA_INIT;
    const int gw = X.vcu * NWAVES + wave_, NGW = X.G * NWAVES, hh = lane_ >> 4, ds = (lane_ & 15) * 8;
    float swv[8];
#pragma unroll
    for (int i = 0; i < 8; ++i) swv[i] = sw[ds + i] * (1.f - LAMBDA_INIT);
    for (int m = gw; m < M; m += NGW) { const v4u p1 = *(const v4u*)(AO + (size_t)m * 1024 + (2 * hh) * 128 + ds), p2 = *(const v4u*)(AO + (size_t)m * 1024 + (2 * hh + 1) * 128 + ds); float v[8];
        v[0] = bf_lo(p1.x) - lam * bf_lo(p2.x); v[1] = bf_hi(p1.x) - lam * bf_hi(p2.x); v[2] = bf_lo(p1.y) - lam * bf_lo(p2.y); v[3] = bf_hi(p1.y) - lam * bf_hi(p2.y);
        v[4] = bf_lo(p1.z) - lam * bf_lo(p2.z); v[5] = bf_hi(p1.z) - lam * bf_hi(p2.z); v[6] = bf_lo(p1.w) - lam * bf_lo(p2.w); v[7] = bf_hi(p1.w) - lam * bf_hi(p2.w);
        float ss = 0.f;
#pragma unroll
        for (int i = 0; i < 8; ++i) ss += v[i] * v[i];
        ss += __shfl_xor(ss, 1); ss += __shfl_xor(ss, 2); ss += __shfl_xor(ss, 4); ss += __shfl_xor(ss, 8);
        const float rstd = 1.f / sqrtf(ss * (1.f / 128.f) + SUBLN_EPS);
        v4u o; o.x = cvt_pk_bf16(v[0] * rstd * swv[0], v[1] * rstd * swv[1]); o.y = cvt_pk_bf16(v[2] * rstd * swv[2], v[3] * rstd * swv[3]);
        o.z = cvt_pk_bf16(v[4] * rstd * swv[4], v[5] * rstd * swv[5]); o.w = cvt_pk_bf16(v[6] * rstd * swv[6], v[7] * rstd * swv[7]);
        *(v4u*)(MIXED + (size_t)m * 1024 + hh * 128 + ds) = o; }
}
__device__ __forceinline__ void phase7_route(const Args& a, const Ctx& X, gu32* ctl, size_t list_delta = 0, int cnt_delta = 0) {
    PHASE_IDS;
    LAS float* WT = (LAS float*)X.lds;
    const float* bgr = a.in[17]; const float* ber = a.in[19]; const float* nw = a.in[15];
    const float* x1 = a.out; const float* mod = (const float*)(X.ws + WS_MOD); bf16* H2 = (bf16*)(X.ws + WS_RA);
    int* elist = (int*)(X.ws + WS_ELIST + list_delta); float* wlist = (float*)(X.ws + WS_WLIST + list_delta);
    { const f32x4* RT = (const f32x4*)(X.ws + WS_RT);
#pragma unroll 6
      for (int i = 0; i < 18; ++i) { const int idx = tid_ + 512 * i; *(LAS f32x4*)(WT + 4 * idx) = RT[idx]; } }
    LAS int* rE = (LAS int*)(X.lds + LDSCTL_OFF + 2048); LAS float* rW = (LAS float*)(rE + 128); LAS unsigned* lcnt = (LAS unsigned*)(rE + 256); LAS unsigned* lbase = lcnt + 32;
    if (tid_ < 32) lcnt[tid_] = 0u;
    if (tid_ < 128) rE[tid_] = -1;
    __syncthreads();
    const int gw = X.vcu * NWAVES + wave_, NGW = X.G * NWAVES; int trip = 0;
    f32x4 xn[4];
    if (gw < M) {
#pragma unroll
        for (int j = 0; j < 4; ++j) xn[j] = ((const f32x4*)(x1 + (size_t)gw * D) + lane_)[64 * j]; }
    for (int m = gw; m < M; m += NGW, ++trip) { const int b = m >> 11; f32x4 h[4]; float ss = 0.f;
#pragma unroll
        for (int j = 0; j < 4; ++j) { h[j] = xn[j]; ss += (h[j].x * h[j].x + h[j].y * h[j].y) + (h[j].z * h[j].z + h[j].w * h[j].w); }
        if (m + NGW < M) {
#pragma unroll
            for (int j = 0; j < 4; ++j) xn[j] = ((const f32x4*)(x1 + (size_t)(m + NGW) * D) + lane_)[64 * j]; }
        const float rstd = 1.f / sqrtf(wave_sum(ss) * (1.f / D) + RMS_EPS);
#pragma unroll
        for (int j = 0; j < 4; ++j) { const int k = 256 * j + 4 * lane_; const f32x4 w = *(const f32x4*)(nw + k), sh = *(const f32x4*)(mod + b * NMOD + 3 * D + k), sc = *(const f32x4*)(mod + b * NMOD + 4 * D + k);
            h[j] = h[j] * rstd * w * (sc + 1.f) + sh; u32x2v o; o.x = cvt_pk_bf16(h[j].x, h[j].y); o.y = cvt_pk_bf16(h[j].z, h[j].w); *(u32x2v*)(H2 + (size_t)m * D + k) = o; }
        float gl[4];
#pragma unroll
        for (int g = 0; g < 4; ++g) { float s = 0.f;
#pragma unroll
            for (int j = 0; j < 4; ++j) { const f32x4 w = *(const LAS f32x4*)(WT + g * 1024 + 256 * j + 4 * lane_); s += (h[j].x * w.x + h[j].y * w.y) + (h[j].z * w.z + h[j].w * w.w); }
            gl[g] = wave_sum(s) + bgr[g]; }
        int gs = 0; float gm = gl[0];
#pragma unroll
        for (int g = 1; g < 4; ++g) if (gl[g] > gm) { gm = gl[g]; gs = g; }
        float den = 0.f;
#pragma unroll
        for (int g = 0; g < 4; ++g) den += expf(gl[g] - gm);
        const float pg = 1.f / den;
        float el[8]; const LAS float* WE = WT + (4 + 8 * gs) * 1024;
#pragma unroll
        for (int i = 0; i < 8; ++i) { float s = 0.f;
#pragma unroll
            for (int j = 0; j < 4; ++j) { const f32x4 w = *(const LAS f32x4*)(WE + i * 1024 + 256 * j + 4 * lane_); s += (h[j].x * w.x + h[j].y * w.y) + (h[j].z * w.z + h[j].w * w.w); }
            el[i] = wave_sum(s) + ber[gs * 8 + i]; }
        int i1 = 0; float m1 = el[0];
#pragma unroll
        for (int i = 1; i < 8; ++i) if (el[i] > m1) { m1 = el[i]; i1 = i; }
        int i2 = -1; float m2 = -INFINITY;
#pragma unroll
        for (int i = 0; i < 8; ++i) if (i != i1 && (i2 < 0 || el[i] > m2)) { m2 = el[i]; i2 = i; }
        const float t = expf(m2 - m1), w1 = pg / (1.f + t), w2 = pg * t / (1.f + t);
        if (lane_ == 0 && trip < 8) { const int li = trip * 8 + wave_; rE[2 * li] = gs * 8 + i1; rE[2 * li + 1] = gs * 8 + i2; rW[2 * li] = w1; rW[2 * li + 1] = w2; }
    }
    __syncthreads();
    int e = -1; unsigned loc = 0u;
    if (tid_ < 128) { e = rE[tid_]; if (e >= 0) loc = __hip_atomic_fetch_add(lcnt + e, 1u, __ATOMIC_RELAXED, __HIP_MEMORY_SCOPE_WORKGROUP); }
    __syncthreads();
    if (tid_ < 32) { const unsigned cn = lcnt[tid_]; lbase[tid_] = cn ? __hip_atomic_fetch_add(ctl + CW_CNT + cnt_delta + 64 * tid_, cn, RLX_AGENT) : 0u; }
    __syncthreads();
    if (tid_ < 128 && e >= 0) { const unsigned slot = lbase[e] + loc; const int li = tid_ >> 1, m = X.vcu * NWAVES + (li & 7) + (li >> 3) * NGW;
        if (slot < (unsigned)LCAP) { elist[e * LCAP + slot] = 2 * m + (tid_ & 1); wlist[e * LCAP + slot] = rW[tid_]; } }
}
__device__ __forceinline__ void phase7_conv(const Args& a, const Ctx& X) {
    PHASE_IDS;
    LAS float* scr = (LAS float*)(X.lds + wave_ * 8448);
    const int gw = X.vcu * NWAVES + wave_, NGW = X.G * NWAVES;
    constexpr int I_GU = 32 * 4 * 8 * 16, I_DN = 32 * 32 * 8;
    for (int it = gw; it < I_GU + I_DN; it += NGW) {
        if (it < I_GU) { const int kb = it & 15, g8 = (it >> 4) & 7, sub = (it >> 7) & 3, e = it >> 9, bj = g8 >> 2, wc = g8 & 3;
            const float* W = (bj ? a.in[21] : a.in[20]) + (size_t)e * D * FF; const int scol = 128 * sub + 32 * wc + plain32(lane_ & 31);
            transpose_item(W, FF, scol, (bf16*)(X.ws + WS_WGU) + ((size_t)(e * 4 + sub) * 256 + 32 * g8) * D, D, 64 * kb, scr, lane_); }
        else { const int r = it - I_GU, kb = r & 7, G32 = (r >> 3) & 31, e = r >> 8; const float* W = a.in[22] + (size_t)e * FF * D; const int scol = 32 * G32 + plain32(lane_ & 31);
            transpose_item(W, D, scol, (bf16*)(X.ws + WS_WD) + ((size_t)e * 1024 + 32 * G32) * FF, FF, 64 * kb, scr, lane_); }
    }
}
__device__ __forceinline__ void phase10(const Args& a, const Ctx& X, float* dst = nullptr) {
    PHASE_IDS;
    float* out = a.out; const float* mod = (const float*)(X.ws + WS_MOD); const bf16* PART = (const bf16*)(X.ws + WS_PART); const float* fw = a.in[23];
    const int gw = X.vcu * NWAVES + wave_, NGW = X.G * NWAVES;
    for (int m = gw; m < M; m += NGW) { const int b = m >> 11; f32x4* xr = (f32x4*)(out + (size_t)m * D) + lane_; f32x4* xw = dst ? (f32x4*)(dst + (size_t)m * D) + lane_ : xr; f32x4 y[4]; float ss = 0.f;
#pragma unroll
        for (int j = 0; j < 4; ++j) { const int k = 256 * j + 4 * lane_; const f32x4 g = *(const f32x4*)(mod + b * NMOD + 5 * D + k);
            const u32x2v p0 = *(const u32x2v*)(PART + (size_t)(2 * m) * D + k), p1 = *(const u32x2v*)(PART + (size_t)(2 * m + 1) * D + k);
            f32x4 f; f.x = bf_lo(p0.x) + bf_lo(p1.x); f.y = bf_hi(p0.x) + bf_hi(p1.x); f.z = bf_lo(p0.y) + bf_lo(p1.y); f.w = bf_hi(p0.y) + bf_hi(p1.y);
            y[j] = xr[64 * j] + g * f; ss += (y[j].x * y[j].x + y[j].y * y[j].y) + (y[j].z * y[j].z + y[j].w * y[j].w); }
        const float rstd = 1.f / sqrtf(wave_sum(ss) * (1.f / D) + RMS_EPS);
#pragma unroll
        for (int j = 0; j < 4; ++j) { const int k = 256 * j + 4 * lane_; xw[64 * j] = y[j] * rstd * *(const f32x4*)(fw + k); }
    }
}

__global__ void __launch_bounds__(NWAVES * 64, 2) hymba_fwd(Args args) {
    extern __shared__ __attribute__((aligned(16))) unsigned char lds[];
    Ctx X; X.lds = (LAS unsigned char*)lds; X.ws = args.ws;
    X.G = gridDim.x; { const int bx = blockIdx.x; X.vcu = (X.G % 8 == 0) ? (bx % 8) * (X.G / 8) + bx / 8 : bx; }
    gu32* ctl = (gu32*)(args.ws + WS_CTL);
    for (int u = threadIdx.x; u < (LDS_BYTES - LDSCTL_OFF) / 4; u += NWAVES * 64) ((LAS unsigned*)(X.lds + LDSCTL_OFF))[u] = 0u;
    __syncthreads();
    if (MK_N_LAUNCHES == 1) (void)xcd_barrier_post((unsigned*)(ctl + CW_BAR), (volatile LAS unsigned*)(X.lds + MISC_OFF) + 8);
    const int lo = args.ph_lo, hi = args.ph_hi;
#ifndef PH_MASK
#define PH_MASK 0x7ff
#endif
#define IN(k) ((((PH_MASK) >> (k)) & 1) && lo <= (k) && (k) < hi)
#define SEAM(k) do { if (IN(k) && IN((k) + 1)) { XcdBarrier bar_; bar_.bar = (unsigned*)((gu32*)(args.ws + WS_CTL) + CW_BAR); bar_.x = xb_xcc_id(); bar_.st = (volatile LAS unsigned*)(X.lds + MISC_OFF) + 8; xcd_barrier(bar_); } } while (0)
    LAS int* tab = (LAS int*)(X.lds + SCHED_OFF);
#ifndef DUP_MASK
#define DUP_MASK 0
#endif
#define GBAR() do { XcdBarrier bar_; bar_.bar = (unsigned*)((gu32*)(args.ws + WS_CTL) + CW_BAR); bar_.x = xb_xcc_id(); bar_.st = (volatile LAS unsigned*)(X.lds + MISC_OFF) + 8; xcd_barrier(bar_); } while (0)
#define DUP(k) (((DUP_MASK) >> (k)) & 1)
    if (IN(0)) { phase0(args, X); if (DUP(0)) { GBAR(); phase0(args, X); } } SEAM(0);
    if (IN(1)) { phase1(args, X); if (DUP(1)) { GBAR(); phase1(args, X); } } SEAM(1);
    if (IN(2)) {
        { DenseOrder S; S.init(M, 2560, D, X.G, (int)blockIdx.x, args.ws + WS_RA, args.ws + WS_WIN, 0, 6, 4);
          EpiInProj<3> E{(bf16*)(args.ws + WS_Q), (float*)(args.ws + WS_EL), (const int*)args.in[2], args.in[12]};
          pg8::gemm_phase<EpiInProj<3>, DenseOrder, false, true>(X.lds, D, S, E); }
        { DenseOrder S; S.init(M, 1024, D, X.G, (int)blockIdx.x, args.ws + WS_RA, args.ws + WS_WIN, 6);
          EpiInProj<4> E{(bf16*)(args.ws + WS_Q), (float*)(args.ws + WS_EL), (const int*)args.in[2], args.in[12]};
          pg8::gemm_phase<EpiInProj<4>, DenseOrder, false, true>(X.lds, D, S, E); }
        if (DUP(2)) { GBAR(); { DenseOrder S; S.init(M, 2560, D, X.G, (int)blockIdx.x, args.ws + WS_RA, args.ws + WS_WIN, 0, 6, 4); EpiInProj<3> E{(bf16*)(args.ws + WS_Q), (float*)(args.ws + WS_EL), (const int*)args.in[2], args.in[12]}; pg8::gemm_phase<EpiInProj<3>, DenseOrder, false, true>(X.lds, D, S, E); }
          { DenseOrder S; S.init(M, 1024, D, X.G, (int)blockIdx.x, args.ws + WS_RA, args.ws + WS_WIN, 6); EpiInProj<4> E{(bf16*)(args.ws + WS_Q), (float*)(args.ws + WS_EL), (const int*)args.in[2], args.in[12]}; pg8::gemm_phase<EpiInProj<4>, DenseOrder, false, true>(X.lds, D, S, E); } } } SEAM(2);
    if (IN(3)) { phase3(args, X); if (DUP(3)) { GBAR(); phase3(args, X); } } SEAM(3);
    if (IN(4)) { if (DUP(11)) { phase4_scan(args, X, WS_WD - WS_UST); GBAR(); } phase4_scan(args, X); phase4_attn(args, X, (char*)lds); } SEAM(4);
    if (IN(5)) { phase5_hgrn(args, X); phase5_comb(args, X); if (DUP(5)) { GBAR(); phase5_hgrn(args, X); phase5_comb(args, X); } } SEAM(5);
    if (IN(6)) { DenseOrder S; S.init(M, D, D, X.G, (int)blockIdx.x, args.ws + WS_MIXED, args.ws + WS_WOUT);
        EpiOut E{args.in[0], (const float*)(args.ws + WS_MOD), args.out};
        pg8::gemm_phase<EpiOut, DenseOrder, false, true>(X.lds, D, S, E); if (DUP(6)) { GBAR(); pg8::gemm_phase<EpiOut, DenseOrder, false, true>(X.lds, D, S, E); } } SEAM(6);
    if (IN(7)) { if (DUP(12)) { phase7_route(args, X, ctl, WS_HID - WS_ELIST, 4096); GBAR(); } phase7_route(args, X, ctl); __syncthreads(); phase7_conv(args, X); if (DUP(7)) { GBAR(); phase7_conv(args, X); } } SEAM(7);
    if (IN(8)) { sched_tables(tab, ctl + CW_CNT, (int)threadIdx.x);
        MoeOrder S{tab, X.G, (int)blockIdx.x, 0, (const char*)(args.ws + WS_RA), (const char*)(args.ws + WS_WGU), (const int*)(args.ws + WS_ELIST)};
        EpiGU E{(bf16*)(args.ws + WS_HID), (const float*)(args.ws + WS_WLIST)};
        pg8::gemm_phase<EpiGU, MoeOrder, true, true>(X.lds, D, S, E); } SEAM(8);
    if (IN(9)) { sched_tables(tab, ctl + CW_CNT, (int)threadIdx.x);
        MoeOrder S{tab, X.G, (int)blockIdx.x, 1, (const char*)(args.ws + WS_HID), (const char*)(args.ws + WS_WD), (const int*)(args.ws + WS_ELIST)};
        EpiDN E{(bf16*)(args.ws + WS_PART), (const int*)(args.ws + WS_ELIST)};
        pg8::gemm_phase<EpiDN, MoeOrder, false, true>(X.lds, FF, S, E); } SEAM(9);
    if (IN(10)) { if (DUP(13)) { phase10(args, X, (float*)(args.ws + WS_WGU)); GBAR(); } phase10(args, X); }
#undef IN
#undef SEAM
}

extern "C" void kernel_launch(void* const* d_in, const int* in_sizes, int n_in, void* d_out, int out_size, void* d_ws, size_t ws_size, hipStream_t stream) {
    static int grid = 0;
    if (grid == 0) {
        if (n_in != 24 || in_sizes[0] != M * D || out_size != M * D || ws_size < WS_END) { fprintf(stderr, "kernel_launch: unexpected shapes (n_in %d, in0 %d, out %d, ws %zu); nothing launched\n", n_in, n_in > 0 ? in_sizes[0] : -1, out_size, ws_size); grid = -1; return; }
        int dev = 0, cus = 0, per_cu = 0;
        if (hipGetDevice(&dev) != hipSuccess || hipDeviceGetAttribute(&cus, hipDeviceAttributeMultiprocessorCount, dev) != hipSuccess) { fprintf(stderr, "kernel_launch: device query failed\n"); grid = -1; return; }
        if (hipFuncSetAttribute((const void*)hymba_fwd, hipFuncAttributeMaxDynamicSharedMemorySize, LDS_BYTES) != hipSuccess) { fprintf(stderr, "kernel_launch: hipFuncSetAttribute failed\n"); grid = -1; return; }
        if (hipOccupancyMaxActiveBlocksPerMultiprocessor(&per_cu, (const void*)hymba_fwd, NWAVES * 64, LDS_BYTES) != hipSuccess || per_cu < 1) { fprintf(stderr, "kernel_launch: occupancy query reports %d workgroups per CU\n", per_cu); (void)hipGetLastError(); grid = -1; return; }
        if (cus != 256) { fprintf(stderr, "kernel_launch: built for a 256-CU device, found %d CUs; nothing launched\n", cus); grid = -1; return; }
        grid = cus;
    }
    if (grid < 0) return;
    (void)hipMemsetAsync((char*)d_ws + WS_CTL, 0, CTL_ZERO_BYTES, stream);
    Args a{};
    for (int i = 0; i < 24; ++i) a.in[i] = (const float*)d_in[i];
    a.out = (float*)d_out; a.ws = (unsigned char*)d_ws;
    if (MK_N_LAUNCHES == 1) { a.ph_lo = 0; a.ph_hi = NPH; hipLaunchKernelGGL(hymba_fwd, dim3(grid), dim3(NWAVES * 64), LDS_BYTES, stream, a); }
    else { for (int p = 0; p < NPH; ++p) { a.ph_lo = p; a.ph_hi = p + 1; hipLaunchKernelGGL(hymba_fwd, dim3(grid), dim3(NWAVES * 64), LDS_BYTES, stream, a); } }
}
```

```cpp
#include <hip/hip_runtime.h>
#include <hip/hip_bf16.h>
#include <cstdio>
#include <cstdint>
#include <cmath>
namespace pg8 {
#define PG8_LAS __attribute__((address_space(3)))
typedef unsigned short bf16_t;
typedef short bf16x8 __attribute__((ext_vector_type(8)));
typedef float f32x4 __attribute__((ext_vector_type(4)));
typedef unsigned u32x4 __attribute__((ext_vector_type(4)));
constexpr int BM = 256, BK = 64, HALF = 128, HTB = HALF * BK * 2  , STAGE_BYTES = 8 * HTB, NXCD = 8, WGM = 8;
__host__ __device__ __forceinline__ int lds_byte(int r, int c) { const int st = (r >> 4) * 2 + (c >> 5), rr = r & 15, cc = c & 31, ob = rr * 64 + cc * 2; return st * 1024 + (ob ^ (((ob >> 9) & 1) << 5)); }
__host__ __device__ __forceinline__ void stage_rc(int b, int& R, int& C) { const int st = b / 1024, sb = b % 1024, swz = sb ^ (((sb >> 9) & 1) << 5); R = (st >> 1) * 16 + swz / 64; C = (st & 1) * 32 + (swz % 64) / 2; }
struct Unit { int pm, pn; const char* A; const char* B; const int* gidx; int rows; int e; int base; };
__device__ __forceinline__ unsigned cvt_pk_bf16(float lo, float hi) { unsigned r; asm volatile("v_cvt_pk_bf16_f32 %0, %1, %2" : "=v"(r) : "v"(lo), "v"(hi)); return r; }
template <class Epi, class Sched, bool GATHER, bool ALIGN_EPI>
__device__ __forceinline__ void gemm_phase(PG8_LAS unsigned char* lds, const int K, const Sched& S, const Epi& E) {
    constexpr bool SP2 = true;
    const int tid = threadIdx.x, wid = __builtin_amdgcn_readfirstlane(tid >> 6), lane = tid & 63, wr = wid >> 2, wc = wid & 3, fr = lane & 15, fq = lane >> 4;
    const int nt = K / BK;
    unsigned voffB[2]; int RA[2], CA[2];
#pragma unroll
    for (int i = 0; i < 2; ++i) { int R, C; stage_rc(tid * 16 + i * 8192, R, C); RA[i] = R; CA[i] = C; voffB[i] = (unsigned)(R * K + C) * 2u; }
#define PG8_SETVOFF(dst, u) do { _Pragma("unroll") for (int _h = 0; _h < 2; ++_h) _Pragma("unroll") for (int _i = 0; _i < 2; ++_i) { int _r = _h * HALF + RA[_i]; \
        if constexpr (GATHER) { _r = _r < (u).rows ? _r : (u).rows - 1; _r = (u).gidx[_r] >> 1; } \
        dst[_h][_i] = (unsigned)(_r * K + CA[_i]) * 2u; } } while (0)
    const size_t kstep = (size_t)(BK * 2);
    const size_t hstep = (size_t)HALF * K * 2;
    const unsigned ldsw = (unsigned)wid * 1024u;
    const int aoff = lds_byte(wr * 64 + fr, fq * 8), boff = lds_byte(wc * 32 + fr, fq * 8);
#define PG8_SA(b, h) (((b) * 2 + (h)) * HTB)
#define PG8_SB(b, h) ((4 + (b) * 2 + (h)) * HTB)
#define PG8_STAGE(bufoff, gbase, voff) do { _Pragma("unroll") for (int _i = 0; _i < 2; ++_i) \
        __builtin_amdgcn_global_load_lds((const unsigned*)((const char*)(gbase) + (voff)[_i]), (PG8_LAS unsigned*)(lds + (bufoff) + ldsw + _i * 8192), 16, 0, 0); } while (0)
#define PG8_STAGEA(bufoff, gbase, h) PG8_STAGE(bufoff, gbase, vA[h])
#define PG8_LDA(dst, b, h) do { _Pragma("unroll") for (int m = 0; m < 4; ++m) _Pragma("unroll") for (int k = 0; k < 2; ++k) dst[m][k] = *(const PG8_LAS bf16x8*)(lds + PG8_SA(b, h) + aoff + m * 2048 + k * 1024); } while (0)
#define PG8_LDB(dst, b, h) do { _Pragma("unroll") for (int n = 0; n < 2; ++n) _Pragma("unroll") for (int k = 0; k < 2; ++k) dst[n][k] = *(const PG8_LAS bf16x8*)(lds + PG8_SB(b, h) + boff + n * 2048 + k * 1024); } while (0)
#define PG8_MMA(ai, bj, At, Bt) do { __builtin_amdgcn_s_setprio(1); _Pragma("unroll") for (int m = 0; m < 4; ++m) _Pragma("unroll") for (int n = 0; n < 2; ++n) _Pragma("unroll") for (int k = 0; k < 2; ++k) \
        acc[ai][bj][m][n] = __builtin_amdgcn_mfma_f32_16x16x32_bf16(Bt[n][k], At[m][k], acc[ai][bj][m][n], 0, 0, 0); __builtin_amdgcn_s_setprio(0); } while (0)
#define PG8_WAIT_V(n) asm volatile("s_waitcnt vmcnt(" #n ")" ::: "memory")
#define PG8_WAIT_L(n) asm volatile("s_waitcnt lgkmcnt(" #n ")" ::: "memory")
#define PG8_BAR __builtin_amdgcn_s_barrier()
#define PG8_SCHED __builtin_amdgcn_sched_barrier(0)
    Unit cur, nxt; int ui = 0;
    if (!S.next(0, cur)) return;
    f32x4 acc[2][2][4][2];
#pragma unroll
    for (int a = 0; a < 2; ++a)
#pragma unroll
        for (int b = 0; b < 2; ++b)
#pragma unroll
            for (int m = 0; m < 4; ++m)
#pragma unroll
                for (int n = 0; n < 2; ++n) acc[a][b][m][n] = (f32x4){0.f, 0.f, 0.f, 0.f};
    bf16x8 At[4][2], B0[2][2], B1[2][2];
    const char* cA = cur.A; const char* cB = cur.B;
    unsigned vA[2][2], vN[2][2];
    PG8_SETVOFF(vA, cur);
    if constexpr (SP2) {
        PG8_STAGE(PG8_SB(0, 0), cB, voffB); PG8_STAGE(PG8_SB(0, 1), cB + hstep, voffB); PG8_STAGEA(PG8_SA(0, 0), cA, 0); PG8_STAGEA(PG8_SA(0, 1), cA, 1);
        if (wr == 1) PG8_BAR;
        PG8_WAIT_V(2); PG8_BAR;
        PG8_STAGE(PG8_SB(1, 0), cB + kstep, voffB); PG8_STAGEA(PG8_SA(1, 0), cA + kstep, 0); PG8_STAGE(PG8_SB(1, 1), cB + hstep + kstep, voffB);
        PG8_WAIT_V(6); PG8_BAR;
    }
    for (;;) {
        const bool has_next = S.next(ui + 1, nxt);
        const char* nA = has_next ? nxt.A : cA; const char* nB = has_next ? nxt.B : cB;
        for (int t = 0; t < nt; t += 2) {
            const bool last = (t == nt - 2);
            const char* a1 = cA + (size_t)(t + 1) * kstep;
            const char* a2 = last ? nA : cA + (size_t)(t + 2) * kstep; const char* b2 = last ? nB : cB + (size_t)(t + 2) * kstep;
            const char* a3 = a2 + kstep; const char* b3 = b2 + kstep;
            if (last) { if (has_next) { PG8_SETVOFF(vN, nxt); } else { _Pragma("unroll") for (int _h = 0; _h < 2; ++_h) _Pragma("unroll") for (int _i = 0; _i < 2; ++_i) vN[_h][_i] = vA[_h][_i]; } }
            if constexpr (SP2) {
            PG8_LDB(B0, 0, 0); PG8_LDB(B1, 0, 1); PG8_SCHED; PG8_LDA(At, 0, 0); PG8_STAGEA(PG8_SA(1, 1), a1, 1);
            if (last) { _Pragma("unroll") for (int _h = 0; _h < 2; ++_h) _Pragma("unroll") for (int _i = 0; _i < 2; ++_i) vA[_h][_i] = vN[_h][_i]; }
            PG8_WAIT_V(8); PG8_WAIT_L(0); PG8_BAR; PG8_MMA(0, 0, At, B0); PG8_MMA(0, 1, At, B1); PG8_BAR; PG8_SCHED;
            PG8_LDA(At, 0, 1); PG8_STAGE(PG8_SB(0, 0), b2, voffB); PG8_STAGE(PG8_SB(0, 1), b2 + hstep, voffB); PG8_STAGEA(PG8_SA(0, 0), a2, 0);
            PG8_WAIT_V(8); PG8_WAIT_L(0); PG8_BAR; PG8_MMA(1, 0, At, B0); PG8_MMA(1, 1, At, B1); PG8_BAR; PG8_SCHED;
            PG8_LDB(B0, 1, 0); PG8_LDB(B1, 1, 1); PG8_SCHED; PG8_LDA(At, 1, 0); PG8_STAGEA(PG8_SA(0, 1), a2, 1);
            PG8_WAIT_V(8); PG8_WAIT_L(0); PG8_BAR; PG8_MMA(0, 0, At, B0); PG8_MMA(0, 1, At, B1); PG8_BAR; PG8_SCHED;
            PG8_LDA(At, 1, 1); PG8_STAGE(PG8_SB(1, 0), b3, voffB); PG8_STAGE(PG8_SB(1, 1), b3 + hstep, voffB); PG8_STAGEA(PG8_SA(1, 0), a3, 0);
            PG8_WAIT_V(8); PG8_WAIT_L(0); PG8_BAR; PG8_MMA(1, 0, At, B0); PG8_MMA(1, 1, At, B1); PG8_BAR; PG8_SCHED;
            }
        }
        if constexpr (ALIGN_EPI) { if (wr == 0) PG8_BAR; }
        E(acc, cur, wr, wc, fr, fq);
        if (!has_next) break;
#pragma unroll
        for (int a = 0; a < 2; ++a)
#pragma unroll
            for (int b = 0; b < 2; ++b)
#pragma unroll
                for (int m = 0; m < 4; ++m)
#pragma unroll
                    for (int n = 0; n < 2; ++n) acc[a][b][m][n] = (f32x4){0.f, 0.f, 0.f, 0.f};
        cur = nxt; cA = nA; cB = nB; ++ui;
        if constexpr (ALIGN_EPI) { if (wr == 1) PG8_BAR; }
    }
    PG8_WAIT_V(0);
    if constexpr (!ALIGN_EPI) { if (wr == 0) PG8_BAR; }
    PG8_BAR;
#undef PG8_SA
#undef PG8_SB
#undef PG8_STAGE
#undef PG8_STAGEA
#undef PG8_SETVOFF
#undef PG8_LDA
#undef PG8_LDB
#undef PG8_MMA
#undef PG8_WAIT_V
#undef PG8_WAIT_L
#undef PG8_BAR
#undef PG8_SCHED
}
}
#include <hip/hip_bf16.h>
#include <cmath>
namespace attn_body {
using bf16=__hip_bfloat16;
using bf16x8=__attribute__((ext_vector_type(8)))short;
using s16x4=__attribute__((ext_vector_type(4)))short;
using f32x16=__attribute__((ext_vector_type(16)))float;
using u32x4=__attribute__((ext_vector_type(4)))unsigned;
constexpr int SEQ=2048,D=64,QKP=512,VP=512,OP=1024;
constexpr int NW=8,QBLK=32,QB=QBLK*NW,KVBLK=64,NQB=SEQ/QB;
constexpr int ATTN_UNIT_ROWS=QB;
__device__ __forceinline__ int crow(int r,int hi){return (r&3)+8*(r>>2)+4*hi;}
#define SBAR() __builtin_amdgcn_sched_barrier(0)
__device__ __forceinline__ void cmask(f32x16&p0,f32x16&p1,int jb,int qrel,int hi){
  const float NEG=-INFINITY; int kb=64*jb+4*hi;
  #pragma unroll
  for(int r=0;r<16;++r){int kv=kb+(r&3)+8*(r>>2); if(kv>qrel)p0[r]=NEG; if(kv+32>qrel)p1[r]=NEG;}
}

constexpr int NSLOT=3, SLOTB=8192;
constexpr int LDS_K=0, LDS_V=NSLOT*SLOTB, LDS_WS=2*NSLOT*SLOTB, LDS_OST=LDS_WS+NW*64*4, LDS_BYTES=LDS_OST+NW*4096;
constexpr float C2=0.125f*1.4426950408889634f;
__device__ __forceinline__ void glds16(const void*gsrc,unsigned lds_dst){unsigned keep;
  asm volatile("s_mov_b32 %0, m0\n\ts_mov_b32 m0, %2\n\ts_nop 0\n\tglobal_load_lds_dwordx4 %1, off\n\ts_mov_b32 m0, %0":"=&s"(keep):"v"(gsrc),"s"(lds_dst):"memory");}
__device__ __forceinline__ float max3f(float a,float b,float c){float r;asm("v_max3_f32 %0, %1, %2, %3":"=v"(r):"v"(a),"v"(b),"v"(c));return r;}
__device__ __forceinline__ float max2f(float a,float b){float r;asm("v_max_f32_e32 %0, %1, %2":"=v"(r):"v"(a),"v"(b));return r;}
__device__ __forceinline__ float fadd_s(float a,float b){float r;asm("v_add_f32_e32 %0, %1, %2":"=v"(r):"v"(a),"v"(b));return r;}
__device__ __forceinline__ float fsub_s(float a,float b){float r;asm("v_sub_f32_e32 %0, %1, %2":"=v"(r):"v"(a),"v"(b));return r;}
typedef float f32x2_t __attribute__((ext_vector_type(2))); typedef __bf16 bf16x2_t __attribute__((ext_vector_type(2)));
__device__ __forceinline__ unsigned cvtpk_s(float lo,float hi){f32x2_t v={lo,hi};bf16x2_t b=__builtin_convertvector(v,bf16x2_t);return __builtin_bit_cast(unsigned,b);}
#define WAIT_BAR(N) asm volatile("s_waitcnt vmcnt(" #N ") lgkmcnt(0)\n\ts_barrier":::"memory")

__device__ __forceinline__ void qkt(f32x16&p0,f32x16&p1,const char*Kslot,const bf16x8*qr,const f32x16&negm,int r32,int hi){
  const char*kb=Kslot+hi*1024+r32*16;
  #pragma unroll
  for(int d0=0;d0<4;++d0){
    const bf16x8 b0=*reinterpret_cast<const bf16x8*>(kb+d0*2048);
    const bf16x8 b1=*reinterpret_cast<const bf16x8*>(kb+d0*2048+512);
    if(d0==0){p0=__builtin_amdgcn_mfma_f32_32x32x16_bf16(b0,qr[0],negm,0,0,0);p1=__builtin_amdgcn_mfma_f32_32x32x16_bf16(b1,qr[0],negm,0,0,0);}
    else{p0=__builtin_amdgcn_mfma_f32_32x32x16_bf16(b0,qr[d0],p0,0,0,0);p1=__builtin_amdgcn_mfma_f32_32x32x16_bf16(b1,qr[d0],p1,0,0,0);}}
}
typedef __attribute__((address_space(3))) const char* lds_cptr;
typedef short v4i16_t __attribute__((ext_vector_type(4)));
__device__ __forceinline__ void kload8(bf16x8*kf,lds_cptr kp){
  kf[0]=*(const __attribute__((address_space(3))) bf16x8*)(kp);      kf[1]=*(const __attribute__((address_space(3))) bf16x8*)(kp+512);
  kf[2]=*(const __attribute__((address_space(3))) bf16x8*)(kp+2048); kf[3]=*(const __attribute__((address_space(3))) bf16x8*)(kp+2560);
  kf[4]=*(const __attribute__((address_space(3))) bf16x8*)(kp+4096); kf[5]=*(const __attribute__((address_space(3))) bf16x8*)(kp+4608);
  kf[6]=*(const __attribute__((address_space(3))) bf16x8*)(kp+6144); kf[7]=*(const __attribute__((address_space(3))) bf16x8*)(kp+6656);
}
__device__ __forceinline__ void kload2(bf16x8*kf,lds_cptr kp,int j){ kf[2*j]=*(const __attribute__((address_space(3))) bf16x8*)(kp+j*2048); kf[2*j+1]=*(const __attribute__((address_space(3))) bf16x8*)(kp+j*2048+512); }
__device__ __forceinline__ s16x4 vtr(lds_cptr p){ return __builtin_bit_cast(s16x4,__builtin_amdgcn_ds_read_tr16_b64_v4i16((__attribute__((address_space(3))) v4i16_t*)p)); }
__device__ __forceinline__ float rowmax(const f32x16&p0,const f32x16&p1){
  float a=max3f(p0[0],p0[1],p1[0]),b=max3f(p0[2],p0[3],p1[1]);a=max3f(a,p1[2],p1[3]);
  #pragma unroll
  for(int r=4;r<16;r+=4){a=max3f(a,p0[r],p0[r+1]);b=max3f(b,p0[r+2],p0[r+3]);a=max3f(a,p1[r],p1[r+1]);b=max3f(b,p1[r+2],p1[r+3]);}
  const float m=max2f(a,b);
  auto rr=__builtin_amdgcn_permlane32_swap(__float_as_uint(m),__float_as_uint(m),false,false);
  return max2f(__uint_as_float(rr[0]),__uint_as_float(rr[1]));
}
__device__ __forceinline__ void pv(f32x16*o,int vb,bf16x8 pa0,bf16x8 pa1,bf16x8 pa2,bf16x8 pa3){
  #pragma unroll
  for(int d0=0;d0<2;++d0){s16x4 lo[4],hi[4];
    #pragma unroll
    for(int ks=0;ks<4;++ks){
      asm volatile("ds_read_b64_tr_b16 %0,%1 offset:%c2":"=&v"(lo[ks]):"v"(vb),"i"(d0*4096+ks*1024):"memory");
      asm volatile("ds_read_b64_tr_b16 %0,%1 offset:%c2":"=&v"(hi[ks]):"v"(vb),"i"(d0*4096+ks*1024+512):"memory");}
    asm volatile("s_waitcnt lgkmcnt(0)":::"memory");SBAR();
    #define PK(k) (bf16x8){lo[k][0],lo[k][1],lo[k][2],lo[k][3],hi[k][0],hi[k][1],hi[k][2],hi[k][3]}
    o[d0]=__builtin_amdgcn_mfma_f32_32x32x16_bf16(pa0,PK(0),o[d0],0,0,0);
    o[d0]=__builtin_amdgcn_mfma_f32_32x32x16_bf16(pa1,PK(1),o[d0],0,0,0);
    o[d0]=__builtin_amdgcn_mfma_f32_32x32x16_bf16(pa2,PK(2),o[d0],0,0,0);
    o[d0]=__builtin_amdgcn_mfma_f32_32x32x16_bf16(pa3,PK(3),o[d0],0,0,0);
    #undef PK
  }
}

#ifndef ATTN_STORE16
#define ATTN_STORE16(p,v) (*(u32x4*)(p)=(v))
#endif
template<int THRL> __device__ __forceinline__ void attn_unit(int b,int qcol,int vcol,int ocol,int qb,const bf16*Q,const bf16*__restrict__ K,const bf16*__restrict__ V,bf16*O,char*shm){
  const int tid=threadIdx.x,lane=tid&63,r32=lane&31,hi=lane>>5; const int wid=__builtin_amdgcn_readfirstlane(tid>>6);
  const long rowbase=(long)b*SEQ; const int q0=qb*QB;
  const bf16*Qw=Q+(rowbase+q0+wid*QBLK)*QKP+qcol;
  const bf16*Kh=K+rowbase*QKP+qcol,*Vh=V+rowbase*VP+vcol;
  const unsigned lds0=(unsigned)(uintptr_t)shm;
  float*wsf=(float*)(shm+LDS_WS)+wid*64;
  const bf16*ksrc=Kh+(long)lane*QKP+wid*8;
  const bf16*vsrc=Vh+(long)(16*(wid&3)+(lane>>2))*VP+(wid>>2)*32+(lane&3)*8;
  const unsigned kdst=lds0+LDS_K+wid*1024, vdst=lds0+LDS_V+wid*1024;
  #define DMA_K(t,slot) glds16(ksrc+(long)(t)*KVBLK*QKP,(unsigned)__builtin_amdgcn_readfirstlane(kdst+(slot)))
  #define DMA_V(t,slot) glds16(vsrc+(long)(t)*KVBLK*VP,(unsigned)__builtin_amdgcn_readfirstlane(vdst+(slot)))
  const int vb0=(int)(lds0+LDS_V)+((lane>>4)&1)*32+(lane&3)*8+(4*hi+((lane&15)>>2))*64;
  const char*Kbase=shm+LDS_K; bf16x8 kf[8];
  const lds_cptr shm3=(lds_cptr)shm; const lds_cptr kp0=shm3+LDS_K+hi*1024+r32*16; const lds_cptr vp0=shm3+LDS_V+((lane>>4)&1)*32+(lane&3)*8+(4*hi+((lane&15)>>2))*64;
  const int NT=(q0+QB)/KVBLK;
  DMA_K(0,0);DMA_V(0,0);DMA_K(1,SLOTB);
  bf16x8 qr[4];
  #pragma unroll
  for(int d0=0;d0<4;++d0)qr[d0]=*reinterpret_cast<const bf16x8*>(&Qw[(long)r32*QKP+d0*16+hi*8]);
  float mhat=0.f,l_reg=0.f;f32x16 o[2];o[0]=f32x16{};o[1]=f32x16{};f32x16 negm=f32x16{};asm volatile("":"+v"(negm));
  const int qrel=wid*QBLK+r32;
  #define CMASK(P0,P1,t) do{int jb_=(t)-(NT-4); if(jb_>=0)cmask(P0,P1,jb_,qrel,hi);}while(0)
  bool resc=false;
  #define START(P0,P1) do{ const float rm=rowmax(P0,P1); resc=false; \
    { const float dl=rm; mhat=fadd_s(mhat,dl); \
      _Pragma("unroll") for(int r=0;r<16;++r){P0[r]=fsub_s(P0[r],dl);P1[r]=fsub_s(P1[r],dl);} \
      _Pragma("unroll") for(int r=0;r<16;++r)negm[r]=-mhat; asm volatile("":"+v"(negm)); } \
    _Pragma("unroll") for(int r=0;r<16;++r)P0[r]=__builtin_amdgcn_exp2f(P0[r]); }while(0)
  #define RESC() do{ if(resc){ asm volatile("s_waitcnt lgkmcnt(0)":::"memory"); \
      _Pragma("unroll") for(int d_=0;d_<2;++d_) _Pragma("unroll") for(int r=0;r<16;++r)o[d_][r]*=wsf[crow(r,hi)]; } }while(0)
  f32x16 pA0,pA1,pB0,pB1;
  int sl_prev=0,sl_cur=0,sl_next=SLOTB;
  #define ROT() do{sl_prev=sl_cur;sl_cur=sl_next;sl_next=(sl_next==(NSLOT-1)*SLOTB)?0:sl_next+SLOTB;}while(0)
  DMA_K(2,2*SLOTB);
  WAIT_BAR(3);
  qkt(pA0,pA1,Kbase,qr,negm,r32,hi);asm volatile("s_nop 15\n\ts_nop 7":"+v"(pA0),"+v"(pA1));CMASK(pA0,pA1,0);
  START(pA0,pA1);
  _Pragma("unroll") for(int r=0;r<16;++r)pA1[r]=__builtin_amdgcn_exp2f(pA1[r]);
  WAIT_BAR(0);
  DMA_K(3,0);DMA_V(1,SLOTB);
  ROT();
  kload8(kf,kp0+sl_cur);
  WAIT_BAR(2);
  s16x4 vlo[8],vhi[8]; u32x4 pw0,pw1,pw2,pw3;
  #define PKW(P,B) cvtpk_s(P[B],P[B+1])
  #define PAF(k) __builtin_bit_cast(bf16x8,pw##k)
  #define VFR(i) (bf16x8){vlo[i][0],vlo[i][1],vlo[i][2],vlo[i][3],vhi[i][0],vhi[i][1],vhi[i][2],vhi[i][3]}
  #define PIN(x) asm volatile("":"+v"(x))
  #define MX3(a,b,c) __builtin_fmaxf(__builtin_fmaxf((a),(b)),(c))
  #define GAPA(MF,A0,A1,A2,A3,W0,W1,PW) do{ MF; sacc+=A0; sacc+=A1; sacc+=A2; sacc+=A3; PIN(sacc); W0; W1; PIN(PW); SBAR(); }while(0)
  #define EX(v) __builtin_amdgcn_exp2f(v)
  #define GAPB(MF,X,B) do{ MF; X[B]=EX(X[B]); X[B+1]=EX(X[B+1]); X[B+2]=EX(X[B+2]); X[B+3]=EX(X[B+3]); PIN(X); SBAR(); }while(0)
  #define VRD(i) do{ vlo[i]=vtr(vp_+(((i)>>2)*4096+((i)&3)*1024)); vhi[i]=vtr(vp_+(((i)>>2)*4096+((i)&3)*1024+512)); }while(0)
  #define KRD(G,j) do{ if(G){ kload2(kf,kp0+sl_next,j); SBAR(); } }while(0)
  #define STEP(C0,C1,P0,P1,t,GK,GV,GL) do{ SBAR(); \
    const lds_cptr vp_=vp0+sl_prev; \
    VRD(0); SBAR(); float sacc=(P0[0]+P0[1]); \
    GAPA(C0=__builtin_amdgcn_mfma_f32_32x32x16_bf16(kf[0],qr[0],negm,0,0,0), P0[2],P0[3],P0[4],P0[5],     pw0[0]=PKW(P0,0), pw0[1]=PKW(P0,2), pw0); \
    VRD(4); SBAR(); GAPA(C1=__builtin_amdgcn_mfma_f32_32x32x16_bf16(kf[1],qr[0],negm,0,0,0), P0[6],P0[7],P0[8],P0[9],     pw0[2]=PKW(P0,4), pw0[3]=PKW(P0,6), pw0); \
    VRD(1); SBAR(); GAPA(C0=__builtin_amdgcn_mfma_f32_32x32x16_bf16(kf[2],qr[1],C0,0,0,0),   P0[10],P0[11],P0[12],P0[13], pw1[0]=PKW(P0,8), pw1[1]=PKW(P0,10), pw1); \
    VRD(5); SBAR(); GAPA(C1=__builtin_amdgcn_mfma_f32_32x32x16_bf16(kf[3],qr[1],C1,0,0,0),   P0[14],P0[15],P1[0],P1[1],   pw1[2]=PKW(P0,12),pw1[3]=PKW(P0,14), pw1); \
    VRD(2); SBAR(); GAPA(C0=__builtin_amdgcn_mfma_f32_32x32x16_bf16(kf[4],qr[2],C0,0,0,0),   P1[2],P1[3],P1[4],P1[5],     pw2[0]=PKW(P1,0), pw2[1]=PKW(P1,2), pw2); \
    VRD(6); SBAR(); GAPA(C1=__builtin_amdgcn_mfma_f32_32x32x16_bf16(kf[5],qr[2],C1,0,0,0),   P1[6],P1[7],P1[8],P1[9],     pw2[2]=PKW(P1,4), pw2[3]=PKW(P1,6), pw2); \
    VRD(3); SBAR(); GAPA(C0=__builtin_amdgcn_mfma_f32_32x32x16_bf16(kf[6],qr[3],C0,0,0,0),   P1[10],P1[11],P1[12],P1[13], pw3[0]=PKW(P1,8), pw3[1]=PKW(P1,10), pw3); \
    VRD(7); SBAR(); GAPA(C1=__builtin_amdgcn_mfma_f32_32x32x16_bf16(kf[7],qr[3],C1,0,0,0),   P1[14],P1[15],0.f,0.f,       pw3[2]=PKW(P1,12),pw3[3]=PKW(P1,14), pw3); \
    l_reg+=sacc; \
    if(GK){DMA_K((t)+3,sl_cur);} if(GV){DMA_V((t)+1,sl_next);} \
    CMASK(C0,C1,t); \
    { float a=MX3(C0[0],C0[1],C1[0]),b=MX3(C0[2],C0[3],C1[1]); a=MX3(a,C1[2],C1[3]); \
      _Pragma("unroll") for(int r=4;r<16;r+=4){a=MX3(a,C0[r],C0[r+1]);b=MX3(b,C0[r+2],C0[r+3]);a=MX3(a,C1[r],C1[r+1]);b=MX3(b,C1[r+2],C1[r+3]);} \
      float rm=__builtin_fmaxf(a,b); { auto rr=__builtin_amdgcn_permlane32_swap(__float_as_uint(rm),__float_as_uint(rm),false,false); rm=__builtin_fmaxf(__uint_as_float(rr[0]),__uint_as_float(rr[1])); } \
      resc=false; \
      if(__builtin_expect(__any(rm>(float)THRL),0)){ const float dl=__builtin_fmaxf(rm,0.f); mhat+=dl; \
        _Pragma("unroll") for(int r=0;r<16;++r){C0[r]-=dl;C1[r]-=dl;} \
        _Pragma("unroll") for(int r=0;r<16;++r)negm[r]=-mhat; asm volatile("":"+v"(negm)); \
        const float f=__builtin_amdgcn_exp2f(-dl); l_reg*=f; if(hi==0)wsf[r32]=f; resc=true; } } \
    SBAR(); \
    GAPB(o[0]=__builtin_amdgcn_mfma_f32_32x32x16_bf16(PAF(0),VFR(0),o[0],0,0,0), C0,0); \
    GAPB(o[1]=__builtin_amdgcn_mfma_f32_32x32x16_bf16(PAF(0),VFR(4),o[1],0,0,0), C0,4); \
    KRD(GL,0); GAPB(o[0]=__builtin_amdgcn_mfma_f32_32x32x16_bf16(PAF(1),VFR(1),o[0],0,0,0), C0,8); \
    KRD(GL,1); GAPB(o[1]=__builtin_amdgcn_mfma_f32_32x32x16_bf16(PAF(1),VFR(5),o[1],0,0,0), C0,12); \
    KRD(GL,2); GAPB(o[0]=__builtin_amdgcn_mfma_f32_32x32x16_bf16(PAF(2),VFR(2),o[0],0,0,0), C1,0); \
    KRD(GL,3); GAPB(o[1]=__builtin_amdgcn_mfma_f32_32x32x16_bf16(PAF(2),VFR(6),o[1],0,0,0), C1,4); \
    GAPB(o[0]=__builtin_amdgcn_mfma_f32_32x32x16_bf16(PAF(3),VFR(3),o[0],0,0,0), C1,8); \
    GAPB(o[1]=__builtin_amdgcn_mfma_f32_32x32x16_bf16(PAF(3),VFR(7),o[1],0,0,0), C1,12); \
    }while(0)
  int t=1;
  #undef CMASK
  #define CMASK(P0,P1,t) do{}while(0)
  for(;t+5<NT;t+=2){
    STEP(pB0,pB1,pA0,pA1,t,true,true,true);     WAIT_BAR(2); RESC(); ROT();
    STEP(pA0,pA1,pB0,pB1,t+1,true,true,true);   WAIT_BAR(2); RESC(); ROT();
  }
  #undef CMASK
  #define CMASK(P0,P1,t) do{int jb_=(t)-(NT-4); if(jb_>=0)cmask(P0,P1,jb_,qrel,hi);}while(0)
  #define ENDW(tt) do{ if((tt)+3<NT){WAIT_BAR(2);} else if((tt)+2<NT){WAIT_BAR(1);} else {WAIT_BAR(0);} }while(0)
  for(;t+1<NT;t+=2){
    STEP(pB0,pB1,pA0,pA1,t,(t+3<NT),(t+1<NT),(t+1<NT));       ENDW(t);   RESC(); ROT();
    STEP(pA0,pA1,pB0,pB1,t+1,(t+4<NT),(t+2<NT),(t+2<NT));     ENDW(t+1); RESC(); ROT();
  }
  STEP(pB0,pB1,pA0,pA1,NT-1,false,false,false); RESC();
  { float sacc=pB0[0]+pB0[1]; _Pragma("unroll") for(int r=2;r<16;++r)sacc+=pB0[r]; _Pragma("unroll") for(int r=0;r<16;++r)sacc+=pB1[r]; l_reg+=sacc;
    pw0=(u32x4){PKW(pB0,0),PKW(pB0,2),PKW(pB0,4),PKW(pB0,6)};pw1=(u32x4){PKW(pB0,8),PKW(pB0,10),PKW(pB0,12),PKW(pB0,14)};pw2=(u32x4){PKW(pB1,0),PKW(pB1,2),PKW(pB1,4),PKW(pB1,6)};pw3=(u32x4){PKW(pB1,8),PKW(pB1,10),PKW(pB1,12),PKW(pB1,14)};
    SBAR(); pv(o,vb0+sl_cur,PAF(0),PAF(1),PAF(2),PAF(3)); }
  #undef PKW
  #undef PAF
  #undef VFR
  #undef PIN
  #undef MX3
  #undef GAPA
  #undef GAPB
  #undef EX
  #undef VRD
  #undef KRD
  #undef STEP
  #undef ENDW
  {auto rr=__builtin_amdgcn_permlane32_swap(__float_as_uint(l_reg),__float_as_uint(l_reg),false,false);l_reg=__uint_as_float(rr[0])+__uint_as_float(rr[1]);}
  if(hi==0)wsf[32+r32]=l_reg;asm volatile("s_waitcnt lgkmcnt(0)":::"memory");
  float rli[16];
  #pragma unroll
  for(int r=0;r<16;++r)rli[r]=__builtin_amdgcn_rcpf(wsf[32+crow(r,hi)]);
  bf16*Ow=O+(rowbase+q0+wid*QBLK)*OP+ocol;
  { bf16*stg=(bf16*)(shm+LDS_OST)+wid*2048;
    #pragma unroll
    for(int r=0;r<16;++r){const int orow=crow(r,hi);
      #pragma unroll
      for(int d0=0;d0<2;++d0)stg[orow*64+d0*32+r32]=__float2bfloat16(o[d0][r]*rli[r]);}
    asm volatile("s_waitcnt lgkmcnt(0)":::"memory");
    #pragma unroll
    for(int i=0;i<4;++i){const int row=i*8+(lane>>3),ch=lane&7; const u32x4 v=*(const u32x4*)(stg+row*64+ch*8); ATTN_STORE16(Ow+(long)row*OP+ch*8,v);} }
  asm volatile("s_waitcnt lgkmcnt(0)\n\ts_barrier":::"memory");
  #undef DMA_K
  #undef DMA_V
  #undef CMASK
  #undef START
  #undef RESC
  #undef ROT
}
constexpr int ATTN_LDS_BYTES=LDS_BYTES;
#undef SBAR
#undef WAIT_BAR
}

#define GAS __attribute__((address_space(1)))
#define LAS __attribute__((address_space(3)))
typedef unsigned short bf16;
typedef unsigned v4u __attribute__((ext_vector_type(4)));
typedef float f32x4 __attribute__((ext_vector_type(4)));
typedef short bf16x8 __attribute__((ext_vector_type(8)));
typedef GAS unsigned gu32;
typedef GAS unsigned long long gu64;
#define RLX_AGENT __ATOMIC_RELAXED, __HIP_MEMORY_SCOPE_AGENT
#define LDS_WAIT() asm volatile("s_waitcnt lgkmcnt(0)" ::: "memory")
#define VM_WAIT() asm volatile("s_waitcnt vmcnt(0)" ::: "memory")
__device__ __forceinline__ unsigned long long rt() { return __builtin_amdgcn_s_memrealtime(); }
__device__ __forceinline__ unsigned f2bf(float f) { unsigned u = __builtin_bit_cast(unsigned, f); return (u + 0x7fffu + ((u >> 16) & 1u)) >> 16; }
__device__ __forceinline__ unsigned pk2(float lo, float hi) { return f2bf(lo) | (f2bf(hi) << 16); }

#define XB_TMO      128
#define XB_XCNT(j)  (256  + 64 * (j))
#define XB_XSUB(j)  (1280 + 64 * (j))
#define XB_XGEN(j)  (2304 + 64 * (j))
#define XB_TOP      3328
#define XB_TOPGEN   3392
#define XCD_BAR_WORDS 3456
#define XB_SPIN_CAP (1u << 18)

__device__ __forceinline__ unsigned xb_ld(unsigned* p)              { return __hip_atomic_load(p, __ATOMIC_RELAXED, __HIP_MEMORY_SCOPE_AGENT); }
__device__ __forceinline__ unsigned xb_add(unsigned* p, unsigned v) { return __hip_atomic_fetch_add(p, v, __ATOMIC_RELAXED, __HIP_MEMORY_SCOPE_AGENT); }
__device__ __forceinline__ unsigned xb_xcc_id() { return (unsigned)__builtin_amdgcn_s_getreg((3 << 11) | 20) & 0xFu; }
#define XB_SPIN(cond, bar) do { unsigned _sp = 0; while (cond) { __builtin_amdgcn_s_sleep(1); \
    if ((++_sp & 255u) == 0u) { if (xb_ld(&(bar)[XB_TMO])) break; if (_sp > XB_SPIN_CAP) { atomicAdd(&(bar)[XB_TMO], 1u); break; } } } } while (0)

struct XcdBarrier {
    unsigned* bar; unsigned x;
    volatile LAS unsigned* st;
};

__device__ __forceinline__ XcdBarrier xcd_barrier_post(unsigned* bar, volatile LAS unsigned* st) {
    XcdBarrier b; b.bar = bar; b.x = xb_xcc_id(); b.st = st;
    if (threadIdx.x == 0) (void)xb_add(&bar[XB_XCNT(b.x)], 1u);
    return b;
}
__device__ __forceinline__ void xcd_barrier_complete(unsigned* bar, unsigned x, unsigned& nloc, unsigned& nx) {
    const unsigned G = gridDim.x * gridDim.y * gridDim.z;
    unsigned sum, cnt, mine, sp = 0u;
    for (;;) {
        sum = 0u; cnt = 0u; mine = 0u;
#pragma unroll
        for (unsigned j = 0; j < 16; ++j) { const unsigned c = xb_ld(&bar[XB_XCNT(j)]); sum += c; cnt += (c > 0u) ? 1u : 0u; mine = (j == x) ? c : mine; }
        if (sum == G) break;
        __builtin_amdgcn_s_sleep(1);
        if ((++sp & 255u) == 0u) { if (xb_ld(&bar[XB_TMO])) break; if (sp > XB_SPIN_CAP) { atomicAdd(&bar[XB_TMO], 1u); break; } }
    }
    nloc = mine > 0u ? mine : 1u; nx = cnt > 0u ? cnt : 1u;
}

__device__ __forceinline__ void xcd_barrier(const XcdBarrier& b) {
    asm volatile("s_waitcnt vmcnt(0)" ::: "memory");
    __syncthreads();
    if (threadIdx.x == 0) {
        unsigned* bar = b.bar;
        __builtin_amdgcn_s_waitcnt(0);
        unsigned nloc = b.st[0], nx = b.st[1];
        if (nloc == 0u) { xcd_barrier_complete(bar, b.x, nloc, nx); b.st[0] = nloc; b.st[1] = nx; }
        const unsigned old = xb_add(&bar[XB_XSUB(b.x)], 1u);
        const unsigned gen = old / nloc;
        if (old + 1u == (gen + 1u) * nloc) {
            __builtin_amdgcn_fence(__ATOMIC_RELEASE, "agent");
            asm volatile("s_waitcnt vmcnt(0)" ::: "memory");
            const unsigned og = xb_add(&bar[XB_TOP], 1u);
            const unsigned tg = og / nx;
            if (og + 1u == (tg + 1u) * nx) xb_add(&bar[XB_TOPGEN], 1u);
            else XB_SPIN(xb_ld(&bar[XB_TOPGEN]) == tg, bar);
            __builtin_amdgcn_fence(__ATOMIC_ACQUIRE, "agent");
            xb_add(&bar[XB_XGEN(b.x)], 1u);
            asm volatile("s_waitcnt vmcnt(0)" ::: "memory");
        } else {
            XB_SPIN(xb_ld(&bar[XB_XGEN(b.x)]) == gen, bar);
            __builtin_amdgcn_fence(__ATOMIC_ACQUIRE, "agent");
            asm volatile("s_waitcnt vmcnt(0)" ::: "memory");
        }
    }
    __syncthreads();
}

constexpr int NWAVES = 8;
constexpr int D = 1024, NB = 8, SEQ = 2048, M = NB * SEQ, NPROJ = 3584, NE = 32, FF = 512, NCH = SEQ / 64, NMOD = 6 * D;
constexpr int LCAP = 16384;
constexpr float RMS_EPS = 1e-6f, SUBLN_EPS = 1e-5f, LAMBDA_INIT = 0.2f;
#ifndef MK_N_LAUNCHES
#define MK_N_LAUNCHES 1
#endif
constexpr int NPH = 11;
constexpr size_t MiB = 1u << 20;
constexpr size_t WS_CTL = 0, CTL_ZERO_BYTES = 1 * MiB;
constexpr size_t WS_MOD = 1 * MiB;
constexpr size_t WS_RT = 1 * MiB + 256 * 1024;
constexpr size_t WS_EL = 1 * MiB + 512 * 1024;
constexpr size_t WS_ELIST = 2 * MiB, WS_WLIST = 4 * MiB;
constexpr size_t WS_WIN = 6 * MiB;
constexpr size_t WS_WOUT = 13 * MiB;
constexpr size_t WS_WGU = 16 * MiB;
constexpr size_t WS_UST = 16 * MiB;
constexpr size_t WS_WD = 80 * MiB;
constexpr size_t WS_MIXED = 80 * MiB;
constexpr size_t WS_RA = 112 * MiB;
constexpr size_t WS_Q = 144 * MiB, WS_K = 160 * MiB, WS_V = 176 * MiB, WS_QP = 192 * MiB, WS_KP = 208 * MiB, WS_VI = 224 * MiB, WS_SG = 240 * MiB;
constexpr size_t WS_PART = 144 * MiB;
constexpr size_t WS_HID = 208 * MiB;
constexpr size_t WS_END = 256 * MiB;
constexpr int CW_BAR = 4096;
constexpr int CW_CNT = 8192;
constexpr int RING_BYTES = 131072;
constexpr int LDSCTL_OFF = 147456;
constexpr int MISC_OFF = LDSCTL_OFF + 320;
constexpr int SCHED_OFF = LDSCTL_OFF + 1024;
constexpr int LDS_BYTES = 163840;

typedef unsigned u32x2v __attribute__((ext_vector_type(2)));
__device__ __forceinline__ float dpp_row_shr(float v, int n) {
    const int iv = __builtin_bit_cast(int, v); int r;
    switch (n) { case 1: r = __builtin_amdgcn_update_dpp(0, iv, 0x111, 0xf, 0xf, true); break; case 2: r = __builtin_amdgcn_update_dpp(0, iv, 0x112, 0xf, 0xf, true); break;
                 case 4: r = __builtin_amdgcn_update_dpp(0, iv, 0x114, 0xf, 0xf, true); break; default: r = __builtin_amdgcn_update_dpp(0, iv, 0x118, 0xf, 0xf, true); break; }
    return __builtin_bit_cast(float, r);
}
__device__ __forceinline__ float wave_sum(float v) {
    v += dpp_row_shr(v, 1); v += dpp_row_shr(v, 2); v += dpp_row_shr(v, 4); v += dpp_row_shr(v, 8);
    v += __builtin_bit_cast(float, __builtin_amdgcn_update_dpp(0, __builtin_bit_cast(int, v), 0x142, 0xa, 0xf, false));
    v += __builtin_bit_cast(float, __builtin_amdgcn_update_dpp(0, __builtin_bit_cast(int, v), 0x143, 0xc, 0xf, false));
    return __builtin_bit_cast(float, __builtin_amdgcn_readlane(__builtin_bit_cast(int, v), 63));
}
__device__ __forceinline__ float bf_lo(unsigned w) { return __uint_as_float(w << 16); }
__device__ __forceinline__ float bf_hi(unsigned w) { return __uint_as_float(w & 0xffff0000u); }
__device__ __forceinline__ float sigmoidf_(float x) { return 1.f / (1.f + __expf(-x)); }

struct Args { const float* in[24]; float* out; unsigned char* ws; int ph_lo, ph_hi; };

struct DenseOrder {
    int nM, nN, nwg, G, c; const char* Abase; const char* Bbase; size_t tstep; int pn_off, pn_cut, pn_shift;
    __device__ __forceinline__ void init(int M_, int N_, int K_, int G_, int c_, const void* A_, const void* B_, int off_ = 0, int cut_ = 1 << 30, int shift_ = 0) { nM = M_ / 256; nN = N_ / 256; nwg = nM * nN; G = G_; c = c_; Abase = (const char*)A_; Bbase = (const char*)B_; tstep = (size_t)256 * K_ * 2; pn_off = off_; pn_cut = cut_; pn_shift = shift_; }
    __device__ __forceinline__ bool next(int i, pg8::Unit& u) const {
        const long L = (long)i * G + c; if (L >= nwg) return false;
        int wgid = (int)L; { const int q = nwg / 8, r = nwg % 8, xcd = wgid % 8, off = wgid / 8; wgid = (xcd < r ? xcd * (q + 1) : r * (q + 1) + (xcd - r) * q) + off; }
        const int nig = 8 * nN, gid = wgid / nig, fm = gid * 8, gsz = (nM - fm) < 8 ? (nM - fm) : 8;
        u.pm = fm + ((wgid % nig) % gsz); { const int idx = (wgid % nig) / gsz; u.pn = idx + pn_off + (idx >= pn_cut ? pn_shift : 0); }
        u.A = Abase + (size_t)u.pm * tstep; u.B = Bbase + (size_t)u.pn * tstep; u.gidx = nullptr; u.rows = 256; u.e = 0; u.base = 0; return true;
    }
};
struct MoeOrder {
    const LAS int* tab; int G, c; int down; const char* Abase; const char* Bbase; const int* elist;
    __device__ __forceinline__ bool next(int i, pg8::Unit& u) const {
#ifndef MOE_REP
#define MOE_REP 1
#endif
        int L = i * G + c; const int T = tab[32];
        if (L >= T * 4 * MOE_REP) return false;
        if (MOE_REP > 1 && L >= T * 4) L -= T * 4;
        const int tile = L >> 2, sub = L & 3; int e = 0;
#pragma unroll 1
        for (int j = 1; j < 32; ++j) e = (tab[j] <= tile) ? j : e;
        const int rt = tile - tab[e], cnt = tab[66 + e], rb = tab[33 + e] + 256 * rt;
        u.pm = rt; u.pn = sub; u.e = e; u.base = rb; u.rows = (cnt - 256 * rt) < 256 ? (cnt - 256 * rt) : 256; u.gidx = elist + e * LCAP + 256 * rt;
        if (down) { u.A = Abase + (size_t)rb * (FF * 2); u.B = Bbase + ((size_t)e * 1024 + 256 * sub) * (FF * 2); }
        else      { u.A = Abase;                          u.B = Bbase + ((size_t)(e * 4 + sub) * 256) * (D * 2); }
        return true;
    }
};
__device__ __forceinline__ void sched_tables(LAS int* tab, gu32* cntw, int tid) {
    if (tid == 0) { int ts = 0, rb = 0;
        for (int e = 0; e < 32; ++e) { int cn = (int)__hip_atomic_load(cntw + 64 * e, RLX_AGENT); cn = cn > LCAP ? LCAP : cn; tab[e] = ts; tab[33 + e] = rb; tab[66 + e] = cn; ts += (cn + 255) >> 8; rb += cn; }
        tab[32] = ts; tab[65] = rb; }
    __syncthreads();
}

using pg8::u32x4; using pg8::cvt_pk_bf16;
__device__ __forceinline__ float silu_(float v) { return v / (1.f + __expf(-v)); }
constexpr float QSCALE = 0.125f * 1.4426950408889634f;
template <int EMASK> struct EpiInProj {
    bf16* R1; float* EL; const int* pos; const float* lbl;
    static constexpr size_t RSTR = (size_t)M * 512;
    __device__ __forceinline__ void operator()(f32x4 (&acc)[2][2][4][2], const pg8::Unit& u, int wr, int wc, int fr, int fq) const {
        asm volatile("" : "+v"(fr), "+v"(fq));
        const int pn = u.pn, rowb = u.pm * 256 + wr * 64 + fr;
        if ((EMASK & 1) && pn < 4) {
            const int part = pn >> 1, th = pn & 1; bf16* dst = R1 + (size_t)part * RSTR; const float qs = part ? 1.f : QSCALE;
            const int i0 = 16 * (wc & 1) + 4 * fq, dm0 = 32 * (wc & 1) + 8 * fq;
            float invf[4];
#pragma unroll
            for (int j = 0; j < 4; ++j) invf[j] = exp2f(-(float)(i0 + j) * 0.41524101186092029f);
#pragma unroll
            for (int ai = 0; ai < 2; ++ai)
#pragma unroll
                for (int m = 0; m < 4; ++m) { const int row = rowb + ai * 128 + m * 16; const float p = (float)pos[row]; float cs[4], sn[4];
#pragma unroll
                    for (int j = 0; j < 4; ++j) { float rev = p * invf[j] * 0.15915494309189535f; rev -= floorf(rev); sn[j] = __builtin_amdgcn_sinf(rev); cs[j] = __builtin_amdgcn_cosf(rev); }
#pragma unroll
                    for (int bj = 0; bj < 2; ++bj) { const int head = 4 * th + 2 * bj + (wc >> 1); const f32x4 x1 = acc[ai][bj][m][0], x2 = acc[ai][bj][m][1]; float o1[4], o2[4];
#pragma unroll
                        for (int j = 0; j < 4; ++j) { o1[j] = (x1[j] * cs[j] - x2[j] * sn[j]) * qs; o2[j] = (x2[j] * cs[j] + x1[j] * sn[j]) * qs; }
                        u32x4 w; w.x = cvt_pk_bf16(o1[0], o1[1]); w.y = cvt_pk_bf16(o1[2], o1[3]); w.z = cvt_pk_bf16(o2[0], o2[1]); w.w = cvt_pk_bf16(o2[2], o2[3]);
                        *(u32x4*)(dst + (size_t)row * 512 + head * 64 + dm0) = w; } }
        } else if ((EMASK & 2) && (pn < 6 || pn >= 10)) {
            bf16* dst = R1 + (size_t)(pn < 6 ? 2 : (pn < 12 ? 5 : 6)) * RSTR; const int cb = ((pn < 6 ? pn - 4 : (pn < 12 ? pn - 10 : pn - 12)) * 256) + wc * 32 + 8 * fq; const bool act = pn >= 12;
#pragma unroll
            for (int ai = 0; ai < 2; ++ai)
#pragma unroll
                for (int m = 0; m < 4; ++m) { const int row = rowb + ai * 128 + m * 16;
#pragma unroll
                    for (int bj = 0; bj < 2; ++bj) { f32x4 v0 = acc[ai][bj][m][0], v1 = acc[ai][bj][m][1];
                        if (act) {
#pragma unroll
                            for (int j = 0; j < 4; ++j) { v0[j] = silu_(v0[j]); v1[j] = silu_(v1[j]); } }
                        u32x4 w; w.x = cvt_pk_bf16(v0[0], v0[1]); w.y = cvt_pk_bf16(v0[2], v0[3]); w.z = cvt_pk_bf16(v1[0], v1[1]); w.w = cvt_pk_bf16(v1[2], v1[3]);
                        *(u32x4*)(dst + (size_t)row * 512 + cb + bj * 128) = w; } }
        } else if (EMASK & 4) {
            const int hh = pn - 6, k0 = wc * 32 + 8 * fq; float lb[2][4];
#pragma unroll
            for (int n = 0; n < 2; ++n)
#pragma unroll
                for (int j = 0; j < 4; ++j) { const int k = hh * 128 + k0 + 4 * n + j; lb[n][j] = 1.f / (1.f + __expf(lbl[512 + k] - lbl[k])); }
#pragma unroll
            for (int ai = 0; ai < 2; ++ai) {
#pragma unroll
                for (int m = 0; m < 4; ++m)
#pragma unroll
                    for (int n = 0; n < 2; ++n)
#pragma unroll
                        for (int j = 0; j < 4; ++j) { const float f = acc[ai][1][m][n][j]; const float t = __expf(fminf(-f, 80.f)); acc[ai][1][m][n][j] = (1.f - lb[n][j]) * (t / (1.f + t)); }
                const int chunk = u.pm * 4 + ai * 2 + wr;
#pragma unroll
                for (int n = 0; n < 2; ++n)
#pragma unroll
                    for (int j = 0; j < 4; ++j) { float carry = 0.f;
#pragma unroll
                        for (int m = 0; m < 4; ++m) { const float kin = acc[ai][1][m][n][j]; float x = __logf(1.f - kin);
#pragma unroll
                            for (int d = 1; d < 16; d <<= 1) { const float y = __shfl_up(x, d, 16); if (fr >= d) x += y; }
                            x += carry; carry = __shfl(x, 15, 16);
                            acc[ai][0][m][n][j] = silu_(acc[ai][0][m][n][j]) * __expf(x); acc[ai][1][m][n][j] = kin * __expf(-x); }
                        if (fr == 0) EL[(size_t)(chunk * 4 + hh) * 128 + k0 + 4 * n + j] = __expf(carry); }
#pragma unroll
                for (int m = 0; m < 4; ++m) { const int row = rowb + ai * 128 + m * 16; const f32x4 q0 = acc[ai][0][m][0], q1 = acc[ai][0][m][1], k0v = acc[ai][1][m][0], k1v = acc[ai][1][m][1];
                    u32x4 w; w.x = cvt_pk_bf16(q0[0], q0[1]); w.y = cvt_pk_bf16(q0[2], q0[3]); w.z = cvt_pk_bf16(q1[0], q1[1]); w.w = cvt_pk_bf16(q1[2], q1[3]);
                    *(u32x4*)(R1 + 3 * RSTR + (size_t)row * 512 + hh * 128 + k0) = w;
                    w.x = cvt_pk_bf16(k0v[0], k0v[1]); w.y = cvt_pk_bf16(k0v[2], k0v[3]); w.z = cvt_pk_bf16(k1v[0], k1v[1]); w.w = cvt_pk_bf16(k1v[2], k1v[3]);
                    *(u32x4*)(R1 + 4 * RSTR + (size_t)row * 512 + hh * 128 + k0) = w; } }
        }
    }
};
struct EpiOut {
    const float* x; const float* mod; float* out;
    __device__ __forceinline__ void operator()(f32x4 (&acc)[2][2][4][2], const pg8::Unit& u, int wr, int wc, int fr, int fq) const {
        const int rowb = u.pm * 256 + wr * 64 + fr, b = u.pm >> 3;
#pragma unroll
        for (int bj = 0; bj < 2; ++bj)
#pragma unroll
            for (int n = 0; n < 2; ++n) { const int col = u.pn * 256 + bj * 128 + wc * 32 + n * 16 + 4 * fq; const f32x4 g = *(const f32x4*)(mod + b * NMOD + 2 * D + col);
#pragma unroll
                for (int ai = 0; ai < 2; ++ai)
#pragma unroll
                    for (int m = 0; m < 4; ++m) { const size_t off = (size_t)(rowb + ai * 128 + m * 16) * D + col; *(f32x4*)(out + off) = *(const f32x4*)(x + off) + g * acc[ai][bj][m][n]; } }
    }
};
struct EpiGU {
    bf16* HID; const float* wlist;
    __device__ __forceinline__ void operator()(f32x4 (&acc)[2][2][4][2], const pg8::Unit& u, int wr, int wc, int fr, int fq) const {
        const int sb = wr * 64 + fr, cb = u.pn * 128 + wc * 32 + 8 * fq;
#pragma unroll
        for (int ai = 0; ai < 2; ++ai)
#pragma unroll
            for (int m = 0; m < 4; ++m) { const int s = sb + ai * 128 + m * 16;
                if (s < u.rows) { const float w = wlist[u.e * LCAP + u.pm * 256 + s]; const f32x4 g0 = acc[ai][0][m][0], g1 = acc[ai][0][m][1], u0 = acc[ai][1][m][0], u1 = acc[ai][1][m][1]; float h0[4], h1[4];
#pragma unroll
                    for (int j = 0; j < 4; ++j) { h0[j] = silu_(g0[j]) * u0[j] * w; h1[j] = silu_(g1[j]) * u1[j] * w; }
                    u32x4 o; o.x = cvt_pk_bf16(h0[0], h0[1]); o.y = cvt_pk_bf16(h0[2], h0[3]); o.z = cvt_pk_bf16(h1[0], h1[1]); o.w = cvt_pk_bf16(h1[2], h1[3]);
                    *(u32x4*)(HID + (size_t)(u.base + s) * FF + cb) = o; } }
    }
};
struct EpiDN {
    bf16* PART; const int* elist;
    __device__ __forceinline__ void operator()(f32x4 (&acc)[2][2][4][2], const pg8::Unit& u, int wr, int wc, int fr, int fq) const {
        const int sb = wr * 64 + fr, cb = u.pn * 256 + wc * 32 + 8 * fq;
#pragma unroll
        for (int ai = 0; ai < 2; ++ai)
#pragma unroll
            for (int m = 0; m < 4; ++m) { const int s = sb + ai * 128 + m * 16;
                if (s < u.rows) { const int ent = elist[u.e * LCAP + u.pm * 256 + s];
#pragma unroll
                    for (int bj = 0; bj < 2; ++bj) { const f32x4 v0 = acc[ai][bj][m][0], v1 = acc[ai][bj][m][1];
                        u32x4 o; o.x = cvt_pk_bf16(v0[0], v0[1]); o.y = cvt_pk_bf16(v0[2], v0[3]); o.z = cvt_pk_bf16(v1[0], v1[1]); o.w = cvt_pk_bf16(v1[2], v1[3]);
                        *(u32x4*)(PART + (size_t)ent * D + cb + bj * 128) = o; } } }
    }
};

__device__ __forceinline__ void transpose_item(const float* W, int ldw, int scol, bf16* dst_rows, int Kd, int k0, LAS float* scr, int lane) {
#pragma unroll 8
    for (int i = 0; i < 32; ++i) { const int kk = 2 * i + (lane >> 5); scr[kk * 33 + (lane & 31)] = W[(size_t)(k0 + kk) * ldw + scol]; }
    LDS_WAIT(); asm volatile("" ::: "memory");
    const int c = lane & 7;
#pragma unroll
    for (int j = 0; j < 4; ++j) { const int n = (lane >> 3) + 8 * j; const LAS float* s = scr + (8 * c) * 33 + n;
        v4u o; o.x = pk2(s[0 * 33], s[1 * 33]); o.y = pk2(s[2 * 33], s[3 * 33]); o.z = pk2(s[4 * 33], s[5 * 33]); o.w = pk2(s[6 * 33], s[7 * 33]);
        *(GAS v4u*)(dst_rows + (size_t)n * Kd + k0 + 8 * c) = o; }
    LDS_WAIT(); asm volatile("" ::: "memory");
}
__device__ __forceinline__ int plain32(int q) { return 8 * ((q >> 2) & 3) + 4 * (q >> 4) + (q & 3); }
__device__ __forceinline__ int win_col(int P) {
    const int pn = P >> 8, p = P & 255, bj = p >> 7, wc = (p >> 5) & 3, n = (p >> 4) & 1, fq = (p >> 2) & 3, j = p & 3;
    if (pn < 4) { const int part = pn >> 1, th = pn & 1, head = 4 * th + 2 * bj + (wc >> 1), d = 32 * n + 16 * (wc & 1) + 4 * fq + j; return part * 512 + head * 64 + d; }
    const int lc = 128 * bj + 32 * wc + 8 * fq + 4 * n + j;
    if (pn < 6) return 1024 + (pn - 4) * 256 + lc;
    if (pn < 10) { const int hh = pn - 6, kk = 32 * wc + 8 * fq + 4 * n + j; return (bj ? 2048 : 1536) + hh * 128 + kk; }
    if (pn < 12) return 2560 + (pn - 10) * 256 + lc;
    return 3072 + (pn - 12) * 256 + lc;
}

struct Ctx { LAS unsigned char* lds; unsigned char* ws; int vcu, G; };
#define PHASE_IDS const int tid_ = threadIdx.x, lane_ = tid_ & 63, wave_ = __builtin_amdgcn_readfirstlane(tid_ >> 6)

__device__ __forceinline__ void phase0(const Args& a, const Ctx& X) {
    PHASE_IDS;
    const float* c = a.in[1]; const float* w_ada = a.in[3]; const float* b_ada = a.in[4];
    LAS float* cs = (LAS float*)X.lds;
    LAS float* part = (LAS float*)(X.lds + 32768);
    float* mod = (float*)(X.ws + WS_MOD);
    if (X.vcu < 192) {
        for (int i = tid_; i < 8192; i += 512) cs[i] = silu_(c[i]);
        __syncthreads();
        for (int item = X.vcu; item < 192; item += X.G) {
            const int n0 = 32 * item, krow = lane_ >> 3, c4 = lane_ & 7; f32x4 acc[8];
#pragma unroll
            for (int b = 0; b < 8; ++b) acc[b] = (f32x4){0.f, 0.f, 0.f, 0.f};
#pragma unroll 4
            for (int it = 0; it < 16; ++it) { const int k = 128 * wave_ + 8 * it + krow; const f32x4 wv = *(const f32x4*)(w_ada + (size_t)k * NMOD + n0 + 4 * c4);
#pragma unroll
                for (int b = 0; b < 8; ++b) acc[b] += wv * cs[b * 1024 + k]; }
#pragma unroll
            for (int b = 0; b < 8; ++b)
#pragma unroll
                for (int j = 0; j < 4; ++j) { float v = acc[b][j]; v += __shfl_xor(v, 8); v += __shfl_xor(v, 16); v += __shfl_xor(v, 32); acc[b][j] = v; }
            if (lane_ < 8) {
#pragma unroll
                for (int b = 0; b < 8; ++b) *(LAS f32x4*)(part + (wave_ * 8 + b) * 32 + 4 * c4) = acc[b]; }
            __syncthreads();
            if (tid_ < 256) { const int b = tid_ >> 5, col = tid_ & 31; float s = b_ada[n0 + col];
#pragma unroll
                for (int w = 0; w < 8; ++w) s += part[(w * 8 + b) * 32 + col];
                mod[b * NMOD + n0 + col] = s; }
            __syncthreads();
        }
    }
    LAS float* scr = (LAS float*)(X.lds + 65536 + wave_ * 8448);
    const int gw = X.vcu * NWAVES + wave_, NGW = X.G * NWAVES;
    constexpr int I_IN = (NPROJ / 32) * 16, I_OUT = (D / 32) * 16;
    for (int it = gw; it < I_IN + I_OUT; it += NGW) {
        if (it < I_IN) { const int G32 = it >> 4, kb = it & 15; transpose_item(a.in[6], NPROJ, win_col(32 * G32 + (lane_ & 31)), (bf16*)(X.ws + WS_WIN) + (size_t)(32 * G32) * D, D, 64 * kb, scr, lane_); }
        else { const int r = it - I_IN, G32 = r >> 4, kb = r & 15; transpose_item(a.in[14], D, 32 * G32 + (lane_ & 31), (bf16*)(X.ws + WS_WOUT) + (size_t)(32 * G32) * D, D, 64 * kb, scr, lane_); }
    }
    { float* RT = (float*)(X.ws + WS_RT); const float* wgr = a.in[16]; const float* wer = a.in[18];
      for (int idx = X.vcu * 512 + tid_; idx < 36 * 1024; idx += X.G * 512) { const int o = idx >> 10, k = idx & 1023; RT[idx] = (o < 4) ? wgr[k * 4 + o] : wer[k * 32 + (o - 4)]; } }
}
__device__ __forceinline__ void phase1(const Args& a, const Ctx& X) {
    PHASE_IDS;
    const float* x = a.in[0]; const float* nw = a.in[5]; const float* mod = (const float*)(X.ws + WS_MOD); bf16* H1 = (bf16*)(X.ws + WS_RA);
    const int gw = X.vcu * NWAVES + wave_, NGW = X.G * NWAVES;
    for (int m = gw; m < M; m += NGW) { const int b = m >> 11; const f32x4* xr = (const f32x4*)(x + (size_t)m * D) + lane_; f32x4 v[4]; float ss = 0.f;
#pragma unroll
        for (int j = 0; j < 4; ++j) { v[j] = xr[64 * j]; ss += (v[j].x * v[j].x + v[j].y * v[j].y) + (v[j].z * v[j].z + v[j].w * v[j].w); }
        const float rstd = 1.f / sqrtf(wave_sum(ss) * (1.f / D) + RMS_EPS);
#pragma unroll
        for (int j = 0; j < 4; ++j) { const int k = 256 * j + 4 * lane_; const f32x4 w = *(const f32x4*)(nw + k), sh = *(const f32x4*)(mod + b * NMOD + k), sc = *(const f32x4*)(mod + b * NMOD + D + k);
            const f32x4 h = v[j] * rstd * w * (sc + 1.f) + sh; u32x2v o; o.x = cvt_pk_bf16(h.x, h.y); o.y = cvt_pk_bf16(h.z, h.w); *(u32x2v*)(H1 + (size_t)m * D + k) = o; }
    }
}
__device__ __forceinline__ bf16x8 frag16(const LAS bf16* A, int ld, int r0, int k0, int lane) { return *(const LAS bf16x8*)(A + (r0 + (lane & 15)) * ld + k0 + 8 * (lane >> 4)); }
#define MFMA16(a, b, c) __builtin_amdgcn_mfma_f32_16x16x32_bf16(a, b, c, 0, 0, 0)
__device__ __forceinline__ void stage_T(const bf16* src, LAS bf16* dst, int wave, int lane) {
#pragma unroll
    for (int cc = 0; cc < 2; ++cc) { const int c = wave + 8 * cc; const v4u q = *(const v4u*)(src + (size_t)lane * 512 + 8 * c);
        dst[(8 * c + 0) * 72 + lane] = (bf16)(q.x & 0xffffu); dst[(8 * c + 1) * 72 + lane] = (bf16)(q.x >> 16); dst[(8 * c + 2) * 72 + lane] = (bf16)(q.y & 0xffffu); dst[(8 * c + 3) * 72 + lane] = (bf16)(q.y >> 16);
        dst[(8 * c + 4) * 72 + lane] = (bf16)(q.z & 0xffffu); dst[(8 * c + 5) * 72 + lane] = (bf16)(q.z >> 16); dst[(8 * c + 6) * 72 + lane] = (bf16)(q.w & 0xffffu); dst[(8 * c + 7) * 72 + lane] = (bf16)(q.w >> 16); }
}
__device__ __forceinline__ void phase3(const Args& a, const Ctx& X) {
    PHASE_IDS;
    LAS bf16* VT = (LAS bf16*)X.lds; LAS bf16* KT = (LAS bf16*)(X.lds + 18432);
    const bf16* VI = (const bf16*)(X.ws + WS_VI); const bf16* KP = (const bf16*)(X.ws + WS_KP); bf16* UST = (bf16*)(X.ws + WS_UST);
    for (int un = X.vcu; un < 1024; un += X.G) { const int c = un & 31, h = (un >> 5) & 3, b = un >> 7; const size_t row0 = (size_t)b * SEQ + c * 64;
        stage_T(VI + row0 * 512 + h * 128, VT, wave_, lane_); stage_T(KP + row0 * 512 + h * 128, KT, wave_, lane_);
        __syncthreads();
        f32x4 acc[8];
#pragma unroll
        for (int kt = 0; kt < 8; ++kt) acc[kt] = (f32x4){0.f, 0.f, 0.f, 0.f};
#pragma unroll
        for (int ks = 0; ks < 2; ++ks) { const bf16x8 af = frag16(VT, 72, 16 * wave_, 32 * ks, lane_);
#pragma unroll
            for (int kt = 0; kt < 8; ++kt) acc[kt] = MFMA16(af, frag16(KT, 72, 16 * kt, 32 * ks, lane_), acc[kt]); }
        bf16* U = UST + (size_t)un * 16384;
#pragma unroll
        for (int kt = 0; kt < 8; ++kt)
#pragma unroll
            for (int j = 0; j < 4; ++j) U[(16 * wave_ + (lane_ >> 4) * 4 + j) * 128 + 16 * kt + (lane_ & 15)] = (bf16)f2bf(acc[kt][j]);
        __syncthreads();
    }
}
__device__ __forceinline__ void phase4_scan(const Args& a, const Ctx& X, size_t dst_delta = 0) {
    PHASE_IDS;
    bf16* UST = (bf16*)(X.ws + WS_UST); const float* EL = (const float*)(X.ws + WS_EL);
    for (int g = X.vcu * 512 + tid_; g < 32 * 4096; g += X.G * 512) { const int bh = g >> 12, rem = g & 4095, v = rem >> 5, k4 = (rem & 31) * 4, h = bh & 3, b = bh >> 2;
        f32x4 S = (f32x4){0.f, 0.f, 0.f, 0.f};
#pragma unroll 4
        for (int c = 0; c < NCH; ++c) { u32x2v* p = (u32x2v*)(UST + (size_t)(bh * 32 + c) * 16384 + v * 128 + k4); const u32x2v uw = *p; const f32x4 e = *(const f32x4*)(EL + (size_t)((b * 32 + c) * 4 + h) * 128 + k4);
            u32x2v o; o.x = cvt_pk_bf16(S.x, S.y); o.y = cvt_pk_bf16(S.z, S.w); *(u32x2v*)((char*)p + dst_delta) = o;
            S.x = e.x * (S.x + bf_lo(uw.x)); S.y = e.y * (S.y + bf_hi(uw.x)); S.z = e.z * (S.z + bf_lo(uw.y)); S.w = e.w * (S.w + bf_hi(uw.y)); }
    }
}
struct AttnUnitU { int bvh; int qb; };
struct AttnOrder {
  int vcu;
#ifndef ATTN_REP
#define ATTN_REP 1
#endif
  __device__ __forceinline__ bool next(int i_, AttnUnitU& u) const { if (i_ >= 4 * ATTN_REP) return false; const int i = i_ & 3; const int s0 = 2 * (vcu & 1); u.bvh = vcu >> 1; u.qb = (i == 0) ? s0 : (i == 1) ? 7 - s0 : (i == 2) ? s0 + 1 : 6 - s0; return true; }
};
struct AttnT { const attn_body::bf16* Q; const attn_body::bf16* K; const attn_body::bf16* V; attn_body::bf16* O; };
template <class Sched> __device__ __forceinline__ void attn_phase_(char* lds, const AttnT& T, const Sched& S) {
  AttnUnitU u;
  for (int i = 0; S.next(i, u); ++i) { const int vh = u.bvh & 1, qh = (u.bvh >> 1) & 7, b = u.bvh >> 4; attn_body::attn_unit<8>(b, qh * 64, (qh >> 1) * 128 + vh * 64, qh * 128 + vh * 64, u.qb, T.Q, T.K, T.V, T.O, lds); }
}
__device__ __forceinline__ void phase4_attn(const Args& a, const Ctx& X, char* ldsg) {
    const AttnT T{(const attn_body::bf16*)(X.ws + WS_Q), (const attn_body::bf16*)(X.ws + WS_K), (const attn_body::bf16*)(X.ws + WS_V), (attn_body::bf16*)(X.ws + WS_RA)};
    const AttnOrder S{X.vcu};
    attn_phase_<AttnOrder>(ldsg, T, S);
}
__device__ __forceinline__ void phase5_hgrn(const Args& a, const Ctx& X) {
    PHASE_IDS;
    LAS bf16* QS = (LAS bf16*)X.lds; LAS bf16* KS = (LAS bf16*)(X.lds + 17408); LAS bf16* VT = (LAS bf16*)(X.lds + 34816); LAS bf16* STs = (LAS bf16*)(X.lds + 53248);
    LAS bf16* PS = (LAS bf16*)(X.lds + 88064); LAS float* OS = (LAS float*)(X.lds + 97280);
    const bf16* QP = (const bf16*)(X.ws + WS_QP); const bf16* KP = (const bf16*)(X.ws + WS_KP); const bf16* VI = (const bf16*)(X.ws + WS_VI); const bf16* SG = (const bf16*)(X.ws + WS_SG);
    const bf16* UST = (const bf16*)(X.ws + WS_UST); bf16* MIXED = (bf16*)(X.ws + WS_MIXED); const float* gnw = a.in[13];
    for (int un = X.vcu; un < 1024; un += X.G) { const int c = un & 31, h = (un >> 5) & 3, b = un >> 7; const size_t row0 = (size_t)b * SEQ + c * 64;
#pragma unroll
        for (int i = 0; i < 2; ++i) { const int idx = tid_ + 512 * i, row = idx >> 4, ch = idx & 15;
            *(LAS v4u*)(QS + row * 136 + ch * 8) = *(const v4u*)(QP + (row0 + row) * 512 + h * 128 + ch * 8); *(LAS v4u*)(KS + row * 136 + ch * 8) = *(const v4u*)(KP + (row0 + row) * 512 + h * 128 + ch * 8); }
#pragma unroll
        for (int i = 0; i < 4; ++i) { const int idx = tid_ + 512 * i, row = idx >> 4, ch = idx & 15; *(LAS v4u*)(STs + row * 136 + ch * 8) = *(const v4u*)(UST + (size_t)un * 16384 + row * 128 + ch * 8); }
        stage_T(VI + row0 * 512 + h * 128, VT, wave_, lane_);
        __syncthreads();
        { const int tt = wave_ >> 1; f32x4 s2[2];
#pragma unroll
          for (int x = 0; x < 2; ++x) s2[x] = (f32x4){0.f, 0.f, 0.f, 0.f};
#pragma unroll
          for (int ks = 0; ks < 4; ++ks) { const bf16x8 af = frag16(QS, 136, 16 * tt, 32 * ks, lane_);
#pragma unroll
              for (int x = 0; x < 2; ++x) s2[x] = MFMA16(af, frag16(KS, 136, 16 * (2 * (wave_ & 1) + x), 32 * ks, lane_), s2[x]); }
#pragma unroll
          for (int x = 0; x < 2; ++x) { const int st = 2 * (wave_ & 1) + x;
#pragma unroll
              for (int j = 0; j < 4; ++j) { const int t = 16 * tt + (lane_ >> 4) * 4 + j, s = 16 * st + (lane_ & 15); PS[t * 72 + s] = (bf16)f2bf(s <= t ? s2[x][j] : 0.f); } } }
        __syncthreads();
        { f32x4 o[4];
#pragma unroll
          for (int tt = 0; tt < 4; ++tt) o[tt] = (f32x4){0.f, 0.f, 0.f, 0.f};
#pragma unroll
          for (int ks = 0; ks < 2; ++ks) { const bf16x8 bfr = frag16(VT, 72, 16 * wave_, 32 * ks, lane_);
#pragma unroll
              for (int tt = 0; tt < 4; ++tt) o[tt] = MFMA16(frag16(PS, 72, 16 * tt, 32 * ks, lane_), bfr, o[tt]); }
#pragma unroll
          for (int ks = 0; ks < 4; ++ks) { const bf16x8 bfr = frag16(STs, 136, 16 * wave_, 32 * ks, lane_);
#pragma unroll
              for (int tt = 0; tt < 4; ++tt) o[tt] = MFMA16(frag16(QS, 136, 16 * tt, 32 * ks, lane_), bfr, o[tt]); }
#pragma unroll
          for (int tt = 0; tt < 4; ++tt)
#pragma unroll
              for (int j = 0; j < 4; ++j) OS[(16 * tt + (lane_ >> 4) * 4 + j) * 132 + 16 * wave_ + (lane_ & 15)] = o[tt][j]; }
        __syncthreads();
#pragma unroll
        for (int r = 0; r < 8; ++r) { const int t = 8 * wave_ + r; const float o0 = OS[t * 132 + 2 * lane_], o1 = OS[t * 132 + 2 * lane_ + 1];
            const float rstd = 1.f / sqrtf(wave_sum(o0 * o0 + o1 * o1) * (1.f / 128.f) + RMS_EPS); const unsigned sg = *(const unsigned*)(SG + (row0 + t) * 512 + h * 128 + 2 * lane_);
            *(unsigned*)(MIXED + (row0 + t) * 1024 + 512 + h * 128 + 2 * lane_) = cvt_pk_bf16(o0 * rstd * gnw[2 * lane_] * bf_lo(sg), o1 * rstd * gnw[2 * lane_ + 1] * bf_hi(sg)); }
        __syncthreads();
    }
}
__device__ __forceinline__ void phase5_comb(const Args& a, const Ctx& X) {
    PHASE_IDS;
    const bf16* AO = (const bf16*)(X.ws + WS_RA); bf16* MIXED = (bf16*)(X.ws + WS_MIXED); const float* sw = a.in[11];
    const float d1 = wave_sum(a.in[7][lane_] * a.in[8][lane_]), d2 = wave_sum(a.in[9][lane_] * a.in[10][lane_]); const float lam = expf(d1) - expf(d2) + LAMBDA_INIT;
    const int gw = X.vcu * NWAVES + wave_, NGW = X.G * NWAVES, hh = lane_ >> 4, ds = (lane_ & 15) * 8;
    float swv[8];
#pragma unroll
    for (int i = 0; i < 8; ++i) swv[i] = sw[ds + i] * (1.f - LAMBDA_INIT);
    for (int m = gw; m < M; m += NGW) { const v4u p1 = *(const v4u*)(AO + (size_t)m * 1024 + (2 * hh) * 128 + ds), p2 = *(const v4u*)(AO + (size_t)m * 1024 + (2 * hh + 1) * 128 + ds); float v[8];
        v[0] = bf_lo(p1.x) - lam * bf_lo(p2.x); v[1] = bf_hi(p1.x) - lam * bf_hi(p2.x); v[2] = bf_lo(p1.y) - lam * bf_lo(p2.y); v[3] = bf_hi(p1.y) - lam * bf_hi(p2.y);
        v[4] = bf_lo(p1.z) - lam * bf_lo(p2.z); v[5] = bf_hi(p1.z) - lam * bf_hi(p2.z); v[6] = bf_lo(p1.w) - lam * bf_lo(p2.w); v[7] = bf_hi(p1.w) - lam * bf_hi(p2.w);
        float ss = 0.f;
#pragma unroll
        for (int i = 0; i < 8; ++i) ss += v[i] * v[i];
        ss += __shfl_xor(ss, 1); ss += __shfl_xor(ss, 2); ss += __shfl_xor(ss, 4); ss += __shfl_xor(ss, 8);
        const float rstd = 1.f / sqrtf(ss * (1.f / 128.f) + SUBLN_EPS);
        v4u o; o.x = cvt_pk_bf16(v[0] * rstd * swv[0], v[1] * rstd * swv[1]); o.y = cvt_pk_bf16(v[2] * rstd * swv[2], v[3] * rstd * swv[3]);
        o.z = cvt_pk_bf16(v[4] * rstd * swv[4], v[5] * rstd * swv[5]); o.w = cvt_pk_bf16(v[6] * rstd * swv[6], v[7] * rstd * swv[7]);
        *(v4u*)(MIXED + (size_t)m * 1024 + hh * 128 + ds) = o; }
}
__device__ __forceinline__ void phase7_route(const Args& a, const Ctx& X, gu32* ctl, size_t list_delta = 0, int cnt_delta = 0) {
    PHASE_IDS;
    LAS float* WT = (LAS float*)X.lds;
    const float* bgr = a.in[17]; const float* ber = a.in[19]; const float* nw = a.in[15];
    const float* x1 = a.out; const float* mod = (const float*)(X.ws + WS_MOD); bf16* H2 = (bf16*)(X.ws + WS_RA);
    int* elist = (int*)(X.ws + WS_ELIST + list_delta); float* wlist = (float*)(X.ws + WS_WLIST + list_delta);
    { const f32x4* RT = (const f32x4*)(X.ws + WS_RT);
#pragma unroll 6
      for (int i = 0; i < 18; ++i) { const int idx = tid_ + 512 * i; *(LAS f32x4*)(WT + 4 * idx) = RT[idx]; } }
    LAS int* rE = (LAS int*)(X.lds + LDSCTL_OFF + 2048); LAS float* rW = (LAS float*)(rE + 128); LAS unsigned* lcnt = (LAS unsigned*)(rE + 256); LAS unsigned* lbase = lcnt + 32;
    if (tid_ < 32) lcnt[tid_] = 0u;
    if (tid_ < 128) rE[tid_] = -1;
    __syncthreads();
    const int gw = X.vcu * NWAVES + wave_, NGW = X.G * NWAVES; int trip = 0;
    f32x4 xn[4];
    if (gw < M) {
#pragma unroll
        for (int j = 0; j < 4; ++j) xn[j] = ((const f32x4*)(x1 + (size_t)gw * D) + lane_)[64 * j]; }
    for (int m = gw; m < M; m += NGW, ++trip) { const int b = m >> 11; f32x4 h[4]; float ss = 0.f;
#pragma unroll
        for (int j = 0; j < 4; ++j) { h[j] = xn[j]; ss += (h[j].x * h[j].x + h[j].y * h[j].y) + (h[j].z * h[j].z + h[j].w * h[j].w); }
        if (m + NGW < M) {
#pragma unroll
            for (int j = 0; j < 4; ++j) xn[j] = ((const f32x4*)(x1 + (size_t)(m + NGW) * D) + lane_)[64 * j]; }
        const float rstd = 1.f / sqrtf(wave_sum(ss) * (1.f / D) + RMS_EPS);
#pragma unroll
        for (int j = 0; j < 4; ++j) { const int k = 256 * j + 4 * lane_; const f32x4 w = *(const f32x4*)(nw + k), sh = *(const f32x4*)(mod + b * NMOD + 3 * D + k), sc = *(const f32x4*)(mod + b * NMOD + 4 * D + k);
            h[j] = h[j] * rstd * w * (sc + 1.f) + sh; u32x2v o; o.x = cvt_pk_bf16(h[j].x, h[j].y); o.y = cvt_pk_bf16(h[j].z, h[j].w); *(u32x2v*)(H2 + (size_t)m * D + k) = o; }
        float gl[4];
#pragma unroll
        for (int g = 0; g < 4; ++g) { float s = 0.f;
#pragma unroll
            for (int j = 0; j < 4; ++j) { const f32x4 w = *(const LAS f32x4*)(WT + g * 1024 + 256 * j + 4 * lane_); s += (h[j].x * w.x + h[j].y * w.y) + (h[j].z * w.z + h[j].w * w.w); }
            gl[g] = wave_sum(s) + bgr[g]; }
        int gs = 0; float gm = gl[0];
#pragma unroll
        for (int g = 1; g < 4; ++g) if (gl[g] > gm) { gm = gl[g]; gs = g; }
        float den = 0.f;
#pragma unroll
        for (int g = 0; g < 4; ++g) den += expf(gl[g] - gm);
        const float pg = 1.f / den;
        float el[8]; const LAS float* WE = WT + (4 + 8 * gs) * 1024;
#pragma unroll
        for (int i = 0; i < 8; ++i) { float s = 0.f;
#pragma unroll
            for (int j = 0; j < 4; ++j) { const f32x4 w = *(const LAS f32x4*)(WE + i * 1024 + 256 * j + 4 * lane_); s += (h[j].x * w.x + h[j].y * w.y) + (h[j].z * w.z + h[j].w * w.w); }
            el[i] = wave_sum(s) + ber[gs * 8 + i]; }
        int i1 = 0; float m1 = el[0];
#pragma unroll
        for (int i = 1; i < 8; ++i) if (el[i] > m1) { m1 = el[i]; i1 = i; }
        int i2 = -1; float m2 = -INFINITY;
#pragma unroll
        for (int i = 0; i < 8; ++i) if (i != i1 && (i2 < 0 || el[i] > m2)) { m2 = el[i]; i2 = i; }
        const float t = expf(m2 - m1), w1 = pg / (1.f + t), w2 = pg * t / (1.f + t);
        if (lane_ == 0 && trip < 8) { const int li = trip * 8 + wave_; rE[2 * li] = gs * 8 + i1; rE[2 * li + 1] = gs * 8 + i2; rW[2 * li] = w1; rW[2 * li + 1] = w2; }
    }
    __syncthreads();
    int e = -1; unsigned loc = 0u;
    if (tid_ < 128) { e = rE[tid_]; if (e >= 0) loc = __hip_atomic_fetch_add(lcnt + e, 1u, __ATOMIC_RELAXED, __HIP_MEMORY_SCOPE_WORKGROUP); }
    __syncthreads();
    if (tid_ < 32) { const unsigned cn = lcnt[tid_]; lbase[tid_] = cn ? __hip_atomic_fetch_add(ctl + CW_CNT + cnt_delta + 64 * tid_, cn, RLX_AGENT) : 0u; }
    __syncthreads();
    if (tid_ < 128 && e >= 0) { const unsigned slot = lbase[e] + loc; const int li = tid_ >> 1, m = X.vcu * NWAVES + (li & 7) + (li >> 3) * NGW;
        if (slot < (unsigned)LCAP) { elist[e * LCAP + slot] = 2 * m + (tid_ & 1); wlist[e * LCAP + slot] = rW[tid_]; } }
}
__device__ __forceinline__ void phase7_conv(const Args& a, const Ctx& X) {
    PHASE_IDS;
    LAS float* scr = (LAS float*)(X.lds + wave_ * 8448);
    const int gw = X.vcu * NWAVES + wave_, NGW = X.G * NWAVES;
    constexpr int I_GU = 32 * 4 * 8 * 16, I_DN = 32 * 32 * 8;
    for (int it = gw; it < I_GU + I_DN; it += NGW) {
        if (it < I_GU) { const int kb = it & 15, g8 = (it >> 4) & 7, sub = (it >> 7) & 3, e = it >> 9, bj = g8 >> 2, wc = g8 & 3;
            const float* W = (bj ? a.in[21] : a.in[20]) + (size_t)e * D * FF; const int scol = 128 * sub + 32 * wc + plain32(lane_ & 31);
            transpose_item(W, FF, scol, (bf16*)(X.ws + WS_WGU) + ((size_t)(e * 4 + sub) * 256 + 32 * g8) * D, D, 64 * kb, scr, lane_); }
        else { const int r = it - I_GU, kb = r & 7, G32 = (r >> 3) & 31, e = r >> 8; const float* W = a.in[22] + (size_t)e * FF * D; const int scol = 32 * G32 + plain32(lane_ & 31);
            transpose_item(W, D, scol, (bf16*)(X.ws + WS_WD) + ((size_t)e * 1024 + 32 * G32) * FF, FF, 64 * kb, scr, lane_); }
    }
}
__device__ __forceinline__ void phase10(const Args& a, const Ctx& X, float* dst = nullptr) {
    PHASE_IDS;
    float* out = a.out; const float* mod = (const float*)(X.ws + WS_MOD); const bf16* PART = (const bf16*)(X.ws + WS_PART); const float* fw = a.in[23];
    const int gw = X.vcu * NWAVES + wave_, NGW = X.G * NWAVES;
    for (int m = gw; m < M; m += NGW) { const int b = m >> 11; f32x4* xr = (f32x4*)(out + (size_t)m * D) + lane_; f32x4* xw = dst ? (f32x4*)(dst + (size_t)m * D) + lane_ : xr; f32x4 y[4]; float ss = 0.f;
#pragma unroll
        for (int j = 0; j < 4; ++j) { const int k = 256 * j + 4 * lane_; const f32x4 g = *(const f32x4*)(mod + b * NMOD + 5 * D + k);
            const u32x2v p0 = *(const u32x2v*)(PART + (size_t)(2 * m) * D + k), p1 = *(const u32x2v*)(PART + (size_t)(2 * m + 1) * D + k);
            f32x4 f; f.x = bf_lo(p0.x) + bf_lo(p1.x); f.y = bf_hi(p0.x) + bf_hi(p1.x); f.z = bf_lo(p0.y) + bf_lo(p1.y); f.w = bf_hi(p0.y) + bf_hi(p1.y);
            y[j] = xr[64 * j] + g * f; ss += (y[j].x * y[j].x + y[j].y * y[j].y) + (y[j].z * y[j].z + y[j].w * y[j].w); }
        const float rstd = 1.f / sqrtf(wave_sum(ss) * (1.f / D) + RMS_EPS);
#pragma unroll
        for (int j = 0; j < 4; ++j) { const int k = 256 * j + 4 * lane_; xw[64 * j] = y[j] * rstd * *(const f32x4*)(fw + k); }
    }
}

__global__ void __launch_bounds__(NWAVES * 64, 2) hymba_fwd(Args args) {
    extern __shared__ __attribute__((aligned(16))) unsigned char lds[];
    Ctx X; X.lds = (LAS unsigned char*)lds; X.ws = args.ws;
    X.G = gridDim.x; { const int bx = blockIdx.x; X.vcu = (X.G % 8 == 0) ? (bx % 8) * (X.G / 8) + bx / 8 : bx; }
    gu32* ctl = (gu32*)(args.ws + WS_CTL);
    for (int u = threadIdx.x; u < (LDS_BYTES - LDSCTL_OFF) / 4; u += NWAVES * 64) ((LAS unsigned*)(X.lds + LDSCTL_OFF))[u] = 0u;
    __syncthreads();
    if (MK_N_LAUNCHES == 1) (void)xcd_barrier_post((unsigned*)(ctl + CW_BAR), (volatile LAS unsigned*)(X.lds + MISC_OFF) + 8);
    const int lo = args.ph_lo, hi = args.ph_hi;
#ifndef PH_MASK
#define PH_MASK 0x7ff
#endif
#define IN(k) ((((PH_MASK) >> (k)) & 1) && lo <= (k) && (k) < hi)
#ifdef TPROBE
    unsigned long long tp_prev = __builtin_amdgcn_s_memrealtime(), tp_dt = 0;
#define TSTAMP(k) do { const unsigned long long n_ = __builtin_amdgcn_s_memrealtime(); if ((k) == TPROBE) tp_dt = n_ - tp_prev; tp_prev = n_; } while (0)
#else
#define TSTAMP(k) do { } while (0)
#endif
#define SEAM(k) do { if (IN(k) && IN((k) + 1)) { XcdBarrier bar_; bar_.bar = (unsigned*)((gu32*)(args.ws + WS_CTL) + CW_BAR); bar_.x = xb_xcc_id(); bar_.st = (volatile LAS unsigned*)(X.lds + MISC_OFF) + 8; xcd_barrier(bar_); } TSTAMP(k); } while (0)
    LAS int* tab = (LAS int*)(X.lds + SCHED_OFF);
#ifndef DUP_MASK
#define DUP_MASK 0
#endif
#define GBAR() do { XcdBarrier bar_; bar_.bar = (unsigned*)((gu32*)(args.ws + WS_CTL) + CW_BAR); bar_.x = xb_xcc_id(); bar_.st = (volatile LAS unsigned*)(X.lds + MISC_OFF) + 8; xcd_barrier(bar_); } while (0)
#define DUP(k) (((DUP_MASK) >> (k)) & 1)
    if (IN(0)) { phase0(args, X); if (DUP(0)) { GBAR(); phase0(args, X); } } SEAM(0);
    if (IN(1)) { phase1(args, X); if (DUP(1)) { GBAR(); phase1(args, X); } } SEAM(1);
#ifdef EXTRA_BARS
    for (int i_ = 0; i_ < EXTRA_BARS; ++i_) GBAR();
#endif
    if (IN(2)) {
        { DenseOrder S; S.init(M, 2560, D, X.G, (int)blockIdx.x, args.ws + WS_RA, args.ws + WS_WIN, 0, 6, 4);
          EpiInProj<3> E{(bf16*)(args.ws + WS_Q), (float*)(args.ws + WS_EL), (const int*)args.in[2], args.in[12]};
          pg8::gemm_phase<EpiInProj<3>, DenseOrder, false, true>(X.lds, D, S, E); }
        { DenseOrder S; S.init(M, 1024, D, X.G, (int)blockIdx.x, args.ws + WS_RA, args.ws + WS_WIN, 6);
          EpiInProj<4> E{(bf16*)(args.ws + WS_Q), (float*)(args.ws + WS_EL), (const int*)args.in[2], args.in[12]};
          pg8::gemm_phase<EpiInProj<4>, DenseOrder, false, true>(X.lds, D, S, E); }
        if (DUP(2)) { GBAR(); { DenseOrder S; S.init(M, 2560, D, X.G, (int)blockIdx.x, args.ws + WS_RA, args.ws + WS_WIN, 0, 6, 4); EpiInProj<3> E{(bf16*)(args.ws + WS_Q), (float*)(args.ws + WS_EL), (const int*)args.in[2], args.in[12]}; pg8::gemm_phase<EpiInProj<3>, DenseOrder, false, true>(X.lds, D, S, E); }
          { DenseOrder S; S.init(M, 1024, D, X.G, (int)blockIdx.x, args.ws + WS_RA, args.ws + WS_WIN, 6); EpiInProj<4> E{(bf16*)(args.ws + WS_Q), (float*)(args.ws + WS_EL), (const int*)args.in[2], args.in[12]}; pg8::gemm_phase<EpiInProj<4>, DenseOrder, false, true>(X.lds, D, S, E); } } } SEAM(2);
    if (IN(3)) { phase3(args, X); if (DUP(3)) { GBAR(); phase3(args, X); } } SEAM(3);
    if (IN(4)) { if (DUP(11)) { phase4_scan(args, X, WS_WD - WS_UST); GBAR(); } phase4_scan(args, X); phase4_attn(args, X, (char*)lds); } SEAM(4);
    if (IN(5)) { phase5_hgrn(args, X); phase5_comb(args, X); if (DUP(5)) { GBAR(); phase5_hgrn(args, X); phase5_comb(args, X); } } SEAM(5);
    if (IN(6)) { DenseOrder S; S.init(M, D, D, X.G, (int)blockIdx.x, args.ws + WS_MIXED, args.ws + WS_WOUT);
        EpiOut E{args.in[0], (const float*)(args.ws + WS_MOD), args.out};
        pg8::gemm_phase<EpiOut, DenseOrder, false, true>(X.lds, D, S, E); if (DUP(6)) { GBAR(); pg8::gemm_phase<EpiOut, DenseOrder, false, true>(X.lds, D, S, E); } } SEAM(6);
    if (IN(7)) { if (DUP(12)) { phase7_route(args, X, ctl, WS_HID - WS_ELIST, 4096); GBAR(); } phase7_route(args, X, ctl); __syncthreads(); phase7_conv(args, X); if (DUP(7)) { GBAR(); phase7_conv(args, X); } } SEAM(7);
    if (IN(8)) { sched_tables(tab, ctl + CW_CNT, (int)threadIdx.x);
        MoeOrder S{tab, X.G, X.vcu, 0, (const char*)(args.ws + WS_RA), (const char*)(args.ws + WS_WGU), (const int*)(args.ws + WS_ELIST)};
        EpiGU E{(bf16*)(args.ws + WS_HID), (const float*)(args.ws + WS_WLIST)};
        pg8::gemm_phase<EpiGU, MoeOrder, true, true>(X.lds, D, S, E); } SEAM(8);
    if (IN(9)) { sched_tables(tab, ctl + CW_CNT, (int)threadIdx.x);
        MoeOrder S{tab, X.G, X.vcu, 1, (const char*)(args.ws + WS_HID), (const char*)(args.ws + WS_WD), (const int*)(args.ws + WS_ELIST)};
        EpiDN E{(bf16*)(args.ws + WS_PART), (const int*)(args.ws + WS_ELIST)};
        pg8::gemm_phase<EpiDN, MoeOrder, false, true>(X.lds, FF, S, E); } SEAM(9);
    if (IN(10)) { if (DUP(13)) { phase10(args, X, (float*)(args.ws + WS_WGU)); GBAR(); } phase10(args, X); }
#ifdef TPROBE
    TSTAMP(10);
    if (blockIdx.x == 0 && threadIdx.x == 0) { const unsigned long long t0_ = __builtin_amdgcn_s_memrealtime(); while (__builtin_amdgcn_s_memrealtime() - t0_ < tp_dt * TSCALE) __builtin_amdgcn_s_sleep(8); }
#endif
#undef IN
#undef SEAM
}

extern "C" void kernel_launch(void* const* d_in, const int* in_sizes, int n_in, void* d_out, int out_size, void* d_ws, size_t ws_size, hipStream_t stream) {
    static int grid = 0;
    if (grid == 0) {
        if (n_in != 24 || in_sizes[0] != M * D || out_size != M * D || ws_size < WS_END) { fprintf(stderr, "kernel_launch: unexpected shapes (n_in %d, in0 %d, out %d, ws %zu); nothing launched\n", n_in, n_in > 0 ? in_sizes[0] : -1, out_size, ws_size); grid = -1; return; }
        int dev = 0, cus = 0, per_cu = 0;
        if (hipGetDevice(&dev) != hipSuccess || hipDeviceGetAttribute(&cus, hipDeviceAttributeMultiprocessorCount, dev) != hipSuccess) { fprintf(stderr, "kernel_launch: device query failed\n"); grid = -1; return; }
        if (hipFuncSetAttribute((const void*)hymba_fwd, hipFuncAttributeMaxDynamicSharedMemorySize, LDS_BYTES) != hipSuccess) { fprintf(stderr, "kernel_launch: hipFuncSetAttribute failed\n"); grid = -1; return; }
        if (hipOccupancyMaxActiveBlocksPerMultiprocessor(&per_cu, (const void*)hymba_fwd, NWAVES * 64, LDS_BYTES) != hipSuccess || per_cu < 1) { fprintf(stderr, "kernel_launch: occupancy query reports %d workgroups per CU\n", per_cu); (void)hipGetLastError(); grid = -1; return; }
        if (cus != 256) { fprintf(stderr, "kernel_launch: built for a 256-CU device, found %d CUs; nothing launched\n", cus); grid = -1; return; }
        grid = cus;
    }
    if (grid < 0) return;
    (void)hipMemsetAsync((char*)d_ws + WS_CTL, 0, CTL_ZERO_BYTES, stream);
    Args a{};
    for (int i = 0; i < 24; ++i) a.in[i] = (const float*)d_in[i];
    a.out = (float*)d_out; a.ws = (unsigned char*)d_ws;
    if (MK_N_LAUNCHES == 1) { a.ph_lo = 0; a.ph_hi = NPH; hipLaunchKernelGGL(hymba_fwd, dim3(grid), dim3(NWAVES * 64), LDS_BYTES, stream, a); }
    else { for (int p = 0; p < NPH; ++p) { a.ph_lo = p; a.ph_hi = p + 1; hipLaunchKernelGGL(hymba_fwd, dim3(grid), dim3(NWAVES * 64), LDS_BYTES, stream, a); } }
}
```
